# Optimizing an MI355X kernel written in HIP

```python
import math
import jax, jax.numpy as jnp
from jax import lax
import numpy as np

D_MODEL = 1024
BATCH = 8
SEQ = 4096
DEPTH = 2

SB_HEADS = 8
SB_HEAD_DIM = 64
SB_WIDTH = SB_HEADS * SB_HEAD_DIM
BLOCK_Q = 128
LRU_WIDTH = 512
LRU_BLOCKS = 8
LRU_BLOCK = LRU_WIDTH // LRU_BLOCKS
LRU_CONV = 4
LRU_C = 8.0
SC_WIDTH = 512
SC_CONV = 3
N_BRANCH = 3
N_GROUPS = 4
EXP_PER_GROUP = 4
N_EXPERTS = N_GROUPS * EXP_PER_GROUP
TOP_K = 2
D_EXPERT = 512
ALPHA = (2 * DEPTH) ** 0.25
BETA = (8 * DEPTH) ** -0.25
LN_EPS = 1e-5

PROJ_SPLITS = [SB_WIDTH] * 3 + [LRU_WIDTH] * 2 + [SC_WIDTH] * 3 + [D_MODEL] * N_BRANCH
PROJ_COLS = sum(PROJ_SPLITS)
SPLIT_POINTS = [sum(PROJ_SPLITS[:i + 1]) for i in range(len(PROJ_SPLITS) - 1)]

kernel_name = "hybrid_sb_rglru_shortconv_hmoe_deepnorm"


def layer_norm(x, g, b):
    xf = x.astype(jnp.float32)
    mu = jnp.mean(xf, axis=-1, keepdims=True)
    var = jnp.mean(jnp.square(xf - mu), axis=-1, keepdims=True)
    y = (xf - mu) * lax.rsqrt(var + LN_EPS) * g.astype(jnp.float32) + b.astype(jnp.float32)
    return y.astype(x.dtype)


def causal_dwconv(u, w):
    K = w.shape[0]
    S = u.shape[1]
    up = jnp.pad(u, ((0, 0), (K - 1, 0), (0, 0)))
    return sum(w[k] * up[:, k:k + S] for k in range(K))


def stick_breaking_attention(q, k, v):
    B, S, H, Dh = q.shape
    nb = S // BLOCK_Q
    qf = q.astype(jnp.float32) * (Dh ** -0.5)
    kf = k.astype(jnp.float32)
    vf = v.astype(jnp.float32)
    q_blocks = qf.reshape(B, nb, BLOCK_Q, H, Dh).transpose(1, 0, 3, 2, 4)
    starts = jnp.arange(nb, dtype=jnp.int32) * BLOCK_Q
    key_pos = jnp.arange(S, dtype=jnp.int32)

    def one_block(args):
        qb, start = args
        z = jnp.einsum('bhqd,bkhd->bhqk', qb, kf)
        q_pos = start + jnp.arange(BLOCK_Q, dtype=jnp.int32)
        before = key_pos[None, :] < q_pos[:, None]
        log_keep = jnp.where(before, jax.nn.log_sigmoid(-z), 0.0)
        log_pass = lax.cumsum(log_keep, axis=3, reverse=True) - log_keep
        w = jnp.where(before, jnp.exp(jax.nn.log_sigmoid(z) + log_pass), 0.0)
        return jnp.einsum('bhqk,bkhd->bqhd', w, vf)

    o = lax.map(one_block, (q_blocks, starts))
    return o.transpose(1, 0, 2, 3, 4).reshape(B, S, H * Dh).astype(q.dtype)


def rg_lru(u, w_a, b_a, w_x, b_x, lam):
    B, S, W = u.shape
    uf = u.astype(jnp.float32)
    ub = uf.reshape(B, S, LRU_BLOCKS, LRU_BLOCK)
    r = jax.nn.sigmoid(jnp.einsum('bshi,hij->bshj', ub, w_a.astype(jnp.float32)).reshape(B, S, W)
                       + b_a.astype(jnp.float32))
    i = jax.nn.sigmoid(jnp.einsum('bshi,hij->bshj', ub, w_x.astype(jnp.float32)).reshape(B, S, W)
                       + b_x.astype(jnp.float32))
    log_a = -LRU_C * r * jax.nn.softplus(-lam.astype(jnp.float32))
    a = jnp.exp(log_a)
    drive = jnp.sqrt(-jnp.expm1(2.0 * log_a)) * (i * uf)

    def combine(left, right):
        a1, b1 = left
        a2, b2 = right
        return a1 * a2, a2 * b1 + b2

    _, h = lax.associative_scan(combine, (a, drive), axis=1)
    return h.astype(u.dtype)


def hybrid_mixer(x, w_in, gate_b, lru_conv_w, lru_conv_b, lru_wa, lru_ba, lru_wx, lru_bx,
                 lru_lambda, sc_conv_w, w_branch_sb, w_branch_lru, w_branch_sc, w_out):
    B, S, _ = x.shape
    zc = jnp.einsum('bsd,de->bse', x, w_in)
    (q, k, v, lru_in, lru_gate, sc_b, sc_c, sc_h,
     g_sb, g_lru, g_sc) = jnp.split(zc, SPLIT_POINTS, axis=-1)
    hs = (B, S, SB_HEADS, SB_HEAD_DIM)
    y_sb = stick_breaking_attention(q.reshape(hs), k.reshape(hs), v.reshape(hs))
    u = causal_dwconv(lru_in, lru_conv_w) + lru_conv_b
    y_lru = jax.nn.gelu(lru_gate) * rg_lru(u, lru_wa, lru_ba, lru_wx, lru_bx, lru_lambda)
    y_sc = sc_b * causal_dwconv(sc_c * sc_h, sc_conv_w)
    merged = (jax.nn.sigmoid(g_sb + gate_b[0]) * jnp.einsum('bsw,wd->bsd', y_sb, w_branch_sb)
              + jax.nn.sigmoid(g_lru + gate_b[1]) * jnp.einsum('bsw,wd->bsd', y_lru, w_branch_lru)
              + jax.nn.sigmoid(g_sc + gate_b[2]) * jnp.einsum('bsw,wd->bsd', y_sc, w_branch_sc))
    return jnp.einsum('bsd,de->bse', merged, w_out)


def hierarchical_moe(x, w_group, group_bias, w_expert_router, expert_bias, w_gate, w_up, w_down):
    B, S, D = x.shape
    xt = x.reshape(-1, D)
    N = xt.shape[0]
    g_logits = jnp.einsum('nd,dg->ng', xt, w_group).astype(jnp.float32)
    g_prob = jax.nn.softmax(g_logits, axis=-1)
    g_sel = jnp.argmax(g_logits + group_bias.astype(jnp.float32), axis=-1)
    e_logits = jnp.einsum('nd,de->ne', xt, w_expert_router).astype(jnp.float32)
    e_logits = e_logits.reshape(N, N_GROUPS, EXP_PER_GROUP)
    e_in_group = jnp.take_along_axis(e_logits, g_sel[:, None, None], axis=1)[:, 0]
    e_bias = expert_bias.astype(jnp.float32).reshape(N_GROUPS, EXP_PER_GROUP)[g_sel]
    _, top_idx = lax.top_k(e_in_group + e_bias, TOP_K)
    top_w = jax.nn.softmax(jnp.take_along_axis(e_in_group, top_idx, axis=1), axis=-1)
    top_w = top_w * jnp.take_along_axis(g_prob, g_sel[:, None], axis=1)
    expert_id = g_sel[:, None] * EXP_PER_GROUP + top_idx
    combine = jnp.sum(jax.nn.one_hot(expert_id, N_EXPERTS, dtype=jnp.float32) * top_w[..., None],
                      axis=1).astype(x.dtype)
    out = jnp.zeros((N, D), x.dtype)
    for grp in range(N_GROUPS):
        sl = slice(grp * EXP_PER_GROUP, (grp + 1) * EXP_PER_GROUP)
        h = (jax.nn.silu(jnp.einsum('nd,edf->nef', xt, w_gate[sl]))
             * jnp.einsum('nd,edf->nef', xt, w_up[sl]))
        out = out + jnp.einsum('nef,efd->nd', h * combine[:, sl, None], w_down[sl])
    return out.reshape(B, S, D)


def setup_inputs(seed: int = 0) -> dict:
    key = jax.random.key(seed)
    ks = iter(jax.random.split(key, 40))
    f32 = jnp.float32

    def nrm(shape, scale):
        return jax.random.normal(next(ks), shape, f32) * scale

    u = jax.random.uniform(next(ks), (DEPTH, LRU_WIDTH), f32, 0.9, 0.999)
    a0 = u ** (1.0 / LRU_C)
    lru_lambda = jnp.log(a0) - jnp.log1p(-a0)
    return {
        "x": nrm((BATCH, SEQ, D_MODEL), 1.0),
        "ln_in_g": 1.0 + nrm((D_MODEL,), 0.02),
        "ln_in_b": nrm((D_MODEL,), 0.02),
        "w_in": nrm((DEPTH, D_MODEL, PROJ_COLS), D_MODEL ** -0.5),
        "gate_b": nrm((DEPTH, N_BRANCH, D_MODEL), 0.1),
        "lru_conv_w": nrm((DEPTH, LRU_CONV, LRU_WIDTH), LRU_CONV ** -0.5),
        "lru_conv_b": nrm((DEPTH, LRU_WIDTH), 0.02),
        "lru_wa": nrm((DEPTH, LRU_BLOCKS, LRU_BLOCK, LRU_BLOCK), LRU_BLOCK ** -0.5),
        "lru_ba": nrm((DEPTH, LRU_WIDTH), 0.1),
        "lru_wx": nrm((DEPTH, LRU_BLOCKS, LRU_BLOCK, LRU_BLOCK), LRU_BLOCK ** -0.5),
        "lru_bx": nrm((DEPTH, LRU_WIDTH), 0.1),
        "lru_lambda": lru_lambda,
        "sc_conv_w": nrm((DEPTH, SC_CONV, SC_WIDTH), SC_CONV ** -0.5),
        "w_branch_sb": nrm((DEPTH, SB_WIDTH, D_MODEL), BETA * SB_WIDTH ** -0.5),
        "w_branch_lru": nrm((DEPTH, LRU_WIDTH, D_MODEL), BETA * LRU_WIDTH ** -0.5),
        "w_branch_sc": nrm((DEPTH, SC_WIDTH, D_MODEL), BETA * SC_WIDTH ** -0.5),
        "w_out": nrm((DEPTH, D_MODEL, D_MODEL), BETA * D_MODEL ** -0.5),
        "ln1_g": 1.0 + nrm((DEPTH, D_MODEL), 0.02),
        "ln1_b": nrm((DEPTH, D_MODEL), 0.02),
        "w_group": nrm((DEPTH, D_MODEL, N_GROUPS), D_MODEL ** -0.5),
        "group_bias": nrm((DEPTH, N_GROUPS), 0.01),
        "w_expert_router": nrm((DEPTH, D_MODEL, N_EXPERTS), D_MODEL ** -0.5),
        "expert_bias": nrm((DEPTH, N_EXPERTS), 0.01),
        "w_gate": nrm((DEPTH, N_EXPERTS, D_MODEL, D_EXPERT), D_MODEL ** -0.5),
        "w_up": nrm((DEPTH, N_EXPERTS, D_MODEL, D_EXPERT), D_MODEL ** -0.5),
        "w_down": nrm((DEPTH, N_EXPERTS, D_EXPERT, D_MODEL), BETA * D_EXPERT ** -0.5),
        "ln2_g": 1.0 + nrm((DEPTH, D_MODEL), 0.02),
        "ln2_b": nrm((DEPTH, D_MODEL), 0.02),
    }


def reference(x, ln_in_g, ln_in_b, w_in, gate_b, lru_conv_w, lru_conv_b, lru_wa, lru_ba,
              lru_wx, lru_bx, lru_lambda, sc_conv_w, w_branch_sb, w_branch_lru, w_branch_sc,
              w_out, ln1_g, ln1_b, w_group, group_bias, w_expert_router, expert_bias,
              w_gate, w_up, w_down, ln2_g, ln2_b):
    h = layer_norm(x, ln_in_g, ln_in_b)
    for l in range(DEPTH):
        mix = hybrid_mixer(h, w_in[l], gate_b[l], lru_conv_w[l], lru_conv_b[l], lru_wa[l],
                           lru_ba[l], lru_wx[l], lru_bx[l], lru_lambda[l], sc_conv_w[l],
                           w_branch_sb[l], w_branch_lru[l], w_branch_sc[l], w_out[l])
        h = layer_norm(ALPHA * h + mix, ln1_g[l], ln1_b[l])
        ffn = hierarchical_moe(h, w_group[l], group_bias[l], w_expert_router[l], expert_bias[l],
                               w_gate[l], w_up[l], w_down[l])
        h = layer_norm(ALPHA * h + ffn, ln2_g[l], ln2_b[l])
    return h
```

```cpp
#include <hip/hip_runtime.h>
#include <cstdio>
#include <cstdint>
namespace pg8 {
#define PG8_LAS __attribute__((address_space(3)))
typedef unsigned short bf16_t;
typedef short bf16x8 __attribute__((ext_vector_type(8)));
typedef float f32x4 __attribute__((ext_vector_type(4)));
typedef float f32x2 __attribute__((ext_vector_type(2)));
typedef unsigned u32x4 __attribute__((ext_vector_type(4)));
typedef unsigned u32x2 __attribute__((ext_vector_type(2)));
constexpr int BM = 256, BK = 64, HALF = 128, HTB = HALF * BK * 2  , STAGE_BYTES = 8 * HTB, NXCD = 8, WGM = 8;

__host__ __device__ __forceinline__ int lds_byte(int r, int c) { const int st = (r >> 4) * 2 + (c >> 5), rr = r & 15, cc = c & 31, ob = rr * 64 + cc * 2; return st * 1024 + (ob ^ (((ob >> 9) & 1) << 5)); }
__host__ __device__ __forceinline__ void stage_rc(int b, int& R, int& C) { const int st = b / 1024, sb = b % 1024, swz = sb ^ (((sb >> 9) & 1) << 5); R = (st >> 1) * 16 + swz / 64; C = (st & 1) * 32 + (swz % 64) / 2; }
__host__ __device__ __forceinline__ int perm32(int rho) { const int n = rho >> 4, i = rho & 15; return 8 * (i >> 2) + 4 * n + (i & 3); }

struct Unit { int pm, pn, ty, aux, nv, pad; const char* A; const char* B; };
struct Gemm { int K, lda, ldb; };

__device__ __forceinline__ void tile_swz(int L, int nM, int nN, int& pm, int& pn) {
    const int nwg = nM * nN; int wgid = L; { const int q = nwg / NXCD, r = nwg % NXCD, xcd = wgid % NXCD, off = wgid / NXCD; wgid = (xcd < r ? xcd * (q + 1) : r * (q + 1) + (xcd - r) * q) + off; }
    const int nig = WGM * nN, gid = wgid / nig, fm = gid * WGM, gsz = (nM - fm) < WGM ? (nM - fm) : WGM;
    pm = fm + ((wgid % nig) % gsz); pn = (wgid % nig) / gsz;
}
__device__ __forceinline__ unsigned cvt_pk_bf16(float lo, float hi) { unsigned r; asm volatile("v_cvt_pk_bf16_f32 %0, %1, %2" : "=v"(r) : "v"(lo), "v"(hi)); return r; }

template <class Epi, class Sched, bool ALIGN_EPI, bool GATHER>
__device__ __forceinline__ void gemm_phase(PG8_LAS unsigned char* lds, const Gemm g, const Sched& S, const Epi& E) {
    int tid = threadIdx.x; asm volatile("" : "+v"(tid));
    const int wid = __builtin_amdgcn_readfirstlane(tid >> 6), lane = tid & 63, wr = wid >> 2, wc = wid & 3, fr = lane & 15, fq = lane >> 4;
    const int K = g.K, nt = K / BK;
    int sR[2], sC[2];
    unsigned cvA[2][2], nvA[2][2], voffB[2];
#pragma unroll
    for (int i = 0; i < 2; ++i) { int R, C; stage_rc(tid * 16 + i * 8192, R, C); sR[i] = R; sC[i] = C; const int Rb = Epi::PERM ? ((R & ~31) + perm32(R & 31)) : R;
        voffB[i] = (unsigned)(Rb * g.ldb + C) * 2u;
#pragma unroll
        for (int h = 0; h < 2; ++h) { cvA[h][i] = (unsigned)((h * HALF + R) * g.lda + C) * 2u; nvA[h][i] = cvA[h][i]; } }
    const size_t kstep = (size_t)(BK * 2);
    const size_t hstepB = (size_t)HALF * g.ldb * 2;
    const unsigned ldsw = (unsigned)wid * 1024u;
    const int aoff = lds_byte(wr * 64 + fr, fq * 8), boff = lds_byte(wc * 32 + fr, fq * 8);
#define PG8_SA(b, h) (((b) * 2 + (h)) * HTB)
#define PG8_SB(b, h) ((4 + (b) * 2 + (h)) * HTB)
#define PG8_STAGE(bufoff, gbase, voff) do { _Pragma("unroll") for (int _i = 0; _i < 2; ++_i) \
        __builtin_amdgcn_global_load_lds((const unsigned*)((const char*)(gbase) + (voff)[_i]), (PG8_LAS unsigned*)(lds + (bufoff) + ldsw + _i * 8192), 16, 0, 0); } while (0)
#define PG8_LDA(dst, b, h) do { _Pragma("unroll") for (int m = 0; m < 4; ++m) _Pragma("unroll") for (int k = 0; k < 2; ++k) dst[m][k] = *(const PG8_LAS bf16x8*)(lds + PG8_SA(b, h) + aoff + m * 2048 + k * 1024); } while (0)
#define PG8_LDB(dst, b, h) do { _Pragma("unroll") for (int n = 0; n < 2; ++n) _Pragma("unroll") for (int k = 0; k < 2; ++k) dst[n][k] = *(const PG8_LAS bf16x8*)(lds + PG8_SB(b, h) + boff + n * 2048 + k * 1024); } while (0)
#define PG8_MMA(ai, bj, At, Bt) do { __builtin_amdgcn_s_setprio(1); _Pragma("unroll") for (int m = 0; m < 4; ++m) _Pragma("unroll") for (int n = 0; n < 2; ++n) _Pragma("unroll") for (int k = 0; k < 2; ++k) \
        acc[ai][bj][m][n] = __builtin_amdgcn_mfma_f32_16x16x32_bf16(Bt[n][k], At[m][k], acc[ai][bj][m][n], 0, 0, 0); __builtin_amdgcn_s_setprio(0); } while (0)
#define PG8_WAIT_V(n) asm volatile("s_waitcnt vmcnt(" #n ")" ::: "memory")
#define PG8_WAIT_L(n) asm volatile("s_waitcnt lgkmcnt(" #n ")" ::: "memory")
#define PG8_BAR __builtin_amdgcn_s_barrier()
#define PG8_SCHED __builtin_amdgcn_sched_barrier(0)
    Unit cur, nxt; int ui = 0;
    if (!S.next(0, cur)) return;
    f32x4 acc[2][2][4][2];
#pragma unroll
    for (int a = 0; a < 2; ++a)
#pragma unroll
        for (int b = 0; b < 2; ++b)
#pragma unroll
            for (int m = 0; m < 4; ++m)
#pragma unroll
                for (int n = 0; n < 2; ++n) acc[a][b][m][n] = (f32x4){0.f, 0.f, 0.f, 0.f};
    bf16x8 At[4][2], B0[2][2], B1[2][2];
    const char* cA = cur.A; const char* cB = cur.B;
    asm volatile("" : "+s"(cA), "+s"(cB));
    if constexpr (GATHER) {
#pragma unroll
        for (int h = 0; h < 2; ++h)
#pragma unroll
            for (int i = 0; i < 2; ++i) cvA[h][i] = (unsigned)(S.arow(cur, h * HALF + sR[i]) * g.lda + sC[i]) * 2u;
        PG8_WAIT_V(0);
    }
    S.a_ready(cur);
    PG8_STAGE(PG8_SB(0, 0), cB, voffB); PG8_STAGE(PG8_SB(0, 1), cB + hstepB, voffB); PG8_STAGE(PG8_SA(0, 0), cA, cvA[0]); PG8_STAGE(PG8_SA(0, 1), cA, cvA[1]);
    if (wr == 1) PG8_BAR;
    PG8_WAIT_V(2); PG8_BAR;
    PG8_STAGE(PG8_SB(1, 0), cB + kstep, voffB); PG8_STAGE(PG8_SA(1, 0), cA + kstep, cvA[0]); PG8_STAGE(PG8_SB(1, 1), cB + hstepB + kstep, voffB);
    PG8_WAIT_V(6); PG8_BAR;
    for (;;) {
        const bool has_next = S.next(ui + 1, nxt);
        const char* nA = has_next ? nxt.A : cA; const char* nB = has_next ? nxt.B : cB;
        asm volatile("" : "+s"(nA), "+s"(nB));
        if constexpr (GATHER) {
            if (has_next) {
#pragma unroll
                for (int h = 0; h < 2; ++h)
#pragma unroll
                    for (int i = 0; i < 2; ++i) nvA[h][i] = (unsigned)(S.arow(nxt, h * HALF + sR[i]) * g.lda + sC[i]) * 2u;
                PG8_WAIT_V(0);
            } else {
#pragma unroll
                for (int h = 0; h < 2; ++h)
#pragma unroll
                    for (int i = 0; i < 2; ++i) nvA[h][i] = cvA[h][i];
            }
        }
        for (int t = 0; t < nt; t += 2) {
            const bool last = (t == nt - 2);
            const char* a1 = cA + (size_t)(t + 1) * kstep;
            const char* a2 = last ? nA : cA + (size_t)(t + 2) * kstep; const char* b2 = last ? nB : cB + (size_t)(t + 2) * kstep;
            const char* a3 = a2 + kstep; const char* b3 = b2 + kstep;
            unsigned o2[2][2];
#pragma unroll
            for (int h = 0; h < 2; ++h)
#pragma unroll
                for (int i = 0; i < 2; ++i) o2[h][i] = (GATHER && last) ? nvA[h][i] : cvA[h][i];
            if (last && has_next) S.a_ready(nxt);
            PG8_LDB(B0, 0, 0); PG8_LDB(B1, 0, 1); PG8_SCHED; PG8_LDA(At, 0, 0); PG8_STAGE(PG8_SA(1, 1), a1, cvA[1]);
            PG8_WAIT_V(8); PG8_WAIT_L(0); PG8_BAR; PG8_MMA(0, 0, At, B0); PG8_MMA(0, 1, At, B1); PG8_BAR; PG8_SCHED;
            PG8_LDA(At, 0, 1); PG8_STAGE(PG8_SB(0, 0), b2, voffB); PG8_STAGE(PG8_SB(0, 1), b2 + hstepB, voffB); PG8_STAGE(PG8_SA(0, 0), a2, o2[0]);
            PG8_WAIT_V(8); PG8_WAIT_L(0); PG8_BAR; PG8_MMA(1, 0, At, B0); PG8_MMA(1, 1, At, B1); PG8_BAR; PG8_SCHED;
            PG8_LDB(B0, 1, 0); PG8_LDB(B1, 1, 1); PG8_SCHED; PG8_LDA(At, 1, 0); PG8_STAGE(PG8_SA(0, 1), a2, o2[1]);
            PG8_WAIT_V(8); PG8_WAIT_L(0); PG8_BAR; PG8_MMA(0, 0, At, B0); PG8_MMA(0, 1, At, B1); PG8_BAR; PG8_SCHED;
            PG8_LDA(At, 1, 1); PG8_STAGE(PG8_SB(1, 0), b3, voffB); PG8_STAGE(PG8_SB(1, 1), b3 + hstepB, voffB); PG8_STAGE(PG8_SA(1, 0), a3, o2[0]);
            PG8_WAIT_V(8); PG8_WAIT_L(0); PG8_BAR; PG8_MMA(1, 0, At, B0); PG8_MMA(1, 1, At, B1); PG8_BAR; PG8_SCHED;
        }
        if constexpr (ALIGN_EPI) { if (wr == 0) PG8_BAR; }
        E(acc, cur, wr, wc, fr, fq); S.done(cur);
        if (!has_next) break;
#pragma unroll
        for (int a = 0; a < 2; ++a)
#pragma unroll
            for (int b = 0; b < 2; ++b)
#pragma unroll
                for (int m = 0; m < 4; ++m)
#pragma unroll
                    for (int n = 0; n < 2; ++n) acc[a][b][m][n] = (f32x4){0.f, 0.f, 0.f, 0.f};
        cur = nxt; cA = nA; cB = nB; ++ui;
        if constexpr (GATHER) {
#pragma unroll
            for (int h = 0; h < 2; ++h)
#pragma unroll
                for (int i = 0; i < 2; ++i) cvA[h][i] = nvA[h][i];
        }
        if constexpr (ALIGN_EPI) { if (wr == 1) PG8_BAR; }
    }
    PG8_WAIT_V(0);
    if constexpr (!ALIGN_EPI) { if (wr == 0) PG8_BAR; }
    PG8_BAR;
#undef PG8_SA
#undef PG8_SB
#undef PG8_STAGE
#undef PG8_LDA
#undef PG8_LDB
#undef PG8_MMA
#undef PG8_WAIT_V
#undef PG8_WAIT_L
#undef PG8_BAR
#undef PG8_SCHED
}
}
constexpr int NWAVES = 8;
constexpr int D = 1024, NTOK = 32768, SEQ = 4096, HTOK = 16384  , DEPTH = 2, NEXP = 16;
constexpr int PROJ = 7168, NMAIN = 6656;
constexpr float ALPHA = 1.41421356237309515f;
constexpr float LN_EPS = 1e-5f;
constexpr float LOG2E = 1.4426950408889634f;
constexpr float C2 = 0.125f * LOG2E;
constexpr int LISTCAP = 32768;

constexpr size_t MiB = 1u << 20;
constexpr size_t WS_CTL = 0, CTL_ZERO_BYTES = 1 * MiB;
constexpr size_t WS_WIN = 1 * MiB;
constexpr size_t WS_WBR = 29 * MiB;
constexpr size_t WS_WOUT = 35 * MiB;
constexpr size_t WS_WGU = 39 * MiB;
constexpr size_t WS_WDN = 103 * MiB;
constexpr size_t WS_LRUW = 135 * MiB;
constexpr size_t WS_H = 136 * MiB;
constexpr size_t WS_Y = 200 * MiB;
constexpr size_t WS_MRG = 248 * MiB;
constexpr size_t WS_ZC = 280 * MiB;
constexpr size_t WS_G = WS_ZC + 96 * MiB, WS_VT = WS_ZC + 192 * MiB;
constexpr size_t WS_SUM = 488 * MiB;
constexpr size_t WS_LIST = 280 * MiB;
constexpr size_t WS_WTS = 282 * MiB;
constexpr size_t WS_HB = 283 * MiB;
constexpr size_t WS_FFN = 351 * MiB;
constexpr size_t WS_END = 489 * MiB;
constexpr int CW_TMO = 0, CW_BAR = 4096, CW_CNT = 8192;

constexpr int RING_BYTES = 131072;
constexpr int LDSCTL_OFF = RING_BYTES, MISC_OFF = LDSCTL_OFF + 320, MOE_OFF = LDSCTL_OFF + 1024;
constexpr int LDS_BYTES = 147456;

#define GAS __attribute__((address_space(1)))
#define LAS __attribute__((address_space(3)))
typedef unsigned short bf16;
typedef unsigned v4u __attribute__((ext_vector_type(4)));
typedef unsigned v2u __attribute__((ext_vector_type(2)));
typedef float f32x4 __attribute__((ext_vector_type(4)));
typedef float f32x16 __attribute__((ext_vector_type(16)));
typedef short bf16x8 __attribute__((ext_vector_type(8)));
typedef GAS unsigned gu32;
#define RLX_AGENT __ATOMIC_RELAXED, __HIP_MEMORY_SCOPE_AGENT
#define LDS_WAIT() asm volatile("s_waitcnt lgkmcnt(0)" ::: "memory")
#define VM_WAIT() asm volatile("s_waitcnt vmcnt(0)" ::: "memory")
__device__ __forceinline__ unsigned f2bf(float f) { unsigned u = __builtin_bit_cast(unsigned, f); return (u + 0x7fffu + ((u >> 16) & 1u)) >> 16; }
__device__ __forceinline__ unsigned pk2(float lo, float hi) { return f2bf(lo) | (f2bf(hi) << 16); }
typedef float f32x2_t __attribute__((ext_vector_type(2))); typedef __bf16 bf16x2_t __attribute__((ext_vector_type(2)));
__device__ __forceinline__ unsigned cvtpk(float lo, float hi) { f32x2_t v = {lo, hi}; bf16x2_t b = __builtin_convertvector(v, bf16x2_t); return __builtin_bit_cast(unsigned, b); }
__device__ __forceinline__ float bflo(unsigned w) { return __builtin_bit_cast(float, w << 16); }
__device__ __forceinline__ float bfhi(unsigned w) { return __builtin_bit_cast(float, w & 0xffff0000u); }
__device__ __forceinline__ float bf1(bf16 b) { return __builtin_bit_cast(float, ((unsigned)b) << 16); }
__device__ __forceinline__ float fexp2(float x) { return __builtin_amdgcn_exp2f(x); }
__device__ __forceinline__ float flog2(float x) { return __builtin_amdgcn_logf(x); }
__device__ __forceinline__ float frcp(float x) { return __builtin_amdgcn_rcpf(x); }
__device__ __forceinline__ float sigmoidf_(float x) { return frcp(1.f + fexp2(-LOG2E * x)); }
__device__ __forceinline__ float wave_sum(float v) {
#pragma unroll
    for (int o = 1; o < 64; o <<= 1) v += __shfl_xor(v, o);
    return v;
}
#define XB_TMO      128
#define XB_XCNT(j)  (256  + 64 * (j))
#define XB_XSUB(j)  (1280 + 64 * (j))
#define XB_XGEN(j)  (2304 + 64 * (j))
#define XB_TOP      3328
#define XB_TOPGEN   3392
#define XCD_BAR_WORDS 3456
#define XB_SPIN_CAP (1u << 18)

__device__ __forceinline__ unsigned xb_ld(unsigned* p)              { return __hip_atomic_load(p, __ATOMIC_RELAXED, __HIP_MEMORY_SCOPE_AGENT); }
__device__ __forceinline__ unsigned xb_add(unsigned* p, unsigned v) { return __hip_atomic_fetch_add(p, v, __ATOMIC_RELAXED, __HIP_MEMORY_SCOPE_AGENT); }
__device__ __forceinline__ unsigned xb_xcc_id() { return (unsigned)__builtin_amdgcn_s_getreg((3 << 11) | 20) & 0xFu; }
#define XB_SPIN(cond, bar) do { unsigned _sp = 0; while (cond) { __builtin_amdgcn_s_sleep(1); \
    if ((++_sp & 255u) == 0u) { if (xb_ld(&(bar)[XB_TMO])) break; if (_sp > XB_SPIN_CAP) { atomicAdd(&(bar)[XB_TMO], 1u); break; } } } } while (0)

struct XcdBarrier {
    unsigned* bar; unsigned x;
    volatile LAS unsigned* st;
};

__device__ __forceinline__ XcdBarrier xcd_barrier_post(unsigned* bar, volatile LAS unsigned* st) {
    XcdBarrier b; b.bar = bar; b.x = xb_xcc_id(); b.st = st;
    if (threadIdx.x == 0) (void)xb_add(&bar[XB_XCNT(b.x)], 1u);
    return b;
}
__device__ __forceinline__ void xcd_barrier_complete(unsigned* bar, unsigned x, unsigned& nloc, unsigned& nx) {
    const unsigned G = gridDim.x * gridDim.y * gridDim.z;
    unsigned sum, cnt, mine, sp = 0u;
    for (;;) {
        sum = 0u; cnt = 0u; mine = 0u;
#pragma unroll
        for (unsigned j = 0; j < 16; ++j) { const unsigned c = xb_ld(&bar[XB_XCNT(j)]); sum += c; cnt += (c > 0u) ? 1u : 0u; mine = (j == x) ? c : mine; }
        if (sum == G) break;
        __builtin_amdgcn_s_sleep(1);
        if ((++sp & 255u) == 0u) { if (xb_ld(&bar[XB_TMO])) break; if (sp > XB_SPIN_CAP) { atomicAdd(&bar[XB_TMO], 1u); break; } }
    }
    nloc = mine > 0u ? mine : 1u; nx = cnt > 0u ? cnt : 1u;
}

__device__ __forceinline__ void xcd_barrier(const XcdBarrier& b) {
    asm volatile("s_waitcnt vmcnt(0)" ::: "memory");
    __syncthreads();
    if (threadIdx.x == 0) {
        unsigned* bar = b.bar;
        __builtin_amdgcn_s_waitcnt(0);
        unsigned nloc = b.st[0], nx = b.st[1];
        if (nloc == 0u) { xcd_barrier_complete(bar, b.x, nloc, nx); b.st[0] = nloc; b.st[1] = nx; }
        const unsigned old = xb_add(&bar[XB_XSUB(b.x)], 1u);
        const unsigned gen = old / nloc;
        if (old + 1u == (gen + 1u) * nloc) {
            __builtin_amdgcn_fence(__ATOMIC_RELEASE, "agent");
            asm volatile("s_waitcnt vmcnt(0)" ::: "memory");
            const unsigned og = xb_add(&bar[XB_TOP], 1u);
            const unsigned tg = og / nx;
            if (og + 1u == (tg + 1u) * nx) xb_add(&bar[XB_TOPGEN], 1u);
            else XB_SPIN(xb_ld(&bar[XB_TOPGEN]) == tg, bar);
            __builtin_amdgcn_fence(__ATOMIC_ACQUIRE, "agent");
            xb_add(&bar[XB_XGEN(b.x)], 1u);
            asm volatile("s_waitcnt vmcnt(0)" ::: "memory");
        } else {
            XB_SPIN(xb_ld(&bar[XB_XGEN(b.x)]) == gen, bar);
            __builtin_amdgcn_fence(__ATOMIC_ACQUIRE, "agent");
            asm volatile("s_waitcnt vmcnt(0)" ::: "memory");
        }
    }
    __syncthreads();
}
using pg8::Unit;
struct NoHooks { __device__ __forceinline__ void a_ready(const Unit&) const {} __device__ __forceinline__ void done(const Unit&) const {} };

struct InprojSched : NoHooks {
    int G, c; const char* Hh; const char* Win;
    __device__ __forceinline__ bool next(int i, Unit& u) const {
        const int L = i * G + c; if (L >= 1792) return false;
        if (L < 1664) { pg8::tile_swz(L, 64, 26, u.pm, u.pn); u.ty = 0; u.A = Hh + (size_t)u.pm * 256 * 2048; u.B = Win + (size_t)u.pn * 256 * 2048; }
        else { const int j = L - 1664; u.pm = j & 1; u.pn = j >> 1; u.ty = 1; u.A = Win + (size_t)(NMAIN + 256 * u.pm) * 2048; u.B = Hh + (size_t)u.pn * 256 * 2048; }
        u.aux = 0; u.nv = 0; u.pad = 0; return true;
    }
};
struct EpiInproj {
    static constexpr bool PERM = true;
    bf16* ZC; bf16* G0; bf16* VT; const float* gate_b;
    __device__ __forceinline__ void operator()(const pg8::f32x4 (&acc)[2][2][4][2], const Unit& u, int wr, int wc, int fr, int fq) const {
        int row0 = u.pm * 256 + wr * 64 + fr; asm volatile("" : "+v"(row0));
        if (u.ty == 0 && u.pn >= 10 && u.pn < 14) {
            bf16* base = ZC + (size_t)5 * HTOK * 512; const int col0 = (u.pn - 10) * 128 + wc * 32 + 8 * fq;
#pragma unroll
            for (int ai = 0; ai < 2; ++ai)
#pragma unroll
                for (int m = 0; m < 4; ++m) { const pg8::f32x4 v0 = acc[ai][0][m][0] * acc[ai][1][m][0], v1 = acc[ai][0][m][1] * acc[ai][1][m][1];
                    v4u w; w.x = cvtpk(v0[0], v0[1]); w.y = cvtpk(v0[2], v0[3]); w.z = cvtpk(v1[0], v1[1]); w.w = cvtpk(v1[2], v1[3]);
                    *(v4u*)(base + (size_t)(row0 + ai * 128 + m * 16) * 512 + col0) = w; }
            return;
        }
        if (u.ty == 0 && u.pn >= 14) {
            const int b = (u.pn - 14) >> 2, col0 = ((u.pn - 14) & 3) * 256 + wc * 32 + 8 * fq; bf16* base = G0 + (size_t)b * HTOK * 1024; const float* gb = gate_b + b * 1024 + col0;
            pg8::f32x4 bv[2][2];
#pragma unroll
            for (int bj = 0; bj < 2; ++bj)
#pragma unroll
                for (int n = 0; n < 2; ++n) bv[bj][n] = *(const pg8::f32x4*)(gb + bj * 128 + 4 * n);
#pragma unroll
            for (int ai = 0; ai < 2; ++ai)
#pragma unroll
                for (int m = 0; m < 4; ++m) { bf16* rowp = base + (size_t)(row0 + ai * 128 + m * 16) * 1024 + col0;
#pragma unroll
                    for (int bj = 0; bj < 2; ++bj) { pg8::f32x4 v0 = acc[ai][bj][m][0] + bv[bj][0], v1 = acc[ai][bj][m][1] + bv[bj][1];
#pragma unroll
                        for (int j = 0; j < 4; ++j) { v0[j] = sigmoidf_(v0[j]); v1[j] = sigmoidf_(v1[j]); }
                        v4u w; w.x = cvtpk(v0[0], v0[1]); w.y = cvtpk(v0[2], v0[3]); w.z = cvtpk(v1[0], v1[1]); w.w = cvtpk(v1[2], v1[3]);
                        *(v4u*)(rowp + bj * 128) = w; } }
            return;
        }
        bf16* base; int ldc, col0; float sc = 1.f;
        if (u.ty == 1) { base = VT; ldc = HTOK; col0 = u.pn * 256 + wc * 32 + 8 * fq; }
        else { const int t = u.pn >> 1; base = ZC + (size_t)t * HTOK * 512; ldc = 512; col0 = (u.pn & 1) * 256 + wc * 32 + 8 * fq; if (t == 0) sc = C2; }
#pragma unroll
        for (int ai = 0; ai < 2; ++ai)
#pragma unroll
            for (int m = 0; m < 4; ++m) { bf16* rowp = base + (size_t)(row0 + ai * 128 + m * 16) * ldc + col0;
#pragma unroll
                for (int bj = 0; bj < 2; ++bj) { const pg8::f32x4 v0 = acc[ai][bj][m][0] * sc, v1 = acc[ai][bj][m][1] * sc;
                    v4u w; w.x = cvtpk(v0[0], v0[1]); w.y = cvtpk(v0[2], v0[3]); w.z = cvtpk(v1[0], v1[1]); w.w = cvtpk(v1[2], v1[3]);
                    *(v4u*)(rowp + bj * 128) = w; } }
    }
};

struct BranchSched : NoHooks {
    int G, c; const char* Y; const char* WBR;
    __device__ __forceinline__ bool next(int i, Unit& u) const {
        const int tile = (i / 3) * G + c, b = i % 3; if (tile >= 256) return false;
        pg8::tile_swz(tile, 64, 4, u.pm, u.pn); u.ty = b; u.aux = 0; u.nv = 0; u.pad = 0;
        u.A = Y + ((size_t)u.pm * 256 * 1536 + b * 512) * 2; u.B = WBR + ((size_t)u.pn * 256 * 1536 + b * 512) * 2; return true;
    }
};
struct EpiBranch {
    static constexpr bool PERM = true;
    const bf16* G0; bf16* MRG;
    __device__ __forceinline__ void operator()(const pg8::f32x4 (&acc)[2][2][4][2], const Unit& u, int wr, int wc, int fr, int fq) const {
        int row0 = u.pm * 256 + wr * 64 + fr; asm volatile("" : "+v"(row0)); const int col0 = u.pn * 256 + wc * 32 + 8 * fq; const bf16* gp = G0 + (size_t)u.ty * HTOK * 1024;
#pragma unroll
        for (int ai = 0; ai < 2; ++ai)
#pragma unroll
            for (int m = 0; m < 4; ++m) { const size_t off = (size_t)(row0 + ai * 128 + m * 16) * 1024 + col0;
#pragma unroll
                for (int bj = 0; bj < 2; ++bj) { const v4u gw = *(const v4u*)(gp + off + bj * 128); v4u ow = (v4u){0u, 0u, 0u, 0u}; if (u.ty != 0) ow = *(const v4u*)(MRG + off + bj * 128);
                    const pg8::f32x4 a0 = acc[ai][bj][m][0], a1 = acc[ai][bj][m][1]; v4u w;
                    w.x = cvtpk(bflo(ow.x) + bflo(gw.x) * a0[0], bfhi(ow.x) + bfhi(gw.x) * a0[1]); w.y = cvtpk(bflo(ow.y) + bflo(gw.y) * a0[2], bfhi(ow.y) + bfhi(gw.y) * a0[3]);
                    w.z = cvtpk(bflo(ow.z) + bflo(gw.z) * a1[0], bfhi(ow.z) + bfhi(gw.z) * a1[1]); w.w = cvtpk(bflo(ow.w) + bflo(gw.w) * a1[2], bfhi(ow.w) + bfhi(gw.w) * a1[3]);
                    *(v4u*)(MRG + off + bj * 128) = w; }
                asm volatile("" ::: "memory"); }
    }
};

struct PlainSched : NoHooks {
    int G, c, nM, nN; const char* A; const char* B; size_t astep, bstep;
    __device__ __forceinline__ bool next(int i, Unit& u) const {
        const int L = i * G + c; if (L >= nM * nN) return false;
        pg8::tile_swz(L, nM, nN, u.pm, u.pn); u.ty = 0; u.aux = 0; u.nv = 0; u.pad = 0; u.A = A + (size_t)u.pm * astep; u.B = B + (size_t)u.pn * bstep; return true;
    }
};
struct EpiOutproj {
    static constexpr bool PERM = true;
    bf16* Hh;
    __device__ __forceinline__ void operator()(const pg8::f32x4 (&acc)[2][2][4][2], const Unit& u, int wr, int wc, int fr, int fq) const {
        int row0 = u.pm * 256 + wr * 64 + fr; asm volatile("" : "+v"(row0)); const int col0 = u.pn * 256 + wc * 32 + 8 * fq;
#pragma unroll
        for (int ai = 0; ai < 2; ++ai)
#pragma unroll
            for (int m = 0; m < 4; ++m) { bf16* rowp = Hh + (size_t)(row0 + ai * 128 + m * 16) * 1024 + col0;
#pragma unroll
                for (int bj = 0; bj < 2; ++bj) { const v4u ow = *(const v4u*)(rowp + bj * 128); const pg8::f32x4 a0 = acc[ai][bj][m][0], a1 = acc[ai][bj][m][1]; v4u w;
                    w.x = cvtpk(ALPHA * bflo(ow.x) + a0[0], ALPHA * bfhi(ow.x) + a0[1]); w.y = cvtpk(ALPHA * bflo(ow.y) + a0[2], ALPHA * bfhi(ow.y) + a0[3]);
                    w.z = cvtpk(ALPHA * bflo(ow.z) + a1[0], ALPHA * bfhi(ow.z) + a1[1]); w.w = cvtpk(ALPHA * bflo(ow.w) + a1[2], ALPHA * bfhi(ow.w) + a1[3]);
                    *(v4u*)(rowp + bj * 128) = w; }
                asm volatile("" ::: "memory"); }
    }
};

struct MoeSched : NoHooks {
    int G, c; const LAS int* tab; const char* Abase; size_t atile; const char* Wbase; size_t wstride, bstep; const unsigned* list;
    __device__ __forceinline__ bool next(int i, Unit& u) const {
        const int L = i * G + c, NT = tab[16]; if (L >= NT * 4) return false;
        const int rt = L >> 2; int e = 0;
#pragma unroll 1
        while (e < 15 && rt >= tab[e + 1]) ++e;
        const int j = rt - tab[e];
        u.pm = rt; u.pn = L & 3; u.ty = e; u.aux = e * LISTCAP + j * 256; u.nv = tab[17 + e] - j * 256; u.pad = 0;
        u.A = Abase + (size_t)rt * atile; u.B = Wbase + (size_t)e * wstride + (size_t)u.pn * bstep; return true;
    }
    __device__ __forceinline__ int arow(const Unit& u, int r) const { return r < u.nv ? (int)(list[u.aux + r] >> 1) : 0; }
};
struct EpiGateUp {
    static constexpr bool PERM = true;
    bf16* HB;
    __device__ __forceinline__ void operator()(const pg8::f32x4 (&acc)[2][2][4][2], const Unit& u, int wr, int wc, int fr, int fq) const {
        int row0 = u.pm * 256 + wr * 64 + fr; asm volatile("" : "+v"(row0)); const int col0 = u.pn * 128 + wc * 32 + 8 * fq;
#pragma unroll
        for (int ai = 0; ai < 2; ++ai)
#pragma unroll
            for (int m = 0; m < 4; ++m) { pg8::f32x4 v0, v1;
#pragma unroll
                for (int j = 0; j < 4; ++j) { const float g0 = acc[ai][0][m][0][j], g1 = acc[ai][0][m][1][j]; v0[j] = g0 * sigmoidf_(g0) * acc[ai][1][m][0][j]; v1[j] = g1 * sigmoidf_(g1) * acc[ai][1][m][1][j]; }
                v4u w; w.x = cvtpk(v0[0], v0[1]); w.y = cvtpk(v0[2], v0[3]); w.z = cvtpk(v1[0], v1[1]); w.w = cvtpk(v1[2], v1[3]);
                *(v4u*)(HB + (size_t)(row0 + ai * 128 + m * 16) * 512 + col0) = w; }
    }
};
struct EpiDown {
    static constexpr bool PERM = true;
    bf16* FFN; const unsigned* list;
    __device__ __forceinline__ void operator()(const pg8::f32x4 (&acc)[2][2][4][2], const Unit& u, int wr, int wc, int fr, int fq) const {
        int r0 = wr * 64 + fr; asm volatile("" : "+v"(r0)); const int col0 = u.pn * 256 + wc * 32 + 8 * fq;
#pragma unroll
        for (int ai = 0; ai < 2; ++ai)
#pragma unroll
            for (int m = 0; m < 4; ++m) { const int r = r0 + ai * 128 + m * 16;
                if (r < u.nv) { const unsigned ent = list[u.aux + r]; bf16* rowp = FFN + ((size_t)(ent & 1u) * NTOK + (ent >> 1)) * 1024 + col0;
#pragma unroll
                    for (int bj = 0; bj < 2; ++bj) { const pg8::f32x4 v0 = acc[ai][bj][m][0], v1 = acc[ai][bj][m][1];
                        v4u w; w.x = cvtpk(v0[0], v0[1]); w.y = cvtpk(v0[2], v0[3]); w.z = cvtpk(v1[0], v1[1]); w.w = cvtpk(v1[2], v1[3]);
                        *(v4u*)(rowp + bj * 128) = w; } } }
    }
};

__device__ __forceinline__ void tr_item(const float* W, int N, int k0, int n0, bf16* dst, size_t drow0, int dpitch, int dk0, LAS float* scr, int lane) {
#pragma unroll 8
    for (int i = 0; i < 32; ++i) { const int kk = 2 * i + (lane >> 5); scr[kk * 33 + (lane & 31)] = W[(size_t)(k0 + kk) * N + n0 + (lane & 31)]; }
    LDS_WAIT(); asm volatile("" ::: "memory");
    const int c = lane & 7;
#pragma unroll
    for (int j = 0; j < 4; ++j) { const int n = (lane >> 3) + 8 * j; const LAS float* s = scr + (8 * c) * 33 + n;
        v4u o; o.x = pk2(s[0 * 33], s[1 * 33]); o.y = pk2(s[2 * 33], s[3 * 33]); o.z = pk2(s[4 * 33], s[5 * 33]); o.w = pk2(s[6 * 33], s[7 * 33]);
        *(v4u*)(dst + (drow0 + n) * (size_t)dpitch + dk0 + k0 + 8 * c) = o; }
    LDS_WAIT(); asm volatile("" ::: "memory");
}
__device__ __forceinline__ int map_in(int n0) {
    if (n0 < 1024) return n0;
    if (n0 < 1536) return NMAIN + (n0 - 1024);
    if (n0 < 3072) return n0 - 512;
    if (n0 < 3584) { const int c = n0 - 3072; return 2560 + (c >> 7) * 256 + (c & 127); }
    if (n0 < 4096) { const int c = n0 - 3584; return 2560 + (c >> 7) * 256 + 128 + (c & 127); }
    return n0 - 512;
}
struct Args { const float* in[28]; float* out; unsigned char* ws; };
typedef const __attribute__((address_space(4))) unsigned long long* KP;
struct KA { KP kp;
    __device__ __forceinline__ const float* in(int k) const { return (const float*)(const GAS float*)kp[k]; }
    __device__ __forceinline__ float* out() const { return (float*)(GAS float*)kp[28]; }
    __device__ __forceinline__ unsigned char* ws() const { return (unsigned char*)(GAS unsigned char*)kp[29]; } };

__device__ __forceinline__ void p0_prologue(const KA& a, LAS unsigned char* lds, int gw, int NGW, int wave, int lane) {
    LAS float* scr = (LAS float*)(lds + wave * 16384);
    unsigned char* ws = a.ws();
    constexpr int I_IN = 16 * 224, I_BR = 8 * 32, I_OUT = 16 * 32, I_G = 16 * 16, I_DN = 8 * 32, I_LRU = 2;
    constexpr int PER_LAYER = I_IN + 3 * I_BR + I_OUT + 16 * (2 * I_G + I_DN) + 32;
    for (int it = gw; it < DEPTH * PER_LAYER; it += NGW) {
        const int l = it / PER_LAYER; int r = it % PER_LAYER;
        if (r < I_IN) { const int kb = r / 224, nb = r % 224; tr_item(a.in(3) + (size_t)l * 1024 * PROJ, PROJ, 64 * kb, 32 * nb, (bf16*)(ws + WS_WIN) + (size_t)l * PROJ * 1024, (size_t)map_in(32 * nb), 1024, 0, scr, lane); continue; } r -= I_IN;
        if (r < 3 * I_BR) { const int b = r / I_BR, q = r % I_BR, kb = q / 32, nb = q % 32; tr_item(a.in(13 + b) + (size_t)l * 512 * 1024, 1024, 64 * kb, 32 * nb, (bf16*)(ws + WS_WBR) + (size_t)l * 1024 * 1536, (size_t)(32 * nb), 1536, b * 512, scr, lane); continue; } r -= 3 * I_BR;
        if (r < I_OUT) { const int kb = r / 32, nb = r % 32; tr_item(a.in(16) + (size_t)l * 1024 * 1024, 1024, 64 * kb, 32 * nb, (bf16*)(ws + WS_WOUT) + (size_t)l * 1024 * 1024, (size_t)(32 * nb), 1024, 0, scr, lane); continue; } r -= I_OUT;
        if (r < 16 * (2 * I_G + I_DN)) { const int e = r / (2 * I_G + I_DN); int q = r % (2 * I_G + I_DN);
            if (q < 2 * I_G) { const int up = q / I_G; q %= I_G; const int kb = q / 16, nb = q % 16, n0 = 32 * nb;
                tr_item(a.in(23 + up) + ((size_t)l * NEXP + e) * 1024 * 512, 512, 64 * kb, n0, (bf16*)(ws + WS_WGU) + ((size_t)l * NEXP + e) * 1024 * 1024, (size_t)((n0 >> 7) * 256 + up * 128 + (n0 & 127)), 1024, 0, scr, lane); }
            else { q -= 2 * I_G; const int kb = q / 32, nb = q % 32; tr_item(a.in(25) + ((size_t)l * NEXP + e) * 512 * 1024, 1024, 64 * kb, 32 * nb, (bf16*)(ws + WS_WDN) + ((size_t)l * NEXP + e) * 1024 * 512, (size_t)(32 * nb), 512, 0, scr, lane); }
            continue; } r -= 16 * (2 * I_G + I_DN);
        { const int gsel = r / 16, hd = (r % 16) / 2, nb = r % 2;
          tr_item(a.in(gsel ? 9 : 7) + ((size_t)l * 8 + hd) * 4096, 64, 0, 32 * nb, (bf16*)(ws + WS_LRUW) + (((size_t)l * 2 + gsel) * 8 + hd) * 4096, (size_t)(32 * nb), 64, 0, scr, lane); }
    }
    const float* gam = a.in(1); const float* bet = a.in(2); bf16* H = (bf16*)(ws + WS_H);
    for (int m = gw; m < NTOK; m += NGW) {
        const f32x4* xr = (const f32x4*)(a.in(0) + (size_t)m * D) + lane;
        f32x4 v[4]; float s = 0.f;
#pragma unroll
        for (int j = 0; j < 4; ++j) { v[j] = xr[64 * j]; s += (v[j].x + v[j].y) + (v[j].z + v[j].w); }
        const float mean = wave_sum(s) * (1.f / D); float s2 = 0.f;
#pragma unroll
        for (int j = 0; j < 4; ++j) { v[j] = v[j] - mean; s2 += (v[j].x * v[j].x + v[j].y * v[j].y) + (v[j].z * v[j].z + v[j].w * v[j].w); }
        const float rstd = 1.f / sqrtf(wave_sum(s2) * (1.f / D) + LN_EPS);
        unsigned long long* o8 = (unsigned long long*)(H + (size_t)m * D) + lane;
#pragma unroll
        for (int j = 0; j < 4; ++j) { const f32x4 g4 = ((const f32x4*)gam)[lane + 64 * j], b4 = ((const f32x4*)bet)[lane + 64 * j]; const f32x4 y = v[j] * rstd * g4 + b4;
            o8[64 * j] = (unsigned long long)pk2(y.x, y.y) | ((unsigned long long)pk2(y.z, y.w) << 32); }
    }
}

#define MFMA32(a, b, c) __builtin_amdgcn_mfma_f32_32x32x16_bf16((a), (b), (c), 0, 0, 0)
__device__ __forceinline__ int crow(int r, int hi) { return (r & 3) + 8 * (r >> 2) + 4 * hi; }
__device__ __forceinline__ bf16x8 pack8(const f32x16& x, int s) {
    v4u p; p.x = cvtpk(x[8 * s], x[8 * s + 1]); p.y = cvtpk(x[8 * s + 2], x[8 * s + 3]); p.z = cvtpk(x[8 * s + 4], x[8 * s + 5]); p.w = cvtpk(x[8 * s + 6], x[8 * s + 7]);
    return __builtin_bit_cast(bf16x8, p);
}
__device__ __forceinline__ float softplus2(float z) { return fmaxf(z, 0.f) + flog2(1.f + fexp2(-fabsf(z))); }

template <bool DIAG>
__device__ __forceinline__ bool sb_tile(const bf16* __restrict__ Kb, const bf16* __restrict__ VT, const bf16x8 (&qf)[4], const bf16x8 (&tri)[2], bf16x8 mones,
                                        f32x16& o0, f32x16& o1, float& carry, int seq0, int k0, int t0, int hd, int l32, int hi) {
    const bf16* kp = Kb + (size_t)(seq0 + k0 + l32) * 512 + hd * 64 + 8 * hi;
    f32x16 s0, s1;
#pragma unroll
    for (int r = 0; r < 16; ++r) { s0[r] = 0.f; s1[r] = 0.f; }
#pragma unroll
    for (int i = 0; i < 4; ++i) { const bf16x8 ka = *(const bf16x8*)(kp + 16 * i), kb = *(const bf16x8*)(kp + 32 * 512 + 16 * i); s0 = MFMA32(ka, qf[i], s0); s1 = MFMA32(kb, qf[i], s1); }
    const float z00 = s0[0];
    f32x16 p0, p1;
#pragma unroll
    for (int r = 0; r < 16; ++r) {
        float a = softplus2(s0[r]), b = softplus2(s1[r]);
        if (DIAG) { const int key = k0 + crow(r, hi), q = t0 + l32; if (key >= q) a = 0.f; if (key + 32 >= q) b = 0.f; }
        p0[r] = a; p1[r] = b;
    }
    const bf16x8 L0a = pack8(p0, 0), L0b = pack8(p0, 1), L1a = pack8(p1, 0), L1b = pack8(p1, 1);
#pragma unroll
    for (int r = 0; r < 16; ++r) { s0[r] -= carry; s1[r] -= carry; }
    s0 = MFMA32(tri[0], L0a, s0); s0 = MFMA32(tri[1], L0b, s0); s0 = MFMA32(mones, L1a, s0); s0 = MFMA32(mones, L1b, s0);
    s1 = MFMA32(tri[0], L1a, s1); s1 = MFMA32(tri[1], L1b, s1);
    float tot = (z00 - carry) - s0[0];
    tot = __shfl(tot, l32);
#pragma unroll
    for (int r = 0; r < 16; ++r) {
        float a = fexp2(s0[r]), b = fexp2(s1[r]);
        if (DIAG) { const int key = k0 + crow(r, hi), q = t0 + l32; if (key >= q) a = 0.f; if (key + 32 >= q) b = 0.f; }
        p0[r] = a; p1[r] = b;
    }
    carry += tot;
    const bf16x8 P0a = pack8(p0, 0), P0b = pack8(p0, 1), P1a = pack8(p1, 0), P1b = pack8(p1, 1);
    const bf16* vp = VT + (size_t)(hd * 64 + l32) * HTOK + seq0 + k0 + 4 * hi;
#pragma unroll
    for (int db = 0; db < 2; ++db) {
        const bf16* vq = vp + (size_t)db * 32 * HTOK;
        v4u a00, a01, a10, a11;
        { const v2u lo = *(const v2u*)(vq), hi8 = *(const v2u*)(vq + 8); a00 = (v4u){lo.x, lo.y, hi8.x, hi8.y}; }
        { const v2u lo = *(const v2u*)(vq + 16), hi8 = *(const v2u*)(vq + 24); a01 = (v4u){lo.x, lo.y, hi8.x, hi8.y}; }
        { const v2u lo = *(const v2u*)(vq + 32), hi8 = *(const v2u*)(vq + 40); a10 = (v4u){lo.x, lo.y, hi8.x, hi8.y}; }
        { const v2u lo = *(const v2u*)(vq + 48), hi8 = *(const v2u*)(vq + 56); a11 = (v4u){lo.x, lo.y, hi8.x, hi8.y}; }
        f32x16 o = db ? o1 : o0;
        o = MFMA32(__builtin_bit_cast(bf16x8, a00), P0a, o); o = MFMA32(__builtin_bit_cast(bf16x8, a01), P0b, o);
        o = MFMA32(__builtin_bit_cast(bf16x8, a10), P1a, o); o = MFMA32(__builtin_bit_cast(bf16x8, a11), P1b, o);
        if (db) o1 = o; else o0 = o;
    }
    return __all(carry > 150.f) != 0;
}
__device__ __forceinline__ void sb_attn_task(const bf16* __restrict__ Q, const bf16* __restrict__ Kb, const bf16* __restrict__ VT, bf16* Y, int b, int hd, int qb, int lane) {
    const int l32 = lane & 31, hi = lane >> 5, seq0 = b * SEQ, t0 = qb * 32;
    bf16x8 qf[4];
    { const bf16* qp = Q + (size_t)(seq0 + t0 + l32) * 512 + hd * 64 + 8 * hi;
#pragma unroll
      for (int i = 0; i < 4; ++i) qf[i] = *(const bf16x8*)(qp + 16 * i); }
    bf16x8 tri[2], mones;
#pragma unroll
    for (int i2 = 0; i2 < 2; ++i2)
#pragma unroll
        for (int j = 0; j < 8; ++j) { const int koff = 16 * i2 + 8 * (j >> 2) + 4 * hi + (j & 3); tri[i2][j] = (koff >= l32) ? (short)0xBF80 : (short)0; }
#pragma unroll
    for (int j = 0; j < 8; ++j) mones[j] = (short)0xBF80;
    f32x16 o0, o1;
#pragma unroll
    for (int r = 0; r < 16; ++r) { o0[r] = 0.f; o1[r] = 0.f; }
    float carry = 0.f;
    const int ktd = t0 >> 6;
    bool done = sb_tile<true>(Kb, VT, qf, tri, mones, o0, o1, carry, seq0, ktd * 64, t0, hd, l32, hi);
#pragma unroll 1
    for (int kt = ktd - 1; kt >= 0 && !done; --kt) done = sb_tile<false>(Kb, VT, qf, tri, mones, o0, o1, carry, seq0, kt * 64, t0, hd, l32, hi);
    bf16* yp = Y + (size_t)(seq0 + t0 + l32) * 1536 + hd * 64 + 4 * hi;
#pragma unroll
    for (int g = 0; g < 4; ++g) {
        *(v2u*)(yp + 8 * g) = (v2u){cvtpk(o0[4 * g], o0[4 * g + 1]), cvtpk(o0[4 * g + 2], o0[4 * g + 3])};
        *(v2u*)(yp + 32 + 8 * g) = (v2u){cvtpk(o1[4 * g], o1[4 * g + 1]), cvtpk(o1[4 * g + 2], o1[4 * g + 3])};
    }
}

__device__ __forceinline__ void lru_local_task(const KA& a, int l, const bf16* __restrict__ LI, bf16* HLOC, bf16* CUMA, float* SUMA, float* SUMH, const bf16* __restrict__ LW,
                                               LAS bf16* U, int b, int ch, int hd, int lane) {
    const int seq0 = b * SEQ, t0 = ch * 64;
    { const int co = lane & 7, sub = lane >> 3, c0 = hd * 64 + co * 8;
      const float* cw = a.in(5) + (size_t)l * 4 * 512 + c0; const float* cb = a.in(6) + (size_t)l * 512 + c0;
      float w[4][8], bias[8];
#pragma unroll
      for (int k = 0; k < 4; ++k) { const f32x4 x0 = *(const f32x4*)(cw + k * 512), x1 = *(const f32x4*)(cw + k * 512 + 4);
          w[k][0] = x0.x; w[k][1] = x0.y; w[k][2] = x0.z; w[k][3] = x0.w; w[k][4] = x1.x; w[k][5] = x1.y; w[k][6] = x1.z; w[k][7] = x1.w; }
      { const f32x4 x0 = *(const f32x4*)(cb), x1 = *(const f32x4*)(cb + 4); bias[0] = x0.x; bias[1] = x0.y; bias[2] = x0.z; bias[3] = x0.w; bias[4] = x1.x; bias[5] = x1.y; bias[6] = x1.z; bias[7] = x1.w; }
#pragma unroll 2
      for (int it = 0; it < 8; ++it) { const int tl = it * 8 + sub, t = t0 + tl; float u[8];
#pragma unroll
          for (int j = 0; j < 8; ++j) u[j] = bias[j];
#pragma unroll
          for (int k = 0; k < 4; ++k) { const int tt = t - 3 + k; if (tt >= 0) { const v4u x = *(const v4u*)(LI + (size_t)(seq0 + tt) * 512 + c0);
              u[0] += w[k][0] * bflo(x.x); u[1] += w[k][1] * bfhi(x.x); u[2] += w[k][2] * bflo(x.y); u[3] += w[k][3] * bfhi(x.y);
              u[4] += w[k][4] * bflo(x.z); u[5] += w[k][5] * bfhi(x.z); u[6] += w[k][6] * bflo(x.w); u[7] += w[k][7] * bfhi(x.w); } }
          *(LAS v4u*)(U + tl * 72 + co * 8) = (v4u){pk2(u[0], u[1]), pk2(u[2], u[3]), pk2(u[4], u[5]), pk2(u[6], u[7])}; }
      LDS_WAIT(); asm volatile("" ::: "memory"); }
    const int l32 = lane & 31, hi = lane >> 5;
    bf16x8 af[2][4];
#pragma unroll
    for (int mb = 0; mb < 2; ++mb)
#pragma unroll
        for (int ks = 0; ks < 4; ++ks) af[mb][ks] = *(const LAS bf16x8*)(U + (mb * 32 + l32) * 72 + 16 * ks + 8 * hi);
    float Hrun = 0.f, Arun = 1.f;
#pragma unroll 1
    for (int nb = 0; nb < 2; ++nb) {
        const int chn = hd * 64 + nb * 32 + l32;
        const bf16* wa = LW + ((size_t)(l * 2 + 0) * 8 + hd) * 4096 + (nb * 32 + l32) * 64 + 8 * hi;
        const bf16* wx = LW + ((size_t)(l * 2 + 1) * 8 + hd) * 4096 + (nb * 32 + l32) * 64 + 8 * hi;
        f32x16 da[2], dx[2];
#pragma unroll
        for (int mb = 0; mb < 2; ++mb)
#pragma unroll
            for (int r = 0; r < 16; ++r) { da[mb][r] = 0.f; dx[mb][r] = 0.f; }
#pragma unroll
        for (int ks = 0; ks < 4; ++ks) { const bf16x8 ba = *(const bf16x8*)(wa + 16 * ks), bx = *(const bf16x8*)(wx + 16 * ks);
#pragma unroll
            for (int mb = 0; mb < 2; ++mb) { da[mb] = MFMA32(af[mb][ks], ba, da[mb]); dx[mb] = MFMA32(af[mb][ks], bx, dx[mb]); } }
        const float b_a = a.in(8)[l * 512 + chn], b_x = a.in(10)[l * 512 + chn], lam = a.in(11)[l * 512 + chn];
        const float c8 = -8.f * (fmaxf(-lam, 0.f) + log1pf(__expf(-fabsf(lam)))) * LOG2E;
        Hrun = 0.f; Arun = 1.f;
#pragma unroll
        for (int mb = 0; mb < 2; ++mb) {
            float hl[16], cA[16], gA[4], gB[4];
#pragma unroll
            for (int g = 0; g < 4; ++g) { float h = 0.f, A = 1.f;
#pragma unroll
                for (int j = 0; j < 4; ++j) { const int r = 4 * g + j, tl = mb * 32 + crow(r, hi);
                    const float ra = sigmoidf_(da[mb][r] + b_a), ix = sigmoidf_(dx[mb][r] + b_x);
                    const float la2 = c8 * ra, av = fexp2(la2), mult = sqrtf(fmaxf(1.f - fexp2(2.f * la2), 0.f));
                    const float uv = bf1(U[tl * 72 + nb * 32 + l32]);
                    const float dr = mult * ix * uv;
                    h = av * h + dr; A *= av; hl[r] = h; cA[r] = A; }
                gA[g] = A; gB[g] = h; }
#pragma unroll
            for (int g = 0; g < 4; ++g) {
                const float pA = __shfl_xor(gA[g], 32), pB = __shfl_xor(gB[g], 32);
                const float A0 = hi ? pA : gA[g], B0 = hi ? pB : gB[g], A1 = hi ? gA[g] : pA, B1 = hi ? gB[g] : pB;
                const float in0 = Hrun, inA0 = Arun; Hrun = A0 * Hrun + B0; Arun *= A0;
                const float in1 = Hrun, inA1 = Arun; Hrun = A1 * Hrun + B1; Arun *= A1;
                const float my_in = hi ? in1 : in0, my_inA = hi ? inA1 : inA0;
#pragma unroll
                for (int j = 0; j < 4; ++j) { const int r = 4 * g + j, tl = mb * 32 + crow(r, hi); const size_t o = (size_t)(seq0 + t0 + tl) * 512 + chn;
                    HLOC[o] = (bf16)f2bf(hl[r] + cA[r] * my_in); CUMA[o] = (bf16)f2bf(cA[r] * my_inA); }
            }
        }
        if (hi == 0) { const size_t so = ((size_t)b * 64 + ch) * 512 + chn; SUMA[so] = Arun; SUMH[so] = Hrun; }
    }
    LDS_WAIT(); asm volatile("" ::: "memory");
}
__device__ __forceinline__ void sc_pass(const KA& a, int l, const bf16* __restrict__ SB, const bf16* __restrict__ P, bf16* Y, int gt, int ngt) {
    const float* cw = a.in(12) + (size_t)l * 3 * 512;
    for (int it = gt; it < HTOK * 64; it += ngt) {
        const int row = it >> 6, c0 = (it & 63) * 8, t = row & (SEQ - 1);
        const v4u sb = *(const v4u*)(SB + (size_t)row * 512 + c0), p2 = *(const v4u*)(P + (size_t)row * 512 + c0);
        v4u p1 = (v4u){0u, 0u, 0u, 0u}, p0 = (v4u){0u, 0u, 0u, 0u};
        if (t >= 1) p1 = *(const v4u*)(P + (size_t)(row - 1) * 512 + c0);
        if (t >= 2) p0 = *(const v4u*)(P + (size_t)(row - 2) * 512 + c0);
        float w0[8], w1[8], w2[8];
#pragma unroll
        for (int h = 0; h < 2; ++h) { const f32x4 x0 = *(const f32x4*)(cw + c0 + 4 * h), x1 = *(const f32x4*)(cw + 512 + c0 + 4 * h), x2 = *(const f32x4*)(cw + 1024 + c0 + 4 * h);
#pragma unroll
            for (int j = 0; j < 4; ++j) { w0[4 * h + j] = x0[j]; w1[4 * h + j] = x1[j]; w2[4 * h + j] = x2[j]; } }
        const unsigned s_[4] = {sb.x, sb.y, sb.z, sb.w}, q0[4] = {p0.x, p0.y, p0.z, p0.w}, q1[4] = {p1.x, p1.y, p1.z, p1.w}, q2[4] = {p2.x, p2.y, p2.z, p2.w};
        unsigned o[4];
#pragma unroll
        for (int j = 0; j < 4; ++j) { const float lo = bflo(s_[j]) * (w0[2 * j] * bflo(q0[j]) + w1[2 * j] * bflo(q1[j]) + w2[2 * j] * bflo(q2[j]));
            const float hi = bfhi(s_[j]) * (w0[2 * j + 1] * bfhi(q0[j]) + w1[2 * j + 1] * bfhi(q1[j]) + w2[2 * j + 1] * bfhi(q2[j])); o[j] = cvtpk(lo, hi); }
        *(v4u*)(Y + (size_t)row * 1536 + 1024 + c0) = (v4u){o[0], o[1], o[2], o[3]};
    }
}
__device__ __forceinline__ void lru_fix_task(const bf16* __restrict__ LG, const bf16* __restrict__ HLOC, const bf16* __restrict__ CUMA, const float* __restrict__ SUMA, const float* __restrict__ SUMH,
                                             bf16* Y, int b, int ch, int tid) {
    float carry = 0.f;
    for (int c = 0; c < ch; ++c) { const size_t so = ((size_t)b * 64 + c) * 512 + tid; carry = SUMA[so] * carry + SUMH[so]; }
    const size_t r0 = (size_t)b * SEQ + ch * 64;
#pragma unroll 4
    for (int t = 0; t < 64; ++t) { const size_t o = (r0 + t) * 512 + tid; const float x = bf1(LG[o]), h = bf1(HLOC[o]) + bf1(CUMA[o]) * carry;
        const float y2 = 2.f * 0.7978845608028654f * (x + 0.044715f * x * x * x);
        Y[(r0 + t) * 1536 + 512 + tid] = (bf16)f2bf(x * sigmoidf_(y2) * h); }
}

__device__ __forceinline__ void ln16(float (&v)[16], const float* gam, const float* bet, int lane) {
    float s = 0.f;
#pragma unroll
    for (int j = 0; j < 16; ++j) s += v[j];
    const float mean = wave_sum(s) * (1.f / D); float s2 = 0.f;
#pragma unroll
    for (int j = 0; j < 16; ++j) { v[j] -= mean; s2 += v[j] * v[j]; }
    const float rstd = 1.f / sqrtf(wave_sum(s2) * (1.f / D) + LN_EPS);
#pragma unroll
    for (int h = 0; h < 2; ++h)
#pragma unroll
        for (int q = 0; q < 2; ++q) { const f32x4 g4 = *(const f32x4*)(gam + 512 * h + 8 * lane + 4 * q), b4 = *(const f32x4*)(bet + 512 * h + 8 * lane + 4 * q);
#pragma unroll
            for (int j = 0; j < 4; ++j) v[8 * h + 4 * q + j] = v[8 * h + 4 * q + j] * rstd * g4[j] + b4[j]; }
}
__device__ __forceinline__ void unpack8(const v4u w, float* v) { v[0] = bflo(w.x); v[1] = bfhi(w.x); v[2] = bflo(w.y); v[3] = bfhi(w.y); v[4] = bflo(w.z); v[5] = bfhi(w.z); v[6] = bflo(w.w); v[7] = bfhi(w.w); }
__device__ __forceinline__ v4u pack8f(const float* v) { return (v4u){cvtpk(v[0], v[1]), cvtpk(v[2], v[3]), cvtpk(v[4], v[5]), cvtpk(v[6], v[7])}; }

__device__ __forceinline__ void p6_ln1_router(const KA& a, int l, LAS unsigned char* lds, int G, int tid, int wave, int lane) {
    unsigned char* ws = a.ws(); bf16* H = (bf16*)(ws + WS_H); float* WTS = (float*)(ws + WS_WTS); unsigned* LIST = (unsigned*)(ws + WS_LIST); gu32* ctl = (gu32*)(ws + WS_CTL);
    LAS float* RW = (LAS float*)lds;
    LAS int* ENT = (LAS int*)(lds + 81920);
    LAS int* RANK = ENT + 256;
    LAS unsigned* LCNT = (LAS unsigned*)(RANK + 256);
    LAS unsigned* LBASE = LCNT + 16;
    { const float* wg = a.in(19) + (size_t)l * 1024 * 4; const float* we = a.in(21) + (size_t)l * 1024 * 16;
      for (int i = tid; i < 1024 * 4; i += 512) RW[(i & 3) * 1024 + (i >> 2)] = wg[i];
      for (int i = tid; i < 1024 * 16; i += 512) RW[(4 + (i & 15)) * 1024 + (i >> 4)] = we[i]; }
    __syncthreads();
    const float* gam = a.in(17) + l * D; const float* bet = a.in(18) + l * D; const float* gbias = a.in(20) + l * 4; const float* ebias = a.in(22) + l * 16;
    for (int rb = blockIdx.x; rb < NTOK / 128; rb += G) {
        if (tid < 16) LCNT[tid] = 0u;
        for (int rr = 0; rr < 16; ++rr) {
            const int rl = wave * 16 + rr, row = rb * 128 + rl;
            bf16* hp = H + (size_t)row * D; float v[16];
            unpack8(*(const v4u*)(hp + 8 * lane), v); unpack8(*(const v4u*)(hp + 512 + 8 * lane), v + 8);
            ln16(v, gam, bet, lane);
            *(v4u*)(hp + 8 * lane) = pack8f(v); *(v4u*)(hp + 512 + 8 * lane) = pack8f(v + 8);
            float lg[20];
#pragma unroll
            for (int o = 0; o < 20; ++o) { const LAS float* w = RW + o * 1024 + 8 * lane; float s = 0.f;
#pragma unroll
                for (int h = 0; h < 2; ++h) { const f32x4 w0 = *(const LAS f32x4*)(w + 512 * h), w1 = *(const LAS f32x4*)(w + 512 * h + 4);
                    s += v[8 * h] * w0.x + v[8 * h + 1] * w0.y + v[8 * h + 2] * w0.z + v[8 * h + 3] * w0.w + v[8 * h + 4] * w1.x + v[8 * h + 5] * w1.y + v[8 * h + 6] * w1.z + v[8 * h + 7] * w1.w; }
                lg[o] = wave_sum(s); }
            int gs = 0; float bestg = lg[0] + gbias[0];
#pragma unroll
            for (int g = 1; g < 4; ++g) { const float x = lg[g] + gbias[g]; if (x > bestg) { bestg = x; gs = g; } }
            const float gmax = fmaxf(fmaxf(lg[0], lg[1]), fmaxf(lg[2], lg[3]));
            float gden = 0.f, gnum = 0.f;
#pragma unroll
            for (int g = 0; g < 4; ++g) { const float e = __expf(lg[g] - gmax); gden += e; gnum = (g == gs) ? e : gnum; }
            const float gprob = gnum / gden;
            float ein[4], eb[4];
#pragma unroll
            for (int i = 0; i < 4; ++i) { ein[i] = gs == 0 ? lg[4 + i] : gs == 1 ? lg[8 + i] : gs == 2 ? lg[12 + i] : lg[16 + i]; eb[i] = ein[i] + ebias[gs * 4 + i]; }
            int i0 = 0; float b0 = eb[0];
#pragma unroll
            for (int i = 1; i < 4; ++i) if (eb[i] > b0) { b0 = eb[i]; i0 = i; }
            int i1 = -1; float b1 = 0.f;
#pragma unroll
            for (int i = 0; i < 4; ++i) if (i != i0 && (i1 < 0 || eb[i] > b1)) { b1 = eb[i]; i1 = i; }
            const float x0 = i0 == 0 ? ein[0] : i0 == 1 ? ein[1] : i0 == 2 ? ein[2] : ein[3], x1 = i1 == 0 ? ein[0] : i1 == 1 ? ein[1] : i1 == 2 ? ein[2] : ein[3];
            const float mx = fmaxf(x0, x1), e0 = __expf(x0 - mx), e1 = __expf(x1 - mx), inv = gprob / (e0 + e1);
            if (lane == 0) { WTS[(size_t)row * 2] = e0 * inv; WTS[(size_t)row * 2 + 1] = e1 * inv; ENT[rl * 2] = gs * 4 + i0; ENT[rl * 2 + 1] = gs * 4 + i1; }
        }
        __syncthreads();
        if (tid < 256) RANK[tid] = (int)__hip_atomic_fetch_add((LAS unsigned*)&LCNT[ENT[tid]], 1u, __ATOMIC_RELAXED, __HIP_MEMORY_SCOPE_WORKGROUP);
        __syncthreads();
        if (tid < 16) LBASE[tid] = __hip_atomic_fetch_add(ctl + CW_CNT + (l * 16 + tid) * 64, LCNT[tid], RLX_AGENT);
        __syncthreads();
        if (tid < 256) { const int e = ENT[tid]; LIST[(size_t)e * LISTCAP + LBASE[e] + RANK[tid]] = (unsigned)((rb * 128 + (tid >> 1)) * 2 + (tid & 1)); }
        __syncthreads();
    }
}
__device__ __forceinline__ void moe_table(const KA& a, int l, LAS int* tab, int tid) {
    gu32* ctl = (gu32*)(a.ws() + WS_CTL);
    if (tid < 16) tab[17 + tid] = (int)__hip_atomic_load(ctl + CW_CNT + (l * 16 + tid) * 64, RLX_AGENT);
    __syncthreads();
    if (tid == 0) { int s = 0; for (int e = 0; e < 16; ++e) { tab[e] = s; s += (tab[17 + e] + 255) >> 8; } tab[16] = s; }
    __syncthreads();
}
__device__ __forceinline__ void p9_ln2(const KA& a, int l, int gw, int NGW, int lane) {
    unsigned char* ws = a.ws(); bf16* H = (bf16*)(ws + WS_H); const float* WTS = (const float*)(ws + WS_WTS); const bf16* F0 = (const bf16*)(ws + WS_FFN); const bf16* F1 = F0 + (size_t)NTOK * D;
    const float* gam = a.in(26) + l * D; const float* bet = a.in(27) + l * D;
    for (int row = gw; row < NTOK; row += NGW) {
        bf16* hp = H + (size_t)row * D; const bf16* f0 = F0 + (size_t)row * D; const bf16* f1 = F1 + (size_t)row * D; const float w0 = WTS[(size_t)row * 2], w1 = WTS[(size_t)row * 2 + 1];
        float v[16], x[8], y[8];
#pragma unroll
        for (int h = 0; h < 2; ++h) { unpack8(*(const v4u*)(hp + 512 * h + 8 * lane), v + 8 * h); unpack8(*(const v4u*)(f0 + 512 * h + 8 * lane), x); unpack8(*(const v4u*)(f1 + 512 * h + 8 * lane), y);
#pragma unroll
            for (int j = 0; j < 8; ++j) v[8 * h + j] = ALPHA * v[8 * h + j] + w0 * x[j] + w1 * y[j]; }
        ln16(v, gam, bet, lane);
        if (l == DEPTH - 1) { float* op = a.out() + (size_t)row * D;
#pragma unroll
            for (int h = 0; h < 2; ++h) { *(f32x4*)(op + 512 * h + 8 * lane) = (f32x4){v[8 * h], v[8 * h + 1], v[8 * h + 2], v[8 * h + 3]}; *(f32x4*)(op + 512 * h + 8 * lane + 4) = (f32x4){v[8 * h + 4], v[8 * h + 5], v[8 * h + 6], v[8 * h + 7]}; } }
        else { *(v4u*)(hp + 8 * lane) = pack8f(v); *(v4u*)(hp + 512 + 8 * lane) = pack8f(v + 8); }
    }
}

#ifndef PH_MASK
#define PH_MASK 0xFFFF
#endif
#ifndef STOP_AT
#define STOP_AT 0
#endif
#define STOP_DUMP(n, off) do { if (STOP_AT == (n) && l == 0 && hf == 0) { PHASE_BEGIN const bf16* H_ = (const bf16*)(ws + (off)); float* o_ = A_.out(); for (size_t i = (size_t)bx * 512 + tid; i < (size_t)NTOK * D; i += (size_t)G * 512) o_[i] = bf1(H_[i]); return; } } while (0)
#define STOP_HERE(n) do { if (STOP_AT == (n)) { PHASE_BEGIN const bf16* H_ = (const bf16*)(ws + WS_H); float* o_ = A_.out(); for (size_t i = (size_t)bx * 512 + tid; i < (size_t)NTOK * D; i += (size_t)G * 512) o_[i] = bf1(H_[i]); return; } } while (0)
__global__ void __launch_bounds__(NWAVES * 64, 2) hybrid_fwd(Args args) {
    extern __shared__ __attribute__((aligned(16))) unsigned char lds_raw[];
    LAS unsigned char* lds = (LAS unsigned char*)lds_raw;
    const int G = gridDim.x, bx = blockIdx.x;
#define PHASE_BEGIN KA A_; A_.kp = (KP)__builtin_amdgcn_kernarg_segment_ptr(); asm volatile("" : "+s"(A_.kp)); int tid = threadIdx.x; asm volatile("" : "+v"(tid)); \
    const int lane = tid & 63, wave = __builtin_amdgcn_readfirstlane(tid >> 6), gw = bx * NWAVES + wave, NGW = G * NWAVES; unsigned char* ws = A_.ws(); (void)lane; (void)gw; (void)NGW; (void)ws;
    XcdBarrier bar;
    { PHASE_BEGIN
      for (int u = tid; u < (LDS_BYTES - LDSCTL_OFF) / 4; u += NWAVES * 64) ((LAS unsigned*)(lds + LDSCTL_OFF))[u] = 0u;
      __syncthreads();
      bar = xcd_barrier_post((unsigned*)(ws + WS_CTL) + CW_BAR, (volatile LAS unsigned*)(lds + MISC_OFF) + 8);
      if (PH_MASK & 1) p0_prologue(A_, lds, gw, NGW, wave, lane); }
    xcd_barrier(bar);
    STOP_HERE(1);

#pragma unroll 1
    for (int l = 0; l < DEPTH; ++l) {
#pragma unroll 1
        for (int hf = 0; hf < 2; ++hf) {
            if (PH_MASK & 2) { PHASE_BEGIN
              InprojSched S; S.G = G; S.c = bx; S.Hh = (const char*)(ws + WS_H) + (size_t)hf * HTOK * D * 2; S.Win = (const char*)(ws + WS_WIN) + (size_t)l * PROJ * 1024 * 2;
              EpiInproj E{(bf16*)(ws + WS_ZC), (bf16*)(ws + WS_G), (bf16*)(ws + WS_VT), A_.in(4) + (size_t)l * 3 * 1024};
              pg8::gemm_phase<EpiInproj, InprojSched, true, false>(lds, pg8::Gemm{1024, 1024, 1024}, S, E); }
            xcd_barrier(bar);
            STOP_DUMP(10, WS_ZC); STOP_DUMP(11, WS_ZC + 64 * MiB); STOP_DUMP(12, WS_ZC + 128 * MiB); STOP_DUMP(13, WS_ZC + 144 * MiB);
            if (PH_MASK & 4) { PHASE_BEGIN
              bf16* ZC = (bf16*)(ws + WS_ZC); bf16* Y = (bf16*)(ws + WS_Y); bf16* HLOC = (bf16*)(ws + WS_MRG); bf16* CUMA = HLOC + (size_t)HTOK * 512; float* SUMA = (float*)(ws + WS_SUM); float* SUMH = SUMA + 4 * 64 * 512;
              LAS bf16* U = (LAS bf16*)(lds + wave * 9216);
              for (int t = gw; t < 4 * 64 * 8; t += NGW) lru_local_task(A_, l, ZC + (size_t)2 * HTOK * 512, HLOC, CUMA, SUMA, SUMH, (const bf16*)(ws + WS_LRUW), U, t >> 9, (t >> 3) & 63, t & 7, lane);
              for (int t = gw; t < 4 * 8 * 128; t += NGW) sb_attn_task(ZC, ZC + (size_t)HTOK * 512, (const bf16*)(ws + WS_VT), Y, t >> 10, (t >> 7) & 7, t & 127, lane);
              sc_pass(A_, l, ZC + (size_t)4 * HTOK * 512, ZC + (size_t)5 * HTOK * 512, Y, bx * 512 + tid, G * 512); }
            xcd_barrier(bar);
            STOP_DUMP(20, WS_Y); STOP_DUMP(21, WS_MRG);
            if (PH_MASK & 8) { PHASE_BEGIN
              const bf16* HLOC = (const bf16*)(ws + WS_MRG); const bf16* CUMA = HLOC + (size_t)HTOK * 512; const float* SUMA = (const float*)(ws + WS_SUM); const float* SUMH = SUMA + 4 * 64 * 512;
              for (int t = bx; t < 4 * 64; t += G) lru_fix_task((const bf16*)(ws + WS_ZC) + (size_t)3 * HTOK * 512, HLOC, CUMA, SUMA, SUMH, (bf16*)(ws + WS_Y), t >> 6, t & 63, tid); }
            xcd_barrier(bar);
            STOP_DUMP(30, WS_Y);
            if (PH_MASK & 16) { PHASE_BEGIN
              BranchSched S; S.G = G; S.c = bx; S.Y = (const char*)(ws + WS_Y); S.WBR = (const char*)(ws + WS_WBR) + (size_t)l * 1024 * 1536 * 2;
              EpiBranch E{(const bf16*)(ws + WS_G), (bf16*)(ws + WS_MRG)};
              pg8::gemm_phase<EpiBranch, BranchSched, true, false>(lds, pg8::Gemm{512, 1536, 1536}, S, E); }
            xcd_barrier(bar);
            STOP_DUMP(40, WS_MRG);
            if (PH_MASK & 32) { PHASE_BEGIN
              PlainSched S; S.G = G; S.c = bx; S.nM = 64; S.nN = 4; S.A = (const char*)(ws + WS_MRG); S.B = (const char*)(ws + WS_WOUT) + (size_t)l * 1024 * 1024 * 2; S.astep = (size_t)256 * 1024 * 2; S.bstep = (size_t)256 * 1024 * 2;
              EpiOutproj E{(bf16*)(ws + WS_H) + (size_t)hf * HTOK * D};
              pg8::gemm_phase<EpiOutproj, PlainSched, true, false>(lds, pg8::Gemm{1024, 1024, 1024}, S, E); }
            xcd_barrier(bar);
            STOP_DUMP(50, WS_H);
        }
        STOP_HERE(2);
        if (PH_MASK & 64) { PHASE_BEGIN p6_ln1_router(A_, l, lds, G, tid, wave, lane); }
        xcd_barrier(bar);
        STOP_HERE(3);
        if (PH_MASK & 128) { PHASE_BEGIN
          LAS int* tab = (LAS int*)(lds + MOE_OFF);
          moe_table(A_, l, tab, tid);
          MoeSched S; S.G = G; S.c = bx; S.tab = tab; S.Abase = (const char*)(ws + WS_H); S.atile = 0; S.Wbase = (const char*)(ws + WS_WGU) + (size_t)l * NEXP * 1024 * 1024 * 2; S.wstride = (size_t)1024 * 1024 * 2; S.bstep = (size_t)256 * 1024 * 2;
          S.list = (const unsigned*)(ws + WS_LIST);
          EpiGateUp E{(bf16*)(ws + WS_HB)};
          pg8::gemm_phase<EpiGateUp, MoeSched, true, true>(lds, pg8::Gemm{1024, 1024, 1024}, S, E); }
        xcd_barrier(bar);
        if (PH_MASK & 256) { PHASE_BEGIN
          LAS int* tab = (LAS int*)(lds + MOE_OFF);
          moe_table(A_, l, tab, tid);
          MoeSched S; S.G = G; S.c = bx; S.tab = tab; S.Abase = (const char*)(ws + WS_HB); S.atile = (size_t)256 * 512 * 2; S.Wbase = (const char*)(ws + WS_WDN) + (size_t)l * NEXP * 1024 * 512 * 2; S.wstride = (size_t)1024 * 512 * 2; S.bstep = (size_t)256 * 512 * 2;
          S.list = (const unsigned*)(ws + WS_LIST);
          EpiDown E{(bf16*)(ws + WS_FFN), (const unsigned*)(ws + WS_LIST)};
          pg8::gemm_phase<EpiDown, MoeSched, true, false>(lds, pg8::Gemm{512, 512, 512}, S, E); }
        xcd_barrier(bar);
        if (PH_MASK & 512) { PHASE_BEGIN p9_ln2(A_, l, gw, NGW, lane); }
        if (l + 1 < DEPTH) xcd_barrier(bar);
        STOP_HERE(4);
    }
}

extern "C" void kernel_launch(void* const* d_in, const int* in_sizes, int n_in, void* d_out, int out_size, void* d_ws, size_t ws_size, hipStream_t stream) {
    static int grid = 0;
    if (grid == 0) {
        if (n_in != 28 || in_sizes[0] != NTOK * D || out_size != NTOK * D || ws_size < WS_END) { fprintf(stderr, "kernel_launch: unexpected shapes (n_in %d, in0 %d, out %d, ws %zu); nothing launched\n", n_in, n_in > 0 ? in_sizes[0] : -1, out_size, ws_size); grid = -1; return; }
        int dev = 0, cus = 0, per_cu = 0;
        if (hipGetDevice(&dev) != hipSuccess || hipDeviceGetAttribute(&cus, hipDeviceAttributeMultiprocessorCount, dev) != hipSuccess) { grid = -1; return; }
        if (hipFuncSetAttribute((const void*)hybrid_fwd, hipFuncAttributeMaxDynamicSharedMemorySize, LDS_BYTES) != hipSuccess) { fprintf(stderr, "kernel_launch: hipFuncSetAttribute failed\n"); grid = -1; return; }
        if (hipOccupancyMaxActiveBlocksPerMultiprocessor(&per_cu, (const void*)hybrid_fwd, NWAVES * 64, LDS_BYTES) != hipSuccess || per_cu < 1) fprintf(stderr, "kernel_launch: occupancy query reports %d\n", per_cu);
        (void)hipGetLastError();
        grid = cus;
    }
    if (grid < 0) return;
    if (hipMemsetAsync((char*)d_ws + WS_CTL, 0, CTL_ZERO_BYTES, stream) != hipSuccess) return;
    Args a{};
    for (int i = 0; i < 28; ++i) a.in[i] = (const float*)d_in[i];
    a.out = (float*)d_out; a.ws = (unsigned char*)d_ws;
    hipLaunchKernelGGL(hybrid_fwd, dim3(grid), dim3(NWAVES * 64), LDS_BYTES, stream, a);
}
```

```cpp
#include <hip/hip_runtime.h>
#include <cstdio>
#include <cstdint>
namespace pg8 {
#define PG8_LAS __attribute__((address_space(3)))
typedef unsigned short bf16_t;
typedef short bf16x8 __attribute__((ext_vector_type(8)));
typedef float f32x4 __attribute__((ext_vector_type(4)));
typedef float f32x2 __attribute__((ext_vector_type(2)));
typedef unsigned u32x4 __attribute__((ext_vector_type(4)));
typedef unsigned u32x2 __attribute__((ext_vector_type(2)));
constexpr int BM = 256, BK = 64, HALF = 128, HTB = HALF * BK * 2  , STAGE_BYTES = 8 * HTB, NXCD = 8, WGM = 8;

__host__ __device__ __forceinline__ int lds_byte(int r, int c) { const int st = (r >> 4) * 2 + (c >> 5), rr = r & 15, cc = c & 31, ob = rr * 64 + cc * 2; return st * 1024 + (ob ^ (((ob >> 9) & 1) << 5)); }
__host__ __device__ __forceinline__ void stage_rc(int b, int& R, int& C) { const int st = b / 1024, sb = b % 1024, swz = sb ^ (((sb >> 9) & 1) << 5); R = (st >> 1) * 16 + swz / 64; C = (st & 1) * 32 + (swz % 64) / 2; }
__host__ __device__ __forceinline__ int perm32(int rho) { const int n = rho >> 4, i = rho & 15; return 8 * (i >> 2) + 4 * n + (i & 3); }

struct Unit { int pm, pn, ty, aux, nv, pad; const char* A; const char* B; };
struct Gemm { int K, lda, ldb; };

__device__ __forceinline__ void tile_swz(int L, int nM, int nN, int& pm, int& pn) {
    const int nwg = nM * nN; int wgid = L; { const int q = nwg / NXCD, r = nwg % NXCD, xcd = wgid % NXCD, off = wgid / NXCD; wgid = (xcd < r ? xcd * (q + 1) : r * (q + 1) + (xcd - r) * q) + off; }
    const int nig = WGM * nN, gid = wgid / nig, fm = gid * WGM, gsz = (nM - fm) < WGM ? (nM - fm) : WGM;
    pm = fm + ((wgid % nig) % gsz); pn = (wgid % nig) / gsz;
}
__device__ __forceinline__ unsigned cvt_pk_bf16(float lo, float hi) { unsigned r; asm volatile("v_cvt_pk_bf16_f32 %0, %1, %2" : "=v"(r) : "v"(lo), "v"(hi)); return r; }

template <class Epi, class Sched, bool ALIGN_EPI, bool GATHER>
__device__ __forceinline__ void gemm_phase(PG8_LAS unsigned char* lds, const Gemm g, const Sched& S, const Epi& E) {
    int tid = threadIdx.x; asm volatile("" : "+v"(tid));
    const int wid = __builtin_amdgcn_readfirstlane(tid >> 6), lane = tid & 63, wr = wid >> 2, wc = wid & 3, fr = lane & 15, fq = lane >> 4;
    const int K = g.K, nt = K / BK;
    int sR[2], sC[2];
    unsigned cvA[2][2], nvA[2][2], voffB[2];
#pragma unroll
    for (int i = 0; i < 2; ++i) { int R, C; stage_rc(tid * 16 + i * 8192, R, C); sR[i] = R; sC[i] = C; const int Rb = Epi::PERM ? ((R & ~31) + perm32(R & 31)) : R;
        voffB[i] = (unsigned)(Rb * g.ldb + C) * 2u;
#pragma unroll
        for (int h = 0; h < 2; ++h) { cvA[h][i] = (unsigned)((h * HALF + R) * g.lda + C) * 2u; nvA[h][i] = cvA[h][i]; } }
    const size_t kstep = (size_t)(BK * 2);
    const size_t hstepB = (size_t)HALF * g.ldb * 2;
    const unsigned ldsw = (unsigned)wid * 1024u;
    const int aoff = lds_byte(wr * 64 + fr, fq * 8), boff = lds_byte(wc * 32 + fr, fq * 8);
#define PG8_SA(b, h) (((b) * 2 + (h)) * HTB)
#define PG8_SB(b, h) ((4 + (b) * 2 + (h)) * HTB)
#define PG8_STAGE(bufoff, gbase, voff) do { _Pragma("unroll") for (int _i = 0; _i < 2; ++_i) \
        __builtin_amdgcn_global_load_lds((const unsigned*)((const char*)(gbase) + (voff)[_i]), (PG8_LAS unsigned*)(lds + (bufoff) + ldsw + _i * 8192), 16, 0, 0); } while (0)
#define PG8_LDA(dst, b, h) do { _Pragma("unroll") for (int m = 0; m < 4; ++m) _Pragma("unroll") for (int k = 0; k < 2; ++k) dst[m][k] = *(const PG8_LAS bf16x8*)(lds + PG8_SA(b, h) + aoff + m * 2048 + k * 1024); } while (0)
#define PG8_LDB(dst, b, h) do { _Pragma("unroll") for (int n = 0; n < 2; ++n) _Pragma("unroll") for (int k = 0; k < 2; ++k) dst[n][k] = *(const PG8_LAS bf16x8*)(lds + PG8_SB(b, h) + boff + n * 2048 + k * 1024); } while (0)
#define PG8_MMA(ai, bj, At, Bt) do { __builtin_amdgcn_s_setprio(1); _Pragma("unroll") for (int m = 0; m < 4; ++m) _Pragma("unroll") for (int n = 0; n < 2; ++n) _Pragma("unroll") for (int k = 0; k < 2; ++k) \
        acc[ai][bj][m][n] = __builtin_amdgcn_mfma_f32_16x16x32_bf16(Bt[n][k], At[m][k], acc[ai][bj][m][n], 0, 0, 0); __builtin_amdgcn_s_setprio(0); } while (0)
#define PG8_WAIT_V(n) asm volatile("s_waitcnt vmcnt(" #n ")" ::: "memory")
#define PG8_WAIT_L(n) asm volatile("s_waitcnt lgkmcnt(" #n ")" ::: "memory")
#define PG8_BAR __builtin_amdgcn_s_barrier()
#define PG8_SCHED __builtin_amdgcn_sched_barrier(0)
    Unit cur, nxt; int ui = 0;
    if (!S.next(0, cur)) return;
    f32x4 acc[2][2][4][2];
#pragma unroll
    for (int a = 0; a < 2; ++a)
#pragma unroll
        for (int b = 0; b < 2; ++b)
#pragma unroll
            for (int m = 0; m < 4; ++m)
#pragma unroll
                for (int n = 0; n < 2; ++n) acc[a][b][m][n] = (f32x4){0.f, 0.f, 0.f, 0.f};
    bf16x8 At[4][2], B0[2][2], B1[2][2];
    const char* cA = cur.A; const char* cB = cur.B;
    asm volatile("" : "+s"(cA), "+s"(cB));
    if constexpr (GATHER) {
#pragma unroll
        for (int h = 0; h < 2; ++h)
#pragma unroll
            for (int i = 0; i < 2; ++i) cvA[h][i] = (unsigned)(S.arow(cur, h * HALF + sR[i]) * g.lda + sC[i]) * 2u;
        PG8_WAIT_V(0);
    }
    S.a_ready(cur);
    PG8_STAGE(PG8_SB(0, 0), cB, voffB); PG8_STAGE(PG8_SB(0, 1), cB + hstepB, voffB); PG8_STAGE(PG8_SA(0, 0), cA, cvA[0]); PG8_STAGE(PG8_SA(0, 1), cA, cvA[1]);
    if (wr == 1) PG8_BAR;
    PG8_WAIT_V(2); PG8_BAR;
    PG8_STAGE(PG8_SB(1, 0), cB + kstep, voffB); PG8_STAGE(PG8_SA(1, 0), cA + kstep, cvA[0]); PG8_STAGE(PG8_SB(1, 1), cB + hstepB + kstep, voffB);
    PG8_WAIT_V(6); PG8_BAR;
    for (;;) {
        const bool has_next = S.next(ui + 1, nxt);
        const char* nA = has_next ? nxt.A : cA; const char* nB = has_next ? nxt.B : cB;
        asm volatile("" : "+s"(nA), "+s"(nB));
        if constexpr (GATHER) {
            if (has_next) {
#pragma unroll
                for (int h = 0; h < 2; ++h)
#pragma unroll
                    for (int i = 0; i < 2; ++i) nvA[h][i] = (unsigned)(S.arow(nxt, h * HALF + sR[i]) * g.lda + sC[i]) * 2u;
                PG8_WAIT_V(0);
            } else {
#pragma unroll
                for (int h = 0; h < 2; ++h)
#pragma unroll
                    for (int i = 0; i < 2; ++i) nvA[h][i] = cvA[h][i];
            }
        }
        for (int t = 0; t < nt; t += 2) {
            const bool last = (t == nt - 2);
            const char* a1 = cA + (size_t)(t + 1) * kstep;
            const char* a2 = last ? nA : cA + (size_t)(t + 2) * kstep; const char* b2 = last ? nB : cB + (size_t)(t + 2) * kstep;
            const char* a3 = a2 + kstep; const char* b3 = b2 + kstep;
            unsigned o2[2][2];
#pragma unroll
            for (int h = 0; h < 2; ++h)
#pragma unroll
                for (int i = 0; i < 2; ++i) o2[h][i] = (GATHER && last) ? nvA[h][i] : cvA[h][i];
            if (last && has_next) S.a_ready(nxt);
            PG8_LDB(B0, 0, 0); PG8_LDB(B1, 0, 1); PG8_SCHED; PG8_LDA(At, 0, 0); PG8_STAGE(PG8_SA(1, 1), a1, cvA[1]);
            PG8_WAIT_V(8); PG8_WAIT_L(0); PG8_BAR; PG8_MMA(0, 0, At, B0); PG8_MMA(0, 1, At, B1); PG8_BAR; PG8_SCHED;
            PG8_LDA(At, 0, 1); PG8_STAGE(PG8_SB(0, 0), b2, voffB); PG8_STAGE(PG8_SB(0, 1), b2 + hstepB, voffB); PG8_STAGE(PG8_SA(0, 0), a2, o2[0]);
            PG8_WAIT_V(8); PG8_WAIT_L(0); PG8_BAR; PG8_MMA(1, 0, At, B0); PG8_MMA(1, 1, At, B1); PG8_BAR; PG8_SCHED;
            PG8_LDB(B0, 1, 0); PG8_LDB(B1, 1, 1); PG8_SCHED; PG8_LDA(At, 1, 0); PG8_STAGE(PG8_SA(0, 1), a2, o2[1]);
            PG8_WAIT_V(8); PG8_WAIT_L(0); PG8_BAR; PG8_MMA(0, 0, At, B0); PG8_MMA(0, 1, At, B1); PG8_BAR; PG8_SCHED;
            PG8_LDA(At, 1, 1); PG8_STAGE(PG8_SB(1, 0), b3, voffB); PG8_STAGE(PG8_SB(1, 1), b3 + hstepB, voffB); PG8_STAGE(PG8_SA(1, 0), a3, o2[0]);
            PG8_WAIT_V(8); PG8_WAIT_L(0); PG8_BAR; PG8_MMA(1, 0, At, B0); PG8_MMA(1, 1, At, B1); PG8_BAR; PG8_SCHED;
        }
        if constexpr (ALIGN_EPI) { if (wr == 0) PG8_BAR; }
        E(acc, cur, wr, wc, fr, fq); S.done(cur);
        if (!has_next) break;
#pragma unroll
        for (int a = 0; a < 2; ++a)
#pragma unroll
            for (int b = 0; b < 2; ++b)
#pragma unroll
                for (int m = 0; m < 4; ++m)
#pragma unroll
                    for (int n = 0; n < 2; ++n) acc[a][b][m][n] = (f32x4){0.f, 0.f, 0.f, 0.f};
        cur = nxt; cA = nA; cB = nB; ++ui;
        if constexpr (GATHER) {
#pragma unroll
            for (int h = 0; h < 2; ++h)
#pragma unroll
                for (int i = 0; i < 2; ++i) cvA[h][i] = nvA[h][i];
        }
        if constexpr (ALIGN_EPI) { if (wr == 1) PG8_BAR; }
    }
    PG8_WAIT_V(0);
    if constexpr (!ALIGN_EPI) { if (wr == 0) PG8_BAR; }
    PG8_BAR;
#undef PG8_SA
#undef PG8_SB
#undef PG8_STAGE
#undef PG8_LDA
#undef PG8_LDB
#undef PG8_MMA
#undef PG8_WAIT_V
#undef PG8_WAIT_L
#undef PG8_BAR
#undef PG8_SCHED
}
}
constexpr int NWAVES = 8;
constexpr int D = 1024, NTOK = 32768, SEQ = 4096, HTOK = 16384  , DEPTH = 2, NEXP = 16;
constexpr int PROJ = 7168, NMAIN = 6656;
constexpr float ALPHA = 1.41421356237309515f;
constexpr float LN_EPS = 1e-5f;
constexpr float LOG2E = 1.4426950408889634f;
constexpr float C2 = 0.125f * LOG2E;
constexpr int LISTCAP = 32768;

constexpr size_t MiB = 1u << 20;
constexpr size_t WS_CTL = 0, CTL_ZERO_BYTES = 1 * MiB;
constexpr size_t WS_WIN = 1 * MiB;
constexpr size_t WS_WBR = 29 * MiB;
constexpr size_t WS_WOUT = 35 * MiB;
constexpr size_t WS_WGU = 39 * MiB;
constexpr size_t WS_WDN = 103 * MiB;
constexpr size_t WS_LRUW = 135 * MiB;
constexpr size_t WS_H = 136 * MiB;
constexpr size_t WS_Y = 200 * MiB;
constexpr size_t WS_MRG = 248 * MiB;
constexpr size_t WS_ZC = 280 * MiB;
constexpr size_t WS_G = WS_ZC + 96 * MiB, WS_VT = WS_ZC + 192 * MiB;
constexpr size_t WS_SUM = 488 * MiB;
constexpr size_t WS_LIST = 280 * MiB;
constexpr size_t WS_WTS = 282 * MiB;
constexpr size_t WS_HB = 283 * MiB;
constexpr size_t WS_FFN = 351 * MiB;
constexpr size_t WS_END = 489 * MiB;
constexpr int CW_TMO = 0, CW_BAR = 4096, CW_CNT = 8192;

constexpr int RING_BYTES = 131072;
constexpr int LDSCTL_OFF = RING_BYTES, MISC_OFF = LDSCTL_OFF + 320, MOE_OFF = LDSCTL_OFF + 1024;
constexpr int LDS_BYTES = 147456;

#define GAS __attribute__((address_space(1)))
#define LAS __attribute__((address_space(3)))
typedef unsigned short bf16;
typedef unsigned v4u __attribute__((ext_vector_type(4)));
typedef unsigned v2u __attribute__((ext_vector_type(2)));
typedef float f32x4 __attribute__((ext_vector_type(4)));
typedef float f32x16 __attribute__((ext_vector_type(16)));
typedef short bf16x8 __attribute__((ext_vector_type(8)));
typedef GAS unsigned gu32;
#define RLX_AGENT __ATOMIC_RELAXED, __HIP_MEMORY_SCOPE_AGENT
#define LDS_WAIT() asm volatile("s_waitcnt lgkmcnt(0)" ::: "memory")
#define VM_WAIT() asm volatile("s_waitcnt vmcnt(0)" ::: "memory")
__device__ __forceinline__ unsigned f2bf(float f) { unsigned u = __builtin_bit_cast(unsigned, f); return (u + 0x7fffu + ((u >> 16) & 1u)) >> 16; }
__device__ __forceinline__ unsigned pk2(float lo, float hi) { return f2bf(lo) | (f2bf(hi) << 16); }
typedef float f32x2_t __attribute__((ext_vector_type(2))); typedef __bf16 bf16x2_t __attribute__((ext_vector_type(2)));
__device__ __forceinline__ unsigned cvtpk(float lo, float hi) { f32x2_t v = {lo, hi}; bf16x2_t b = __builtin_convertvector(v, bf16x2_t); return __builtin_bit_cast(unsigned, b); }
__device__ __forceinline__ float bflo(unsigned w) { return __builtin_bit_cast(float, w << 16); }
__device__ __forceinline__ float bfhi(unsigned w) { return __builtin_bit_cast(float, w & 0xffff0000u); }
__device__ __forceinline__ float bf1(bf16 b) { return __builtin_bit_cast(float, ((unsigned)b) << 16); }
__device__ __forceinline__ float fexp2(float x) { return __builtin_amdgcn_exp2f(x); }
__device__ __forceinline__ float flog2(float x) { return __builtin_amdgcn_logf(x); }
__device__ __forceinline__ float frcp(float x) { return __builtin_amdgcn_rcpf(x); }
__device__ __forceinline__ float sigmoidf_(float x) { return frcp(1.f + fexp2(-LOG2E * x)); }
#define DPP_ADD(v, ctrl) ((v) + __builtin_bit_cast(float, __builtin_amdgcn_update_dpp(0, __builtin_bit_cast(int, (v)), (ctrl), 0xF, 0xF, true)))
__device__ __forceinline__ float row16_sum(float v) { v = DPP_ADD(v, 0xB1); v = DPP_ADD(v, 0x4E); v = DPP_ADD(v, 0x141); v = DPP_ADD(v, 0x140); return v; }
__device__ __forceinline__ float wave_sum(float v) {
    v = row16_sum(v); const int iv = __builtin_bit_cast(int, v);
    const float a = __builtin_bit_cast(float, __builtin_amdgcn_readlane(iv, 0)), b = __builtin_bit_cast(float, __builtin_amdgcn_readlane(iv, 16)),
                c = __builtin_bit_cast(float, __builtin_amdgcn_readlane(iv, 32)), d = __builtin_bit_cast(float, __builtin_amdgcn_readlane(iv, 48));
    return (a + b) + (c + d);
}
#define XB_TMO      128
#define XB_XCNT(j)  (256  + 64 * (j))
#define XB_XSUB(j)  (1280 + 64 * (j))
#define XB_XGEN(j)  (2304 + 64 * (j))
#define XB_TOP      3328
#define XB_TOPGEN   3392
#define XCD_BAR_WORDS 3456
#define XB_SPIN_CAP (1u << 18)

__device__ __forceinline__ unsigned xb_ld(unsigned* p)              { return __hip_atomic_load(p, __ATOMIC_RELAXED, __HIP_MEMORY_SCOPE_AGENT); }
__device__ __forceinline__ unsigned xb_add(unsigned* p, unsigned v) { return __hip_atomic_fetch_add(p, v, __ATOMIC_RELAXED, __HIP_MEMORY_SCOPE_AGENT); }
__device__ __forceinline__ unsigned xb_xcc_id() { return (unsigned)__builtin_amdgcn_s_getreg((3 << 11) | 20) & 0xFu; }
#define XB_SPIN(cond, bar) do { unsigned _sp = 0; while (cond) { __builtin_amdgcn_s_sleep(1); \
    if ((++_sp & 255u) == 0u) { if (xb_ld(&(bar)[XB_TMO])) break; if (_sp > XB_SPIN_CAP) { atomicAdd(&(bar)[XB_TMO], 1u); break; } } } } while (0)

struct XcdBarrier {
    unsigned* bar; unsigned x;
    volatile LAS unsigned* st;
};

__device__ __forceinline__ XcdBarrier xcd_barrier_post(unsigned* bar, volatile LAS unsigned* st) {
    XcdBarrier b; b.bar = bar; b.x = xb_xcc_id(); b.st = st;
    if (threadIdx.x == 0) (void)xb_add(&bar[XB_XCNT(b.x)], 1u);
    return b;
}
__device__ __forceinline__ void xcd_barrier_complete(unsigned* bar, unsigned x, unsigned& nloc, unsigned& nx) {
    const unsigned G = gridDim.x * gridDim.y * gridDim.z;
    unsigned sum, cnt, mine, sp = 0u;
    for (;;) {
        sum = 0u; cnt = 0u; mine = 0u;
#pragma unroll
        for (unsigned j = 0; j < 16; ++j) { const unsigned c = xb_ld(&bar[XB_XCNT(j)]); sum += c; cnt += (c > 0u) ? 1u : 0u; mine = (j == x) ? c : mine; }
        if (sum == G) break;
        __builtin_amdgcn_s_sleep(1);
        if ((++sp & 255u) == 0u) { if (xb_ld(&bar[XB_TMO])) break; if (sp > XB_SPIN_CAP) { atomicAdd(&bar[XB_TMO], 1u); break; } }
    }
    nloc = mine > 0u ? mine : 1u; nx = cnt > 0u ? cnt : 1u;
}

__device__ __forceinline__ void xcd_barrier(const XcdBarrier& b) {
    asm volatile("s_waitcnt vmcnt(0)" ::: "memory");
    __syncthreads();
    if (threadIdx.x == 0) {
        unsigned* bar = b.bar;
        __builtin_amdgcn_s_waitcnt(0);
        unsigned nloc = b.st[0], nx = b.st[1];
        if (nloc == 0u) { xcd_barrier_complete(bar, b.x, nloc, nx); b.st[0] = nloc; b.st[1] = nx; }
        const unsigned old = xb_add(&bar[XB_XSUB(b.x)], 1u);
        const unsigned gen = old / nloc;
        if (old + 1u == (gen + 1u) * nloc) {
            __builtin_amdgcn_fence(__ATOMIC_RELEASE, "agent");
            asm volatile("s_waitcnt vmcnt(0)" ::: "memory");
            const unsigned og = xb_add(&bar[XB_TOP], 1u);
            const unsigned tg = og / nx;
            if (og + 1u == (tg + 1u) * nx) xb_add(&bar[XB_TOPGEN], 1u);
            else XB_SPIN(xb_ld(&bar[XB_TOPGEN]) == tg, bar);
            __builtin_amdgcn_fence(__ATOMIC_ACQUIRE, "agent");
            xb_add(&bar[XB_XGEN(b.x)], 1u);
            asm volatile("s_waitcnt vmcnt(0)" ::: "memory");
        } else {
            XB_SPIN(xb_ld(&bar[XB_XGEN(b.x)]) == gen, bar);
            __builtin_amdgcn_fence(__ATOMIC_ACQUIRE, "agent");
            asm volatile("s_waitcnt vmcnt(0)" ::: "memory");
        }
    }
    __syncthreads();
}
using pg8::Unit;
struct NoHooks { __device__ __forceinline__ void a_ready(const Unit&) const {} __device__ __forceinline__ void done(const Unit&) const {} };

struct InprojSched : NoHooks {
    int G, c; const char* Hh; const char* Win;
    __device__ __forceinline__ bool next(int i, Unit& u) const {
        const int L = i * G + c; if (L >= 1792) return false;
        if (L < 1664) { pg8::tile_swz(L, 64, 26, u.pm, u.pn); u.ty = 0; u.A = Hh + (size_t)u.pm * 256 * 2048; u.B = Win + (size_t)u.pn * 256 * 2048; }
        else { const int j = L - 1664; u.pm = j & 1; u.pn = j >> 1; u.ty = 1; u.A = Win + (size_t)(NMAIN + 256 * u.pm) * 2048; u.B = Hh + (size_t)u.pn * 256 * 2048; }
        u.aux = 0; u.nv = 0; u.pad = 0; return true;
    }
};
struct EpiInproj {
    static constexpr bool PERM = true;
    bf16* ZC; bf16* G0; bf16* VT; const float* gate_b;
    __device__ __forceinline__ void operator()(const pg8::f32x4 (&acc)[2][2][4][2], const Unit& u, int wr, int wc, int fr, int fq) const {
        int row0 = u.pm * 256 + wr * 64 + fr; asm volatile("" : "+v"(row0));
        if (u.ty == 0 && u.pn >= 10 && u.pn < 14) {
            bf16* base = ZC + (size_t)5 * HTOK * 512; const int col0 = (u.pn - 10) * 128 + wc * 32 + 8 * fq;
#pragma unroll
            for (int ai = 0; ai < 2; ++ai)
#pragma unroll
                for (int m = 0; m < 4; ++m) { const pg8::f32x4 v0 = acc[ai][0][m][0] * acc[ai][1][m][0], v1 = acc[ai][0][m][1] * acc[ai][1][m][1];
                    v4u w; w.x = cvtpk(v0[0], v0[1]); w.y = cvtpk(v0[2], v0[3]); w.z = cvtpk(v1[0], v1[1]); w.w = cvtpk(v1[2], v1[3]);
                    *(v4u*)(base + (size_t)(row0 + ai * 128 + m * 16) * 512 + col0) = w; }
            return;
        }
        if (u.ty == 0 && u.pn >= 14) {
            const int b = (u.pn - 14) >> 2, col0 = ((u.pn - 14) & 3) * 256 + wc * 32 + 8 * fq; bf16* base = G0 + (size_t)b * HTOK * 1024; const float* gb = gate_b + b * 1024 + col0;
            pg8::f32x4 bv[2][2];
#pragma unroll
            for (int bj = 0; bj < 2; ++bj)
#pragma unroll
                for (int n = 0; n < 2; ++n) bv[bj][n] = *(const pg8::f32x4*)(gb + bj * 128 + 4 * n);
#pragma unroll
            for (int ai = 0; ai < 2; ++ai)
#pragma unroll
                for (int m = 0; m < 4; ++m) { bf16* rowp = base + (size_t)(row0 + ai * 128 + m * 16) * 1024 + col0;
#pragma unroll
                    for (int bj = 0; bj < 2; ++bj) { pg8::f32x4 v0 = acc[ai][bj][m][0] + bv[bj][0], v1 = acc[ai][bj][m][1] + bv[bj][1];
#pragma unroll
                        for (int j = 0; j < 4; ++j) { v0[j] = sigmoidf_(v0[j]); v1[j] = sigmoidf_(v1[j]); }
                        v4u w; w.x = cvtpk(v0[0], v0[1]); w.y = cvtpk(v0[2], v0[3]); w.z = cvtpk(v1[0], v1[1]); w.w = cvtpk(v1[2], v1[3]);
                        *(v4u*)(rowp + bj * 128) = w; } }
            return;
        }
        bf16* base; int ldc, col0; float sc = 1.f;
        if (u.ty == 1) { base = VT; ldc = HTOK; col0 = u.pn * 256 + wc * 32 + 8 * fq; }
        else { const int t = u.pn >> 1; base = ZC + (size_t)t * HTOK * 512; ldc = 512; col0 = (u.pn & 1) * 256 + wc * 32 + 8 * fq; if (t == 0) sc = C2; }
#pragma unroll
        for (int ai = 0; ai < 2; ++ai)
#pragma unroll
            for (int m = 0; m < 4; ++m) { bf16* rowp = base + (size_t)(row0 + ai * 128 + m * 16) * ldc + col0;
#pragma unroll
                for (int bj = 0; bj < 2; ++bj) { const pg8::f32x4 v0 = acc[ai][bj][m][0] * sc, v1 = acc[ai][bj][m][1] * sc;
                    v4u w; w.x = cvtpk(v0[0], v0[1]); w.y = cvtpk(v0[2], v0[3]); w.z = cvtpk(v1[0], v1[1]); w.w = cvtpk(v1[2], v1[3]);
                    *(v4u*)(rowp + bj * 128) = w; } }
    }
};

struct BranchSched : NoHooks {
    int G, c; const char* Y; const char* WBR;
    __device__ __forceinline__ bool next(int i, Unit& u) const {
        const int tile = (i / 3) * G + c, b = i % 3; if (tile >= 256) return false;
        pg8::tile_swz(tile, 64, 4, u.pm, u.pn); u.ty = b; u.aux = 0; u.nv = 0; u.pad = 0;
        u.A = Y + ((size_t)u.pm * 256 * 1536 + b * 512) * 2; u.B = WBR + ((size_t)u.pn * 256 * 1536 + b * 512) * 2; return true;
    }
};
struct EpiBranch {
    static constexpr bool PERM = true;
    const bf16* G0; bf16* MRG;
    __device__ __forceinline__ void operator()(const pg8::f32x4 (&acc)[2][2][4][2], const Unit& u, int wr, int wc, int fr, int fq) const {
        int row0 = u.pm * 256 + wr * 64 + fr; asm volatile("" : "+v"(row0)); const int col0 = u.pn * 256 + wc * 32 + 8 * fq; const bf16* gp = G0 + (size_t)u.ty * HTOK * 1024;
#pragma unroll
        for (int ai = 0; ai < 2; ++ai)
#pragma unroll
            for (int m = 0; m < 4; ++m) { const size_t off = (size_t)(row0 + ai * 128 + m * 16) * 1024 + col0;
#pragma unroll
                for (int bj = 0; bj < 2; ++bj) { const v4u gw = *(const v4u*)(gp + off + bj * 128); v4u ow = (v4u){0u, 0u, 0u, 0u}; if (u.ty != 0) ow = *(const v4u*)(MRG + off + bj * 128);
                    const pg8::f32x4 a0 = acc[ai][bj][m][0], a1 = acc[ai][bj][m][1]; v4u w;
                    w.x = cvtpk(bflo(ow.x) + bflo(gw.x) * a0[0], bfhi(ow.x) + bfhi(gw.x) * a0[1]); w.y = cvtpk(bflo(ow.y) + bflo(gw.y) * a0[2], bfhi(ow.y) + bfhi(gw.y) * a0[3]);
                    w.z = cvtpk(bflo(ow.z) + bflo(gw.z) * a1[0], bfhi(ow.z) + bfhi(gw.z) * a1[1]); w.w = cvtpk(bflo(ow.w) + bflo(gw.w) * a1[2], bfhi(ow.w) + bfhi(gw.w) * a1[3]);
                    *(v4u*)(MRG + off + bj * 128) = w; }
                asm volatile("" ::: "memory"); }
    }
};

struct PlainSched : NoHooks {
    int G, c, nM, nN; const char* A; const char* B; size_t astep, bstep;
    __device__ __forceinline__ bool next(int i, Unit& u) const {
        const int L = i * G + c; if (L >= nM * nN) return false;
        pg8::tile_swz(L, nM, nN, u.pm, u.pn); u.ty = 0; u.aux = 0; u.nv = 0; u.pad = 0; u.A = A + (size_t)u.pm * astep; u.B = B + (size_t)u.pn * bstep; return true;
    }
};
struct EpiOutproj {
    static constexpr bool PERM = true;
    bf16* Hh;
    __device__ __forceinline__ void operator()(const pg8::f32x4 (&acc)[2][2][4][2], const Unit& u, int wr, int wc, int fr, int fq) const {
        int row0 = u.pm * 256 + wr * 64 + fr; asm volatile("" : "+v"(row0)); const int col0 = u.pn * 256 + wc * 32 + 8 * fq;
#pragma unroll
        for (int ai = 0; ai < 2; ++ai)
#pragma unroll
            for (int m = 0; m < 4; ++m) { bf16* rowp = Hh + (size_t)(row0 + ai * 128 + m * 16) * 1024 + col0;
#pragma unroll
                for (int bj = 0; bj < 2; ++bj) { const v4u ow = *(const v4u*)(rowp + bj * 128); const pg8::f32x4 a0 = acc[ai][bj][m][0], a1 = acc[ai][bj][m][1]; v4u w;
                    w.x = cvtpk(ALPHA * bflo(ow.x) + a0[0], ALPHA * bfhi(ow.x) + a0[1]); w.y = cvtpk(ALPHA * bflo(ow.y) + a0[2], ALPHA * bfhi(ow.y) + a0[3]);
                    w.z = cvtpk(ALPHA * bflo(ow.z) + a1[0], ALPHA * bfhi(ow.z) + a1[1]); w.w = cvtpk(ALPHA * bflo(ow.w) + a1[2], ALPHA * bfhi(ow.w) + a1[3]);
                    *(v4u*)(rowp + bj * 128) = w; }
                asm volatile("" ::: "memory"); }
    }
};

struct MoeSched : NoHooks {
    int G, c; const LAS int* tab; const char* Abase; size_t atile; const char* Wbase; size_t wstride, bstep; const unsigned* list;
    __device__ __forceinline__ bool next(int i, Unit& u) const {
        const int L = i * G + c, NT = tab[16]; if (L >= NT * 4) return false;
        const int rt = L >> 2; int e = 0;
#pragma unroll 1
        while (e < 15 && rt >= tab[e + 1]) ++e;
        const int j = rt - tab[e];
        u.pm = rt; u.pn = L & 3; u.ty = e; u.aux = e * LISTCAP + j * 256; u.nv = tab[17 + e] - j * 256; u.pad = 0;
        u.A = Abase + (size_t)rt * atile; u.B = Wbase + (size_t)e * wstride + (size_t)u.pn * bstep; return true;
    }
    __device__ __forceinline__ int arow(const Unit& u, int r) const { return r < u.nv ? (int)(list[u.aux + r] >> 1) : 0; }
};
struct EpiGateUp {
    static constexpr bool PERM = true;
    bf16* HB;
    __device__ __forceinline__ void operator()(const pg8::f32x4 (&acc)[2][2][4][2], const Unit& u, int wr, int wc, int fr, int fq) const {
        int row0 = u.pm * 256 + wr * 64 + fr; asm volatile("" : "+v"(row0)); const int col0 = u.pn * 128 + wc * 32 + 8 * fq;
#pragma unroll
        for (int ai = 0; ai < 2; ++ai)
#pragma unroll
            for (int m = 0; m < 4; ++m) { pg8::f32x4 v0, v1;
#pragma unroll
                for (int j = 0; j < 4; ++j) { const float g0 = acc[ai][0][m][0][j], g1 = acc[ai][0][m][1][j]; v0[j] = g0 * sigmoidf_(g0) * acc[ai][1][m][0][j]; v1[j] = g1 * sigmoidf_(g1) * acc[ai][1][m][1][j]; }
                v4u w; w.x = cvtpk(v0[0], v0[1]); w.y = cvtpk(v0[2], v0[3]); w.z = cvtpk(v1[0], v1[1]); w.w = cvtpk(v1[2], v1[3]);
                *(v4u*)(HB + (size_t)(row0 + ai * 128 + m * 16) * 512 + col0) = w; }
    }
};
struct EpiDown {
    static constexpr bool PERM = true;
    bf16* FFN; const unsigned* list;
    __device__ __forceinline__ void operator()(const pg8::f32x4 (&acc)[2][2][4][2], const Unit& u, int wr, int wc, int fr, int fq) const {
        int r0 = wr * 64 + fr; asm volatile("" : "+v"(r0)); const int col0 = u.pn * 256 + wc * 32 + 8 * fq;
#pragma unroll
        for (int ai = 0; ai < 2; ++ai)
#pragma unroll
            for (int m = 0; m < 4; ++m) { const int r = r0 + ai * 128 + m * 16;
                if (r < u.nv) { const unsigned ent = list[u.aux + r]; bf16* rowp = FFN + ((size_t)(ent & 1u) * NTOK + (ent >> 1)) * 1024 + col0;
#pragma unroll
                    for (int bj = 0; bj < 2; ++bj) { const pg8::f32x4 v0 = acc[ai][bj][m][0], v1 = acc[ai][bj][m][1];
                        v4u w; w.x = cvtpk(v0[0], v0[1]); w.y = cvtpk(v0[2], v0[3]); w.z = cvtpk(v1[0], v1[1]); w.w = cvtpk(v1[2], v1[3]);
                        *(v4u*)(rowp + bj * 128) = w; } } }
    }
};

__device__ __forceinline__ void tr_item(const float* W, int N, int k0, int n0, bf16* dst, size_t drow0, int dpitch, int dk0, LAS float* scr, int lane) {
#pragma unroll 8
    for (int i = 0; i < 32; ++i) { const int kk = 2 * i + (lane >> 5); scr[kk * 33 + (lane & 31)] = W[(size_t)(k0 + kk) * N + n0 + (lane & 31)]; }
    LDS_WAIT(); asm volatile("" ::: "memory");
    const int c = lane & 7;
#pragma unroll
    for (int j = 0; j < 4; ++j) { const int n = (lane >> 3) + 8 * j; const LAS float* s = scr + (8 * c) * 33 + n;
        v4u o; o.x = pk2(s[0 * 33], s[1 * 33]); o.y = pk2(s[2 * 33], s[3 * 33]); o.z = pk2(s[4 * 33], s[5 * 33]); o.w = pk2(s[6 * 33], s[7 * 33]);
        *(v4u*)(dst + (drow0 + n) * (size_t)dpitch + dk0 + k0 + 8 * c) = o; }
    LDS_WAIT(); asm volatile("" ::: "memory");
}
__device__ __forceinline__ int map_in(int n0) {
    if (n0 < 1024) return n0;
    if (n0 < 1536) return NMAIN + (n0 - 1024);
    if (n0 < 3072) return n0 - 512;
    if (n0 < 3584) { const int c = n0 - 3072; return 2560 + (c >> 7) * 256 + (c & 127); }
    if (n0 < 4096) { const int c = n0 - 3584; return 2560 + (c >> 7) * 256 + 128 + (c & 127); }
    return n0 - 512;
}
struct Args { const float* in[28]; float* out; unsigned char* ws; };
typedef const __attribute__((address_space(4))) unsigned long long* KP;
struct KA { KP kp;
    __device__ __forceinline__ const float* in(int k) const { return (const float*)(const GAS float*)kp[k]; }
    __device__ __forceinline__ float* out() const { return (float*)(GAS float*)kp[28]; }
    __device__ __forceinline__ unsigned char* ws() const { return (unsigned char*)(GAS unsigned char*)kp[29]; } };

__device__ __forceinline__ void p0_prologue(const KA& a, LAS unsigned char* lds, int gw, int NGW, int wave, int lane) {
    LAS float* scr = (LAS float*)(lds + wave * 16384);
    unsigned char* ws = a.ws();
    constexpr int I_IN = 16 * 224, I_BR = 8 * 32, I_OUT = 16 * 32, I_G = 16 * 16, I_DN = 8 * 32, I_LRU = 2;
    constexpr int PER_LAYER = I_IN + 3 * I_BR + I_OUT + 16 * (2 * I_G + I_DN) + 32;
    for (int it = gw; it < DEPTH * PER_LAYER; it += NGW) {
        const int l = it / PER_LAYER; int r = it % PER_LAYER;
        if (r < I_IN) { const int kb = r / 224, nb = r % 224; tr_item(a.in(3) + (size_t)l * 1024 * PROJ, PROJ, 64 * kb, 32 * nb, (bf16*)(ws + WS_WIN) + (size_t)l * PROJ * 1024, (size_t)map_in(32 * nb), 1024, 0, scr, lane); continue; } r -= I_IN;
        if (r < 3 * I_BR) { const int b = r / I_BR, q = r % I_BR, kb = q / 32, nb = q % 32; tr_item(a.in(13 + b) + (size_t)l * 512 * 1024, 1024, 64 * kb, 32 * nb, (bf16*)(ws + WS_WBR) + (size_t)l * 1024 * 1536, (size_t)(32 * nb), 1536, b * 512, scr, lane); continue; } r -= 3 * I_BR;
        if (r < I_OUT) { const int kb = r / 32, nb = r % 32; tr_item(a.in(16) + (size_t)l * 1024 * 1024, 1024, 64 * kb, 32 * nb, (bf16*)(ws + WS_WOUT) + (size_t)l * 1024 * 1024, (size_t)(32 * nb), 1024, 0, scr, lane); continue; } r -= I_OUT;
        if (r < 16 * (2 * I_G + I_DN)) { const int e = r / (2 * I_G + I_DN); int q = r % (2 * I_G + I_DN);
            if (q < 2 * I_G) { const int up = q / I_G; q %= I_G; const int kb = q / 16, nb = q % 16, n0 = 32 * nb;
                tr_item(a.in(23 + up) + ((size_t)l * NEXP + e) * 1024 * 512, 512, 64 * kb, n0, (bf16*)(ws + WS_WGU) + ((size_t)l * NEXP + e) * 1024 * 1024, (size_t)((n0 >> 7) * 256 + up * 128 + (n0 & 127)), 1024, 0, scr, lane); }
            else { q -= 2 * I_G; const int kb = q / 32, nb = q % 32; tr_item(a.in(25) + ((size_t)l * NEXP + e) * 512 * 1024, 1024, 64 * kb, 32 * nb, (bf16*)(ws + WS_WDN) + ((size_t)l * NEXP + e) * 1024 * 512, (size_t)(32 * nb), 512, 0, scr, lane); }
            continue; } r -= 16 * (2 * I_G + I_DN);
        { const int gsel = r / 16, hd = (r % 16) / 2, nb = r % 2;
          tr_item(a.in(gsel ? 9 : 7) + ((size_t)l * 8 + hd) * 4096, 64, 0, 32 * nb, (bf16*)(ws + WS_LRUW) + (((size_t)l * 2 + gsel) * 8 + hd) * 4096, (size_t)(32 * nb), 64, 0, scr, lane); }
    }
    const float* gam = a.in(1); const float* bet = a.in(2); bf16* H = (bf16*)(ws + WS_H);
    for (int m = gw; m < NTOK; m += NGW) {
        const f32x4* xr = (const f32x4*)(a.in(0) + (size_t)m * D) + lane;
        f32x4 v[4]; float s = 0.f;
#pragma unroll
        for (int j = 0; j < 4; ++j) { v[j] = xr[64 * j]; s += (v[j].x + v[j].y) + (v[j].z + v[j].w); }
        const float mean = wave_sum(s) * (1.f / D); float s2 = 0.f;
#pragma unroll
        for (int j = 0; j < 4; ++j) { v[j] = v[j] - mean; s2 += (v[j].x * v[j].x + v[j].y * v[j].y) + (v[j].z * v[j].z + v[j].w * v[j].w); }
        const float rstd = 1.f / sqrtf(wave_sum(s2) * (1.f / D) + LN_EPS);
        unsigned long long* o8 = (unsigned long long*)(H + (size_t)m * D) + lane;
#pragma unroll
        for (int j = 0; j < 4; ++j) { const f32x4 g4 = ((const f32x4*)gam)[lane + 64 * j], b4 = ((const f32x4*)bet)[lane + 64 * j]; const f32x4 y = v[j] * rstd * g4 + b4;
            o8[64 * j] = (unsigned long long)pk2(y.x, y.y) | ((unsigned long long)pk2(y.z, y.w) << 32); }
    }
}

#define MFMA32(a, b, c) __builtin_amdgcn_mfma_f32_32x32x16_bf16((a), (b), (c), 0, 0, 0)
__device__ __forceinline__ int crow(int r, int hi) { return (r & 3) + 8 * (r >> 2) + 4 * hi; }
__device__ __forceinline__ bf16x8 pack8(const f32x16& x, int s) {
    v4u p; p.x = cvtpk(x[8 * s], x[8 * s + 1]); p.y = cvtpk(x[8 * s + 2], x[8 * s + 3]); p.z = cvtpk(x[8 * s + 4], x[8 * s + 5]); p.w = cvtpk(x[8 * s + 6], x[8 * s + 7]);
    return __builtin_bit_cast(bf16x8, p);
}
__device__ __forceinline__ float softplus2(float z) { return fmaxf(z, 0.f) + flog2(1.f + fexp2(-fabsf(z))); }

template <bool DIAG>
__device__ __forceinline__ bool sb_tile(const bf16* __restrict__ Kb, const bf16* __restrict__ VT, const bf16x8 (&qf)[4], const bf16x8 (&tri)[2], bf16x8 mones,
                                        f32x16& o0, f32x16& o1, float& carry, int seq0, int k0, int t0, int hd, int l32, int hi) {
    const bf16* kp = Kb + (size_t)(seq0 + k0 + l32) * 512 + hd * 64 + 8 * hi;
    f32x16 s0, s1;
#pragma unroll
    for (int r = 0; r < 16; ++r) { s0[r] = 0.f; s1[r] = 0.f; }
#pragma unroll
    for (int i = 0; i < 4; ++i) { const bf16x8 ka = *(const bf16x8*)(kp + 16 * i), kb = *(const bf16x8*)(kp + 32 * 512 + 16 * i); s0 = MFMA32(ka, qf[i], s0); s1 = MFMA32(kb, qf[i], s1); }
    const float z00 = s0[0];
    f32x16 p0, p1;
#pragma unroll
    for (int r = 0; r < 16; ++r) {
        float a = softplus2(s0[r]), b = softplus2(s1[r]);
        if (DIAG) { const int key = k0 + crow(r, hi), q = t0 + l32; if (key >= q) a = 0.f; if (key + 32 >= q) b = 0.f; }
        p0[r] = a; p1[r] = b;
    }
    const bf16x8 L0a = pack8(p0, 0), L0b = pack8(p0, 1), L1a = pack8(p1, 0), L1b = pack8(p1, 1);
#pragma unroll
    for (int r = 0; r < 16; ++r) { s0[r] -= carry; s1[r] -= carry; }
    s0 = MFMA32(tri[0], L0a, s0); s0 = MFMA32(tri[1], L0b, s0); s0 = MFMA32(mones, L1a, s0); s0 = MFMA32(mones, L1b, s0);
    s1 = MFMA32(tri[0], L1a, s1); s1 = MFMA32(tri[1], L1b, s1);
    float tot = (z00 - carry) - s0[0];
    tot = __shfl(tot, l32);
#pragma unroll
    for (int r = 0; r < 16; ++r) {
        float a = fexp2(s0[r]), b = fexp2(s1[r]);
        if (DIAG) { const int key = k0 + crow(r, hi), q = t0 + l32; if (key >= q) a = 0.f; if (key + 32 >= q) b = 0.f; }
        p0[r] = a; p1[r] = b;
    }
    carry += tot;
    const bf16x8 P0a = pack8(p0, 0), P0b = pack8(p0, 1), P1a = pack8(p1, 0), P1b = pack8(p1, 1);
    const bf16* vp = VT + (size_t)(hd * 64 + l32) * HTOK + seq0 + k0 + 4 * hi;
#pragma unroll
    for (int db = 0; db < 2; ++db) {
        const bf16* vq = vp + (size_t)db * 32 * HTOK;
        v4u a00, a01, a10, a11;
        { const v2u lo = *(const v2u*)(vq), hi8 = *(const v2u*)(vq + 8); a00 = (v4u){lo.x, lo.y, hi8.x, hi8.y}; }
        { const v2u lo = *(const v2u*)(vq + 16), hi8 = *(const v2u*)(vq + 24); a01 = (v4u){lo.x, lo.y, hi8.x, hi8.y}; }
        { const v2u lo = *(const v2u*)(vq + 32), hi8 = *(const v2u*)(vq + 40); a10 = (v4u){lo.x, lo.y, hi8.x, hi8.y}; }
        { const v2u lo = *(const v2u*)(vq + 48), hi8 = *(const v2u*)(vq + 56); a11 = (v4u){lo.x, lo.y, hi8.x, hi8.y}; }
        f32x16 o = db ? o1 : o0;
        o = MFMA32(__builtin_bit_cast(bf16x8, a00), P0a, o); o = MFMA32(__builtin_bit_cast(bf16x8, a01), P0b, o);
        o = MFMA32(__builtin_bit_cast(bf16x8, a10), P1a, o); o = MFMA32(__builtin_bit_cast(bf16x8, a11), P1b, o);
        if (db) o1 = o; else o0 = o;
    }
    return __all(carry > 150.f) != 0;
}
__device__ __forceinline__ void sb_attn_task(const bf16* __restrict__ Q, const bf16* __restrict__ Kb, const bf16* __restrict__ VT, bf16* Y, int b, int hd, int qb, int lane) {
    const int l32 = lane & 31, hi = lane >> 5, seq0 = b * SEQ, t0 = qb * 32;
    bf16x8 qf[4];
    { const bf16* qp = Q + (size_t)(seq0 + t0 + l32) * 512 + hd * 64 + 8 * hi;
#pragma unroll
      for (int i = 0; i < 4; ++i) qf[i] = *(const bf16x8*)(qp + 16 * i); }
    bf16x8 tri[2], mones;
#pragma unroll
    for (int i2 = 0; i2 < 2; ++i2)
#pragma unroll
        for (int j = 0; j < 8; ++j) { const int koff = 16 * i2 + 8 * (j >> 2) + 4 * hi + (j & 3); tri[i2][j] = (koff >= l32) ? (short)0xBF80 : (short)0; }
#pragma unroll
    for (int j = 0; j < 8; ++j) mones[j] = (short)0xBF80;
    f32x16 o0, o1;
#pragma unroll
    for (int r = 0; r < 16; ++r) { o0[r] = 0.f; o1[r] = 0.f; }
    float carry = 0.f;
    const int ktd = t0 >> 6;
    bool done = sb_tile<true>(Kb, VT, qf, tri, mones, o0, o1, carry, seq0, ktd * 64, t0, hd, l32, hi);
#pragma unroll 1
    for (int kt = ktd - 1; kt >= 0 && !done; --kt) done = sb_tile<false>(Kb, VT, qf, tri, mones, o0, o1, carry, seq0, kt * 64, t0, hd, l32, hi);
    bf16* yp = Y + (size_t)(seq0 + t0 + l32) * 1536 + hd * 64 + 4 * hi;
#pragma unroll
    for (int g = 0; g < 4; ++g) {
        *(v2u*)(yp + 8 * g) = (v2u){cvtpk(o0[4 * g], o0[4 * g + 1]), cvtpk(o0[4 * g + 2], o0[4 * g + 3])};
        *(v2u*)(yp + 32 + 8 * g) = (v2u){cvtpk(o1[4 * g], o1[4 * g + 1]), cvtpk(o1[4 * g + 2], o1[4 * g + 3])};
    }
}

__device__ __forceinline__ void lru_local_task(const KA& a, int l, const bf16* __restrict__ LI, bf16* HLOC, bf16* CUMA, float* SUMA, float* SUMH, const bf16* __restrict__ LW,
                                               LAS bf16* U, int b, int ch, int hd, int lane) {
    const int seq0 = b * SEQ, t0 = ch * 64;
    { const int co = lane & 7, sub = lane >> 3, c0 = hd * 64 + co * 8;
      const float* cw = a.in(5) + (size_t)l * 4 * 512 + c0; const float* cb = a.in(6) + (size_t)l * 512 + c0;
      float w[4][8], bias[8];
#pragma unroll
      for (int k = 0; k < 4; ++k) { const f32x4 x0 = *(const f32x4*)(cw + k * 512), x1 = *(const f32x4*)(cw + k * 512 + 4);
          w[k][0] = x0.x; w[k][1] = x0.y; w[k][2] = x0.z; w[k][3] = x0.w; w[k][4] = x1.x; w[k][5] = x1.y; w[k][6] = x1.z; w[k][7] = x1.w; }
      { const f32x4 x0 = *(const f32x4*)(cb), x1 = *(const f32x4*)(cb + 4); bias[0] = x0.x; bias[1] = x0.y; bias[2] = x0.z; bias[3] = x0.w; bias[4] = x1.x; bias[5] = x1.y; bias[6] = x1.z; bias[7] = x1.w; }
#pragma unroll 2
      for (int it = 0; it < 8; ++it) { const int tl = it * 8 + sub, t = t0 + tl; float u[8];
#pragma unroll
          for (int j = 0; j < 8; ++j) u[j] = bias[j];
#pragma unroll
          for (int k = 0; k < 4; ++k) { const int tt = t - 3 + k; if (tt >= 0) { const v4u x = *(const v4u*)(LI + (size_t)(seq0 + tt) * 512 + c0);
              u[0] += w[k][0] * bflo(x.x); u[1] += w[k][1] * bfhi(x.x); u[2] += w[k][2] * bflo(x.y); u[3] += w[k][3] * bfhi(x.y);
              u[4] += w[k][4] * bflo(x.z); u[5] += w[k][5] * bfhi(x.z); u[6] += w[k][6] * bflo(x.w); u[7] += w[k][7] * bfhi(x.w); } }
          *(LAS v4u*)(U + tl * 72 + co * 8) = (v4u){pk2(u[0], u[1]), pk2(u[2], u[3]), pk2(u[4], u[5]), pk2(u[6], u[7])}; }
      LDS_WAIT(); asm volatile("" ::: "memory"); }
    const int l32 = lane & 31, hi = lane >> 5;
    bf16x8 af[2][4];
#pragma unroll
    for (int mb = 0; mb < 2; ++mb)
#pragma unroll
        for (int ks = 0; ks < 4; ++ks) af[mb][ks] = *(const LAS bf16x8*)(U + (mb * 32 + l32) * 72 + 16 * ks + 8 * hi);
    float Hrun = 0.f, Arun = 1.f;
#pragma unroll 1
    for (int nb = 0; nb < 2; ++nb) {
        const int chn = hd * 64 + nb * 32 + l32;
        const bf16* wa = LW + ((size_t)(l * 2 + 0) * 8 + hd) * 4096 + (nb * 32 + l32) * 64 + 8 * hi;
        const bf16* wx = LW + ((size_t)(l * 2 + 1) * 8 + hd) * 4096 + (nb * 32 + l32) * 64 + 8 * hi;
        f32x16 da[2], dx[2];
#pragma unroll
        for (int mb = 0; mb < 2; ++mb)
#pragma unroll
            for (int r = 0; r < 16; ++r) { da[mb][r] = 0.f; dx[mb][r] = 0.f; }
#pragma unroll
        for (int ks = 0; ks < 4; ++ks) { const bf16x8 ba = *(const bf16x8*)(wa + 16 * ks), bx = *(const bf16x8*)(wx + 16 * ks);
#pragma unroll
            for (int mb = 0; mb < 2; ++mb) { da[mb] = MFMA32(af[mb][ks], ba, da[mb]); dx[mb] = MFMA32(af[mb][ks], bx, dx[mb]); } }
        const float b_a = a.in(8)[l * 512 + chn], b_x = a.in(10)[l * 512 + chn], lam = a.in(11)[l * 512 + chn];
        const float c8 = -8.f * (fmaxf(-lam, 0.f) + log1pf(__expf(-fabsf(lam)))) * LOG2E;
        Hrun = 0.f; Arun = 1.f;
#pragma unroll
        for (int mb = 0; mb < 2; ++mb) {
            float hl[16], cA[16], gA[4], gB[4];
#pragma unroll
            for (int g = 0; g < 4; ++g) { float h = 0.f, A = 1.f;
#pragma unroll
                for (int j = 0; j < 4; ++j) { const int r = 4 * g + j, tl = mb * 32 + crow(r, hi);
                    const float ra = sigmoidf_(da[mb][r] + b_a), ix = sigmoidf_(dx[mb][r] + b_x);
                    const float la2 = c8 * ra, av = fexp2(la2), mult = sqrtf(fmaxf(1.f - fexp2(2.f * la2), 0.f));
                    const float uv = bf1(U[tl * 72 + nb * 32 + l32]);
                    const float dr = mult * ix * uv;
                    h = av * h + dr; A *= av; hl[r] = h; cA[r] = A; }
                gA[g] = A; gB[g] = h; }
#pragma unroll
            for (int g = 0; g < 4; ++g) {
                const float pA = __shfl_xor(gA[g], 32), pB = __shfl_xor(gB[g], 32);
                const float A0 = hi ? pA : gA[g], B0 = hi ? pB : gB[g], A1 = hi ? gA[g] : pA, B1 = hi ? gB[g] : pB;
                const float in0 = Hrun, inA0 = Arun; Hrun = A0 * Hrun + B0; Arun *= A0;
                const float in1 = Hrun, inA1 = Arun; Hrun = A1 * Hrun + B1; Arun *= A1;
                const float my_in = hi ? in1 : in0, my_inA = hi ? inA1 : inA0;
#pragma unroll
                for (int j = 0; j < 4; ++j) { const int r = 4 * g + j, tl = mb * 32 + crow(r, hi); const size_t o = (size_t)(seq0 + t0 + tl) * 512 + chn;
                    HLOC[o] = (bf16)f2bf(hl[r] + cA[r] * my_in); CUMA[o] = (bf16)f2bf(cA[r] * my_inA); }
            }
        }
        if (hi == 0) { const size_t so = ((size_t)b * 64 + ch) * 512 + chn; SUMA[so] = Arun; SUMH[so] = Hrun; }
    }
    LDS_WAIT(); asm volatile("" ::: "memory");
}
__device__ __forceinline__ void unpack8(const v4u w, float* v) { v[0] = bflo(w.x); v[1] = bfhi(w.x); v[2] = bflo(w.y); v[3] = bfhi(w.y); v[4] = bflo(w.z); v[5] = bfhi(w.z); v[6] = bflo(w.w); v[7] = bfhi(w.w); }
__device__ __forceinline__ v4u pack8f(const float* v) { return (v4u){cvtpk(v[0], v[1]), cvtpk(v[2], v[3]), cvtpk(v[4], v[5]), cvtpk(v[6], v[7])}; }
__device__ __forceinline__ void sc_pass(const KA& a, int l, const bf16* __restrict__ SB, const bf16* __restrict__ P, bf16* Y, int gt, int ngt) {
    const float* cw = a.in(12) + (size_t)l * 3 * 512;
    for (int it = gt; it < HTOK * 64; it += ngt) {
        const int row = it >> 6, c0 = (it & 63) * 8, t = row & (SEQ - 1);
        const v4u sb = *(const v4u*)(SB + (size_t)row * 512 + c0), p2 = *(const v4u*)(P + (size_t)row * 512 + c0);
        v4u p1 = (v4u){0u, 0u, 0u, 0u}, p0 = (v4u){0u, 0u, 0u, 0u};
        if (t >= 1) p1 = *(const v4u*)(P + (size_t)(row - 1) * 512 + c0);
        if (t >= 2) p0 = *(const v4u*)(P + (size_t)(row - 2) * 512 + c0);
        float w0[8], w1[8], w2[8];
#pragma unroll
        for (int h = 0; h < 2; ++h) { const f32x4 x0 = *(const f32x4*)(cw + c0 + 4 * h), x1 = *(const f32x4*)(cw + 512 + c0 + 4 * h), x2 = *(const f32x4*)(cw + 1024 + c0 + 4 * h);
#pragma unroll
            for (int j = 0; j < 4; ++j) { w0[4 * h + j] = x0[j]; w1[4 * h + j] = x1[j]; w2[4 * h + j] = x2[j]; } }
        const unsigned s_[4] = {sb.x, sb.y, sb.z, sb.w}, q0[4] = {p0.x, p0.y, p0.z, p0.w}, q1[4] = {p1.x, p1.y, p1.z, p1.w}, q2[4] = {p2.x, p2.y, p2.z, p2.w};
        unsigned o[4];
#pragma unroll
        for (int j = 0; j < 4; ++j) { const float lo = bflo(s_[j]) * (w0[2 * j] * bflo(q0[j]) + w1[2 * j] * bflo(q1[j]) + w2[2 * j] * bflo(q2[j]));
            const float hi = bfhi(s_[j]) * (w0[2 * j + 1] * bfhi(q0[j]) + w1[2 * j + 1] * bfhi(q1[j]) + w2[2 * j + 1] * bfhi(q2[j])); o[j] = cvtpk(lo, hi); }
        *(v4u*)(Y + (size_t)row * 1536 + 1024 + c0) = (v4u){o[0], o[1], o[2], o[3]};
    }
}
__device__ __forceinline__ float gelu_tanh_f(float x) { return x * sigmoidf_(2.f * 0.7978845608028654f * (x + 0.044715f * x * x * x)); }
__device__ __forceinline__ void lru_fix_task(const bf16* __restrict__ LG, const bf16* __restrict__ HLOC, const bf16* __restrict__ CUMA, const float* __restrict__ SUMA, const float* __restrict__ SUMH,
                                             bf16* Y, LAS float* CAR, int b, int ch, int tid) {
    { float carry = 0.f; const float* pa = SUMA + (size_t)b * 64 * 512 + tid; const float* ph = SUMH + (size_t)b * 64 * 512 + tid;
#pragma unroll 8
      for (int c = 0; c < ch; ++c) carry = pa[c * 512] * carry + ph[c * 512];
      CAR[tid] = carry; }
    __syncthreads();
    const int g8 = (tid & 63) * 8; float cr[8];
#pragma unroll
    for (int j = 0; j < 8; ++j) cr[j] = CAR[g8 + j];
    const size_t r0 = (size_t)b * SEQ + ch * 64;
#pragma unroll 2
    for (int k = 0; k < 8; ++k) { const size_t row = r0 + (tid >> 6) + 8 * k, o = row * 512 + g8;
        float x[8], h[8], c[8]; unpack8(*(const v4u*)(LG + o), x); unpack8(*(const v4u*)(HLOC + o), h); unpack8(*(const v4u*)(CUMA + o), c);
#pragma unroll
        for (int j = 0; j < 8; ++j) x[j] = gelu_tanh_f(x[j]) * (h[j] + c[j] * cr[j]);
        *(v4u*)(Y + row * 1536 + 512 + g8) = pack8f(x); }
    __syncthreads();
}

__device__ __forceinline__ void ln16(float (&v)[16], const float* gam, const float* bet, int lane) {
    float s = 0.f;
#pragma unroll
    for (int j = 0; j < 16; ++j) s += v[j];
    const float mean = wave_sum(s) * (1.f / D); float s2 = 0.f;
#pragma unroll
    for (int j = 0; j < 16; ++j) { v[j] -= mean; s2 += v[j] * v[j]; }
    const float rstd = 1.f / sqrtf(wave_sum(s2) * (1.f / D) + LN_EPS);
#pragma unroll
    for (int h = 0; h < 2; ++h)
#pragma unroll
        for (int q = 0; q < 2; ++q) { const f32x4 g4 = *(const f32x4*)(gam + 512 * h + 8 * lane + 4 * q), b4 = *(const f32x4*)(bet + 512 * h + 8 * lane + 4 * q);
#pragma unroll
            for (int j = 0; j < 4; ++j) v[8 * h + 4 * q + j] = v[8 * h + 4 * q + j] * rstd * g4[j] + b4[j]; }
}

__device__ __forceinline__ void p6_ln1_router(const KA& a, int l, LAS unsigned char* lds, int G, int tid, int wave, int lane) {
    unsigned char* ws = a.ws(); bf16* H = (bf16*)(ws + WS_H); float* WTS = (float*)(ws + WS_WTS); unsigned* LIST = (unsigned*)(ws + WS_LIST); gu32* ctl = (gu32*)(ws + WS_CTL);
    LAS float* RW = (LAS float*)lds;
    LAS int* ENT = (LAS int*)(lds + 81920);
    LAS int* RANK = ENT + 256;
    LAS unsigned* LCNT = (LAS unsigned*)(RANK + 256);
    LAS unsigned* LBASE = LCNT + 16;
    LAS float* LGS = (LAS float*)(lds + 81920 + 4096) + wave * (16 * 20 * 4);
    { const float* wg = a.in(19) + (size_t)l * 1024 * 4; const float* we = a.in(21) + (size_t)l * 1024 * 16;
      for (int i = tid; i < 1024 * 4; i += 512) RW[(i & 3) * 1024 + (i >> 2)] = wg[i];
      for (int i = tid; i < 1024 * 16; i += 512) RW[(4 + (i & 15)) * 1024 + (i >> 4)] = we[i]; }
    __syncthreads();
    const float* gam = a.in(17) + l * D; const float* bet = a.in(18) + l * D; const float* gbias = a.in(20) + l * 4; const float* ebias = a.in(22) + l * 16;
    for (int rb = blockIdx.x; rb < NTOK / 128; rb += G) {
        if (tid < 16) LCNT[tid] = 0u;
#pragma unroll 1
        for (int grp = 0; grp < 4; ++grp) {
            float v[4][16];
#pragma unroll
            for (int r = 0; r < 4; ++r) { bf16* hp = H + (size_t)(rb * 128 + wave * 16 + grp * 4 + r) * D; unpack8(*(const v4u*)(hp + 8 * lane), v[r]); unpack8(*(const v4u*)(hp + 512 + 8 * lane), v[r] + 8); }
#pragma unroll
            for (int r = 0; r < 4; ++r) { ln16(v[r], gam, bet, lane); bf16* hp = H + (size_t)(rb * 128 + wave * 16 + grp * 4 + r) * D; *(v4u*)(hp + 8 * lane) = pack8f(v[r]); *(v4u*)(hp + 512 + 8 * lane) = pack8f(v[r] + 8); }
#pragma unroll 2
            for (int o = 0; o < 20; ++o) { const LAS float* w = RW + o * 1024 + 8 * lane; float wv[16];
#pragma unroll
                for (int h = 0; h < 2; ++h) { const f32x4 w0 = *(const LAS f32x4*)(w + 512 * h), w1 = *(const LAS f32x4*)(w + 512 * h + 4);
                    wv[8 * h] = w0.x; wv[8 * h + 1] = w0.y; wv[8 * h + 2] = w0.z; wv[8 * h + 3] = w0.w; wv[8 * h + 4] = w1.x; wv[8 * h + 5] = w1.y; wv[8 * h + 6] = w1.z; wv[8 * h + 7] = w1.w; }
#pragma unroll
                for (int r = 0; r < 4; ++r) { float s = 0.f;
#pragma unroll
                    for (int j = 0; j < 16; ++j) s += v[r][j] * wv[j];
                    s = row16_sum(s);
                    if ((lane & 15) == 0) LGS[((grp * 4 + r) * 20 + o) * 4 + (lane >> 4)] = s; } }
        }
        LDS_WAIT(); asm volatile("" ::: "memory");
        if (lane < 16) {
            const int rl = wave * 16 + lane, row = rb * 128 + rl; float lg[20];
#pragma unroll
            for (int o = 0; o < 20; ++o) { const f32x4 p = *(const LAS f32x4*)(LGS + (lane * 20 + o) * 4); lg[o] = (p.x + p.y) + (p.z + p.w); }
            int gs = 0; float bestg = lg[0] + gbias[0];
#pragma unroll
            for (int g = 1; g < 4; ++g) { const float x = lg[g] + gbias[g]; if (x > bestg) { bestg = x; gs = g; } }
            const float gmax = fmaxf(fmaxf(lg[0], lg[1]), fmaxf(lg[2], lg[3]));
            float gden = 0.f, gnum = 0.f;
#pragma unroll
            for (int g = 0; g < 4; ++g) { const float e = __expf(lg[g] - gmax); gden += e; gnum = (g == gs) ? e : gnum; }
            const float gprob = gnum / gden;
            float ein[4], eb[4];
#pragma unroll
            for (int i = 0; i < 4; ++i) { ein[i] = gs == 0 ? lg[4 + i] : gs == 1 ? lg[8 + i] : gs == 2 ? lg[12 + i] : lg[16 + i]; eb[i] = ein[i] + ebias[gs * 4 + i]; }
            int i0 = 0; float b0 = eb[0];
#pragma unroll
            for (int i = 1; i < 4; ++i) if (eb[i] > b0) { b0 = eb[i]; i0 = i; }
            int i1 = -1; float b1 = 0.f;
#pragma unroll
            for (int i = 0; i < 4; ++i) if (i != i0 && (i1 < 0 || eb[i] > b1)) { b1 = eb[i]; i1 = i; }
            const float x0 = i0 == 0 ? ein[0] : i0 == 1 ? ein[1] : i0 == 2 ? ein[2] : ein[3], x1 = i1 == 0 ? ein[0] : i1 == 1 ? ein[1] : i1 == 2 ? ein[2] : ein[3];
            const float mx = fmaxf(x0, x1), e0 = __expf(x0 - mx), e1 = __expf(x1 - mx), inv = gprob / (e0 + e1);
            *(pg8::f32x2*)(WTS + (size_t)row * 2) = (pg8::f32x2){e0 * inv, e1 * inv}; ENT[rl * 2] = gs * 4 + i0; ENT[rl * 2 + 1] = gs * 4 + i1;
        }
        __syncthreads();
        if (tid < 256) RANK[tid] = (int)__hip_atomic_fetch_add((LAS unsigned*)&LCNT[ENT[tid]], 1u, __ATOMIC_RELAXED, __HIP_MEMORY_SCOPE_WORKGROUP);
        __syncthreads();
        if (tid < 16) LBASE[tid] = __hip_atomic_fetch_add(ctl + CW_CNT + (l * 16 + tid) * 64, LCNT[tid], RLX_AGENT);
        __syncthreads();
        if (tid < 256) { const int e = ENT[tid]; LIST[(size_t)e * LISTCAP + LBASE[e] + RANK[tid]] = (unsigned)((rb * 128 + (tid >> 1)) * 2 + (tid & 1)); }
        __syncthreads();
    }
}
__device__ __forceinline__ void moe_table(const KA& a, int l, LAS int* tab, int tid) {
    gu32* ctl = (gu32*)(a.ws() + WS_CTL);
    if (tid < 16) tab[17 + tid] = (int)__hip_atomic_load(ctl + CW_CNT + (l * 16 + tid) * 64, RLX_AGENT);
    __syncthreads();
    if (tid == 0) { int s = 0; for (int e = 0; e < 16; ++e) { tab[e] = s; s += (tab[17 + e] + 255) >> 8; } tab[16] = s; }
    __syncthreads();
}
__device__ __forceinline__ void p9_ln2(const KA& a, int l, int gw, int NGW, int lane) {
    unsigned char* ws = a.ws(); bf16* H = (bf16*)(ws + WS_H); const float* WTS = (const float*)(ws + WS_WTS); const bf16* F0 = (const bf16*)(ws + WS_FFN); const bf16* F1 = F0 + (size_t)NTOK * D;
    const float* gam = a.in(26) + l * D; const float* bet = a.in(27) + l * D;
    for (int row = gw; row < NTOK; row += NGW) {
        bf16* hp = H + (size_t)row * D; const bf16* f0 = F0 + (size_t)row * D; const bf16* f1 = F1 + (size_t)row * D; const float w0 = WTS[(size_t)row * 2], w1 = WTS[(size_t)row * 2 + 1];
        float v[16], x[8], y[8];
#pragma unroll
        for (int h = 0; h < 2; ++h) { unpack8(*(const v4u*)(hp + 512 * h + 8 * lane), v + 8 * h); unpack8(*(const v4u*)(f0 + 512 * h + 8 * lane), x); unpack8(*(const v4u*)(f1 + 512 * h + 8 * lane), y);
#pragma unroll
            for (int j = 0; j < 8; ++j) v[8 * h + j] = ALPHA * v[8 * h + j] + w0 * x[j] + w1 * y[j]; }
        ln16(v, gam, bet, lane);
        if (l == DEPTH - 1) { float* op = a.out() + (size_t)row * D;
#pragma unroll
            for (int h = 0; h < 2; ++h) { *(f32x4*)(op + 512 * h + 8 * lane) = (f32x4){v[8 * h], v[8 * h + 1], v[8 * h + 2], v[8 * h + 3]}; *(f32x4*)(op + 512 * h + 8 * lane + 4) = (f32x4){v[8 * h + 4], v[8 * h + 5], v[8 * h + 6], v[8 * h + 7]}; } }
        else { *(v4u*)(hp + 8 * lane) = pack8f(v); *(v4u*)(hp + 512 + 8 * lane) = pack8f(v + 8); }
    }
}

#ifndef PH_MASK
#define PH_MASK 0xFFFF
#endif
#ifndef REP_MASK
#define REP_MASK 0
#endif
#define REPS(bit) for (int rep_ = 0; rep_ < ((REP_MASK & (bit)) ? 2 : 1); ++rep_)
#ifndef STOP_AT
#define STOP_AT 0
#endif
#define STOP_DUMP(n, off) do { if (STOP_AT == (n) && l == 0 && hf == 0) { PHASE_BEGIN const bf16* H_ = (const bf16*)(ws + (off)); float* o_ = A_.out(); for (size_t i = (size_t)bx * 512 + tid; i < (size_t)NTOK * D; i += (size_t)G * 512) o_[i] = bf1(H_[i]); return; } } while (0)
#define STOP_HERE(n) do { if (STOP_AT == (n)) { PHASE_BEGIN const bf16* H_ = (const bf16*)(ws + WS_H); float* o_ = A_.out(); for (size_t i = (size_t)bx * 512 + tid; i < (size_t)NTOK * D; i += (size_t)G * 512) o_[i] = bf1(H_[i]); return; } } while (0)
__global__ void __launch_bounds__(NWAVES * 64, 2) hybrid_fwd(Args args) {
    extern __shared__ __attribute__((aligned(16))) unsigned char lds_raw[];
    LAS unsigned char* lds = (LAS unsigned char*)lds_raw;
    const int G = gridDim.x, bx = blockIdx.x;
#define PHASE_BEGIN KA A_; A_.kp = (KP)__builtin_amdgcn_kernarg_segment_ptr(); asm volatile("" : "+s"(A_.kp)); int tid = threadIdx.x; asm volatile("" : "+v"(tid)); \
    const int lane = tid & 63, wave = __builtin_amdgcn_readfirstlane(tid >> 6), gw = bx * NWAVES + wave, NGW = G * NWAVES; unsigned char* ws = A_.ws(); (void)lane; (void)gw; (void)NGW; (void)ws;
    XcdBarrier bar;
    { PHASE_BEGIN
      for (int u = tid; u < (LDS_BYTES - LDSCTL_OFF) / 4; u += NWAVES * 64) ((LAS unsigned*)(lds + LDSCTL_OFF))[u] = 0u;
      __syncthreads();
      bar = xcd_barrier_post((unsigned*)(ws + WS_CTL) + CW_BAR, (volatile LAS unsigned*)(lds + MISC_OFF) + 8);
      REPS(1) if (PH_MASK & 1) p0_prologue(A_, lds, gw, NGW, wave, lane); }
    xcd_barrier(bar);
    STOP_HERE(1);

#pragma unroll 1
    for (int l = 0; l < DEPTH; ++l) {
#pragma unroll 1
        for (int hf = 0; hf < 2; ++hf) {
            REPS(2) if (PH_MASK & 2) { PHASE_BEGIN
              InprojSched S; S.G = G; S.c = bx; S.Hh = (const char*)(ws + WS_H) + (size_t)hf * HTOK * D * 2; S.Win = (const char*)(ws + WS_WIN) + (size_t)l * PROJ * 1024 * 2;
              EpiInproj E{(bf16*)(ws + WS_ZC), (bf16*)(ws + WS_G), (bf16*)(ws + WS_VT), A_.in(4) + (size_t)l * 3 * 1024};
              pg8::gemm_phase<EpiInproj, InprojSched, true, false>(lds, pg8::Gemm{1024, 1024, 1024}, S, E); }
            xcd_barrier(bar);
            STOP_DUMP(10, WS_ZC); STOP_DUMP(11, WS_ZC + 64 * MiB); STOP_DUMP(12, WS_ZC + 128 * MiB); STOP_DUMP(13, WS_ZC + 144 * MiB);
            REPS(4) if (PH_MASK & 4) { PHASE_BEGIN
              bf16* ZC = (bf16*)(ws + WS_ZC); bf16* Y = (bf16*)(ws + WS_Y); bf16* HLOC = (bf16*)(ws + WS_MRG); bf16* CUMA = HLOC + (size_t)HTOK * 512; float* SUMA = (float*)(ws + WS_SUM); float* SUMH = SUMA + 4 * 64 * 512;
              LAS bf16* U = (LAS bf16*)(lds + wave * 9216);
              for (int t = gw; t < 4 * 64 * 8; t += NGW) lru_local_task(A_, l, ZC + (size_t)2 * HTOK * 512, HLOC, CUMA, SUMA, SUMH, (const bf16*)(ws + WS_LRUW), U, t >> 9, (t >> 3) & 63, t & 7, lane);
              for (int t = gw; t < 4 * 8 * 128; t += NGW) sb_attn_task(ZC, ZC + (size_t)HTOK * 512, (const bf16*)(ws + WS_VT), Y, t >> 10, (t >> 7) & 7, t & 127, lane);
              sc_pass(A_, l, ZC + (size_t)4 * HTOK * 512, ZC + (size_t)5 * HTOK * 512, Y, bx * 512 + tid, G * 512); }
            xcd_barrier(bar);
            STOP_DUMP(20, WS_Y); STOP_DUMP(21, WS_MRG);
            REPS(8) if (PH_MASK & 8) { PHASE_BEGIN
              const bf16* HLOC = (const bf16*)(ws + WS_MRG); const bf16* CUMA = HLOC + (size_t)HTOK * 512; const float* SUMA = (const float*)(ws + WS_SUM); const float* SUMH = SUMA + 4 * 64 * 512;
              for (int t = bx; t < 4 * 64; t += G) lru_fix_task((const bf16*)(ws + WS_ZC) + (size_t)3 * HTOK * 512, HLOC, CUMA, SUMA, SUMH, (bf16*)(ws + WS_Y), (LAS float*)lds, t >> 6, t & 63, tid); }
            xcd_barrier(bar);
            STOP_DUMP(30, WS_Y);
            REPS(16) if (PH_MASK & 16) { PHASE_BEGIN
              BranchSched S; S.G = G; S.c = bx; S.Y = (const char*)(ws + WS_Y); S.WBR = (const char*)(ws + WS_WBR) + (size_t)l * 1024 * 1536 * 2;
              EpiBranch E{(const bf16*)(ws + WS_G), (bf16*)(ws + WS_MRG)};
              pg8::gemm_phase<EpiBranch, BranchSched, true, false>(lds, pg8::Gemm{512, 1536, 1536}, S, E); }
            xcd_barrier(bar);
            STOP_DUMP(40, WS_MRG);
            if (PH_MASK & 32) { PHASE_BEGIN
              PlainSched S; S.G = G; S.c = bx; S.nM = 64; S.nN = 4; S.A = (const char*)(ws + WS_MRG); S.B = (const char*)(ws + WS_WOUT) + (size_t)l * 1024 * 1024 * 2; S.astep = (size_t)256 * 1024 * 2; S.bstep = (size_t)256 * 1024 * 2;
              EpiOutproj E{(bf16*)(ws + WS_H) + (size_t)hf * HTOK * D};
              pg8::gemm_phase<EpiOutproj, PlainSched, true, false>(lds, pg8::Gemm{1024, 1024, 1024}, S, E); }
            xcd_barrier(bar);
            STOP_DUMP(50, WS_H);
        }
        STOP_HERE(2);
        if (PH_MASK & 64) { PHASE_BEGIN p6_ln1_router(A_, l, lds, G, tid, wave, lane); }
        xcd_barrier(bar);
        STOP_HERE(3);
        REPS(128) if (PH_MASK & 128) { PHASE_BEGIN
          LAS int* tab = (LAS int*)(lds + MOE_OFF);
          moe_table(A_, l, tab, tid);
          MoeSched S; S.G = G; S.c = bx; S.tab = tab; S.Abase = (const char*)(ws + WS_H); S.atile = 0; S.Wbase = (const char*)(ws + WS_WGU) + (size_t)l * NEXP * 1024 * 1024 * 2; S.wstride = (size_t)1024 * 1024 * 2; S.bstep = (size_t)256 * 1024 * 2;
          S.list = (const unsigned*)(ws + WS_LIST);
          EpiGateUp E{(bf16*)(ws + WS_HB)};
          pg8::gemm_phase<EpiGateUp, MoeSched, true, true>(lds, pg8::Gemm{1024, 1024, 1024}, S, E); }
        xcd_barrier(bar);
        REPS(256) if (PH_MASK & 256) { PHASE_BEGIN
          LAS int* tab = (LAS int*)(lds + MOE_OFF);
          moe_table(A_, l, tab, tid);
          MoeSched S; S.G = G; S.c = bx; S.tab = tab; S.Abase = (const char*)(ws + WS_HB); S.atile = (size_t)256 * 512 * 2; S.Wbase = (const char*)(ws + WS_WDN) + (size_t)l * NEXP * 1024 * 512 * 2; S.wstride = (size_t)1024 * 512 * 2; S.bstep = (size_t)256 * 512 * 2;
          S.list = (const unsigned*)(ws + WS_LIST);
          EpiDown E{(bf16*)(ws + WS_FFN), (const unsigned*)(ws + WS_LIST)};
          pg8::gemm_phase<EpiDown, MoeSched, true, false>(lds, pg8::Gemm{512, 512, 512}, S, E); }
        xcd_barrier(bar);
        if (PH_MASK & 512) { PHASE_BEGIN p9_ln2(A_, l, gw, NGW, lane); }
        if (l + 1 < DEPTH) xcd_barrier(bar);
        STOP_HERE(4);
    }
}

extern "C" void kernel_launch(void* const* d_in, const int* in_sizes, int n_in, void* d_out, int out_size, void* d_ws, size_t ws_size, hipStream_t stream) {
    static int grid = 0;
    if (grid == 0) {
        if (n_in != 28 || in_sizes[0] != NTOK * D || out_size != NTOK * D || ws_size < WS_END) { fprintf(stderr, "kernel_launch: unexpected shapes (n_in %d, in0 %d, out %d, ws %zu); nothing launched\n", n_in, n_in > 0 ? in_sizes[0] : -1, out_size, ws_size); grid = -1; return; }
        int dev = 0, cus = 0, per_cu = 0;
        if (hipGetDevice(&dev) != hipSuccess || hipDeviceGetAttribute(&cus, hipDeviceAttributeMultiprocessorCount, dev) != hipSuccess) { grid = -1; return; }
        if (hipFuncSetAttribute((const void*)hybrid_fwd, hipFuncAttributeMaxDynamicSharedMemorySize, LDS_BYTES) != hipSuccess) { fprintf(stderr, "kernel_launch: hipFuncSetAttribute failed\n"); grid = -1; return; }
        if (hipOccupancyMaxActiveBlocksPerMultiprocessor(&per_cu, (const void*)hybrid_fwd, NWAVES * 64, LDS_BYTES) != hipSuccess || per_cu < 1) fprintf(stderr, "kernel_launch: occupancy query reports %d\n", per_cu);
        (void)hipGetLastError();
        grid = cus;
    }
    if (grid < 0) return;
    if (hipMemsetAsync((char*)d_ws + WS_CTL, 0, CTL_ZERO_BYTES, stream) != hipSuccess) return;
    Args a{};
    for (int i = 0; i < 28; ++i) a.in[i] = (const float*)d_in[i];
    a.out = (float*)d_out; a.ws = (unsigned char*)d_ws;
    hipLaunchKernelGGL(hybrid_fwd, dim3(grid), dim3(NWAVES * 64), LDS_BYTES, stream, a);
}
```

```cpp
#include <hip/hip_runtime.h>
#include <cstdio>
#include <cstdint>
namespace pg8 {
#define PG8_LAS __attribute__((address_space(3)))
typedef unsigned short bf16_t;
typedef short bf16x8 __attribute__((ext_vector_type(8)));
typedef float f32x4 __attribute__((ext_vector_type(4)));
typedef float f32x2 __attribute__((ext_vector_type(2)));
typedef unsigned u32x4 __attribute__((ext_vector_type(4)));
typedef unsigned u32x2 __attribute__((ext_vector_type(2)));
constexpr int BM = 256, BK = 64, HALF = 128, HTB = HALF * BK * 2  , STAGE_BYTES = 8 * HTB, NXCD = 8, WGM = 8;

__host__ __device__ __forceinline__ int lds_byte(int r, int c) { const int st = (r >> 4) * 2 + (c >> 5), rr = r & 15, cc = c & 31, ob = rr * 64 + cc * 2; return st * 1024 + (ob ^ (((ob >> 9) & 1) << 5)); }
__host__ __device__ __forceinline__ void stage_rc(int b, int& R, int& C) { const int st = b / 1024, sb = b % 1024, swz = sb ^ (((sb >> 9) & 1) << 5); R = (st >> 1) * 16 + swz / 64; C = (st & 1) * 32 + (swz % 64) / 2; }
__host__ __device__ __forceinline__ int perm32(int rho) { const int n = rho >> 4, i = rho & 15; return 8 * (i >> 2) + 4 * n + (i & 3); }

struct Unit { int pm, pn, ty, aux, nv, pad; const char* A; const char* B; };
struct Gemm { int K, lda, ldb; };

__device__ __forceinline__ void tile_swz(int L, int nM, int nN, int& pm, int& pn) {
    const int nwg = nM * nN; int wgid = L; { const int q = nwg / NXCD, r = nwg % NXCD, xcd = wgid % NXCD, off = wgid / NXCD; wgid = (xcd < r ? xcd * (q + 1) : r * (q + 1) + (xcd - r) * q) + off; }
    const int nig = WGM * nN, gid = wgid / nig, fm = gid * WGM, gsz = (nM - fm) < WGM ? (nM - fm) : WGM;
    pm = fm + ((wgid % nig) % gsz); pn = (wgid % nig) / gsz;
}
__device__ __forceinline__ unsigned cvt_pk_bf16(float lo, float hi) { unsigned r; asm volatile("v_cvt_pk_bf16_f32 %0, %1, %2" : "=v"(r) : "v"(lo), "v"(hi)); return r; }

template <class Epi, class Sched, bool ALIGN_EPI, bool GATHER>
__device__ __forceinline__ void gemm_phase(PG8_LAS unsigned char* lds, const Gemm g, const Sched& S, const Epi& E) {
    int tid = threadIdx.x; asm volatile("" : "+v"(tid));
    const int wid = __builtin_amdgcn_readfirstlane(tid >> 6), lane = tid & 63, wr = wid >> 2, wc = wid & 3, fr = lane & 15, fq = lane >> 4;
    const int K = g.K, nt = K / BK;
    int sR[2], sC[2];
    unsigned cvA[2][2], nvA[2][2], voffB[2];
#pragma unroll
    for (int i = 0; i < 2; ++i) { int R, C; stage_rc(tid * 16 + i * 8192, R, C); sR[i] = R; sC[i] = C; const int Rb = Epi::PERM ? ((R & ~31) + perm32(R & 31)) : R;
        voffB[i] = (unsigned)(Rb * g.ldb + C) * 2u;
#pragma unroll
        for (int h = 0; h < 2; ++h) { cvA[h][i] = (unsigned)((h * HALF + R) * g.lda + C) * 2u; nvA[h][i] = cvA[h][i]; } }
    const size_t kstep = (size_t)(BK * 2);
    const size_t hstepB = (size_t)HALF * g.ldb * 2;
    const unsigned ldsw = (unsigned)wid * 1024u;
    const int aoff = lds_byte(wr * 64 + fr, fq * 8), boff = lds_byte(wc * 32 + fr, fq * 8);
#define PG8_SA(b, h) (((b) * 2 + (h)) * HTB)
#define PG8_SB(b, h) ((4 + (b) * 2 + (h)) * HTB)
#define PG8_STAGE(bufoff, gbase, voff) do { _Pragma("unroll") for (int _i = 0; _i < 2; ++_i) \
        __builtin_amdgcn_global_load_lds((const unsigned*)((const char*)(gbase) + (voff)[_i]), (PG8_LAS unsigned*)(lds + (bufoff) + ldsw + _i * 8192), 16, 0, 0); } while (0)
#define PG8_LDA(dst, b, h) do { _Pragma("unroll") for (int m = 0; m < 4; ++m) _Pragma("unroll") for (int k = 0; k < 2; ++k) dst[m][k] = *(const PG8_LAS bf16x8*)(lds + PG8_SA(b, h) + aoff + m * 2048 + k * 1024); } while (0)
#define PG8_LDB(dst, b, h) do { _Pragma("unroll") for (int n = 0; n < 2; ++n) _Pragma("unroll") for (int k = 0; k < 2; ++k) dst[n][k] = *(const PG8_LAS bf16x8*)(lds + PG8_SB(b, h) + boff + n * 2048 + k * 1024); } while (0)
#define PG8_MMA(ai, bj, At, Bt) do { __builtin_amdgcn_s_setprio(1); _Pragma("unroll") for (int m = 0; m < 4; ++m) _Pragma("unroll") for (int n = 0; n < 2; ++n) _Pragma("unroll") for (int k = 0; k < 2; ++k) \
        acc[ai][bj][m][n] = __builtin_amdgcn_mfma_f32_16x16x32_bf16(Bt[n][k], At[m][k], acc[ai][bj][m][n], 0, 0, 0); __builtin_amdgcn_s_setprio(0); } while (0)
#define PG8_WAIT_V(n) asm volatile("s_waitcnt vmcnt(" #n ")" ::: "memory")
#define PG8_WAIT_L(n) asm volatile("s_waitcnt lgkmcnt(" #n ")" ::: "memory")
#define PG8_BAR __builtin_amdgcn_s_barrier()
#define PG8_SCHED __builtin_amdgcn_sched_barrier(0)
    Unit cur, nxt; int ui = 0;
    if (!S.next(0, cur)) return;
    f32x4 acc[2][2][4][2];
#pragma unroll
    for (int a = 0; a < 2; ++a)
#pragma unroll
        for (int b = 0; b < 2; ++b)
#pragma unroll
            for (int m = 0; m < 4; ++m)
#pragma unroll
                for (int n = 0; n < 2; ++n) acc[a][b][m][n] = (f32x4){0.f, 0.f, 0.f, 0.f};
    bf16x8 At[4][2], B0[2][2], B1[2][2];
    const char* cA = cur.A; const char* cB = cur.B;
    asm volatile("" : "+s"(cA), "+s"(cB));
    if constexpr (GATHER) {
#pragma unroll
        for (int h = 0; h < 2; ++h)
#pragma unroll
            for (int i = 0; i < 2; ++i) cvA[h][i] = (unsigned)(S.arow(cur, h * HALF + sR[i]) * g.lda + sC[i]) * 2u;
        PG8_WAIT_V(0);
    }
    S.a_ready(cur);
    PG8_STAGE(PG8_SB(0, 0), cB, voffB); PG8_STAGE(PG8_SB(0, 1), cB + hstepB, voffB); PG8_STAGE(PG8_SA(0, 0), cA, cvA[0]); PG8_STAGE(PG8_SA(0, 1), cA, cvA[1]);
    if (wr == 1) PG8_BAR;
    PG8_WAIT_V(2); PG8_BAR;
    PG8_STAGE(PG8_SB(1, 0), cB + kstep, voffB); PG8_STAGE(PG8_SA(1, 0), cA + kstep, cvA[0]); PG8_STAGE(PG8_SB(1, 1), cB + hstepB + kstep, voffB);
    PG8_WAIT_V(6); PG8_BAR;
    for (;;) {
        const bool has_next = S.next(ui + 1, nxt);
        const char* nA = has_next ? nxt.A : cA; const char* nB = has_next ? nxt.B : cB;
        asm volatile("" : "+s"(nA), "+s"(nB));
        if constexpr (GATHER) {
            if (has_next) {
#pragma unroll
                for (int h = 0; h < 2; ++h)
#pragma unroll
                    for (int i = 0; i < 2; ++i) nvA[h][i] = (unsigned)(S.arow(nxt, h * HALF + sR[i]) * g.lda + sC[i]) * 2u;
                PG8_WAIT_V(0);
            } else {
#pragma unroll
                for (int h = 0; h < 2; ++h)
#pragma unroll
                    for (int i = 0; i < 2; ++i) nvA[h][i] = cvA[h][i];
            }
        }
        for (int t = 0; t < nt; t += 2) {
            const bool last = (t == nt - 2);
            const char* a1 = cA + (size_t)(t + 1) * kstep;
            const char* a2 = last ? nA : cA + (size_t)(t + 2) * kstep; const char* b2 = last ? nB : cB + (size_t)(t + 2) * kstep;
            const char* a3 = a2 + kstep; const char* b3 = b2 + kstep;
            unsigned o2[2][2];
#pragma unroll
            for (int h = 0; h < 2; ++h)
#pragma unroll
                for (int i = 0; i < 2; ++i) o2[h][i] = (GATHER && last) ? nvA[h][i] : cvA[h][i];
            if (last && has_next) S.a_ready(nxt);
            PG8_LDB(B0, 0, 0); PG8_LDB(B1, 0, 1); PG8_SCHED; PG8_LDA(At, 0, 0); PG8_STAGE(PG8_SA(1, 1), a1, cvA[1]);
            PG8_WAIT_V(8); PG8_WAIT_L(0); PG8_BAR; PG8_MMA(0, 0, At, B0); PG8_MMA(0, 1, At, B1); PG8_BAR; PG8_SCHED;
            PG8_LDA(At, 0, 1); PG8_STAGE(PG8_SB(0, 0), b2, voffB); PG8_STAGE(PG8_SB(0, 1), b2 + hstepB, voffB); PG8_STAGE(PG8_SA(0, 0), a2, o2[0]);
            PG8_WAIT_V(8); PG8_WAIT_L(0); PG8_BAR; PG8_MMA(1, 0, At, B0); PG8_MMA(1, 1, At, B1); PG8_BAR; PG8_SCHED;
            PG8_LDB(B0, 1, 0); PG8_LDB(B1, 1, 1); PG8_SCHED; PG8_LDA(At, 1, 0); PG8_STAGE(PG8_SA(0, 1), a2, o2[1]);
            PG8_WAIT_V(8); PG8_WAIT_L(0); PG8_BAR; PG8_MMA(0, 0, At, B0); PG8_MMA(0, 1, At, B1); PG8_BAR; PG8_SCHED;
            PG8_LDA(At, 1, 1); PG8_STAGE(PG8_SB(1, 0), b3, voffB); PG8_STAGE(PG8_SB(1, 1), b3 + hstepB, voffB); PG8_STAGE(PG8_SA(1, 0), a3, o2[0]);
            PG8_WAIT_V(8); PG8_WAIT_L(0); PG8_BAR; PG8_MMA(1, 0, At, B0); PG8_MMA(1, 1, At, B1); PG8_BAR; PG8_SCHED;
        }
        if constexpr (ALIGN_EPI) { if (wr == 0) PG8_BAR; }
        E(acc, cur, wr, wc, fr, fq); S.done(cur);
        if (!has_next) break;
#pragma unroll
        for (int a = 0; a < 2; ++a)
#pragma unroll
            for (int b = 0; b < 2; ++b)
#pragma unroll
                for (int m = 0; m < 4; ++m)
#pragma unroll
                    for (int n = 0; n < 2; ++n) acc[a][b][m][n] = (f32x4){0.f, 0.f, 0.f, 0.f};
        cur = nxt; cA = nA; cB = nB; ++ui;
        if constexpr (GATHER) {
#pragma unroll
            for (int h = 0; h < 2; ++h)
#pragma unroll
                for (int i = 0; i < 2; ++i) cvA[h][i] = nvA[h][i];
        }
        if constexpr (ALIGN_EPI) { if (wr == 1) PG8_BAR; }
    }
    PG8_WAIT_V(0);
    if constexpr (!ALIGN_EPI) { if (wr == 0) PG8_BAR; }
    PG8_BAR;
#undef PG8_SA
#undef PG8_SB
#undef PG8_STAGE
#undef PG8_LDA
#undef PG8_LDB
#undef PG8_MMA
#undef PG8_WAIT_V
#undef PG8_WAIT_L
#undef PG8_BAR
#undef PG8_SCHED
}
}
constexpr int NWAVES = 8;
constexpr int D = 1024, NTOK = 32768, SEQ = 4096, HTOK = 16384  , DEPTH = 2, NEXP = 16;
constexpr int PROJ = 7168, NMAIN = 6656;
constexpr float ALPHA = 1.41421356237309515f;
constexpr float LN_EPS = 1e-5f;
constexpr float LOG2E = 1.4426950408889634f;
constexpr float C2 = 0.125f * LOG2E;
constexpr int LISTCAP = 32768;

constexpr size_t MiB = 1u << 20;
constexpr size_t WS_CTL = 0, CTL_ZERO_BYTES = 1 * MiB;
constexpr size_t WS_WIN = 1 * MiB;
constexpr size_t WS_WBR = 29 * MiB;
constexpr size_t WS_WOUT = 35 * MiB;
constexpr size_t WS_WGU = 39 * MiB;
constexpr size_t WS_WDN = 103 * MiB;
constexpr size_t WS_LRUW = 135 * MiB;
constexpr size_t WS_H = 136 * MiB;
constexpr size_t WS_Y = 200 * MiB;
constexpr size_t WS_MRG = 248 * MiB;
constexpr size_t WS_ZC = 280 * MiB;
constexpr size_t WS_G = WS_ZC + 96 * MiB, WS_VT = WS_ZC + 192 * MiB;
constexpr size_t WS_SUM = 488 * MiB;
constexpr size_t WS_LIST = 280 * MiB;
constexpr size_t WS_WTS = 282 * MiB;
constexpr size_t WS_HB = 283 * MiB;
constexpr size_t WS_FFN = 351 * MiB;
constexpr size_t WS_END = 489 * MiB;
constexpr int CW_TMO = 0, CW_BAR = 4096, CW_CNT = 8192;

constexpr int RING_BYTES = 131072;
constexpr int LDSCTL_OFF = RING_BYTES, MISC_OFF = LDSCTL_OFF + 320, MOE_OFF = LDSCTL_OFF + 1024;
constexpr int LDS_BYTES = 147456;

#define GAS __attribute__((address_space(1)))
#define LAS __attribute__((address_space(3)))
typedef unsigned short bf16;
typedef unsigned v4u __attribute__((ext_vector_type(4)));
typedef unsigned v2u __attribute__((ext_vector_type(2)));
typedef float f32x4 __attribute__((ext_vector_type(4)));
typedef float f32x16 __attribute__((ext_vector_type(16)));
typedef short bf16x8 __attribute__((ext_vector_type(8)));
typedef GAS unsigned gu32;
#define RLX_AGENT __ATOMIC_RELAXED, __HIP_MEMORY_SCOPE_AGENT
#define LDS_WAIT() asm volatile("s_waitcnt lgkmcnt(0)" ::: "memory")
#define VM_WAIT() asm volatile("s_waitcnt vmcnt(0)" ::: "memory")
__device__ __forceinline__ unsigned f2bf(float f) { unsigned u = __builtin_bit_cast(unsigned, f); return (u + 0x7fffu + ((u >> 16) & 1u)) >> 16; }
__device__ __forceinline__ unsigned pk2(float lo, float hi) { return f2bf(lo) | (f2bf(hi) << 16); }
typedef float f32x2_t __attribute__((ext_vector_type(2))); typedef __bf16 bf16x2_t __attribute__((ext_vector_type(2)));
__device__ __forceinline__ unsigned cvtpk(float lo, float hi) { f32x2_t v = {lo, hi}; bf16x2_t b = __builtin_convertvector(v, bf16x2_t); return __builtin_bit_cast(unsigned, b); }
__device__ __forceinline__ float bflo(unsigned w) { return __builtin_bit_cast(float, w << 16); }
__device__ __forceinline__ float bfhi(unsigned w) { return __builtin_bit_cast(float, w & 0xffff0000u); }
__device__ __forceinline__ float bf1(bf16 b) { return __builtin_bit_cast(float, ((unsigned)b) << 16); }
__device__ __forceinline__ float fexp2(float x) { return __builtin_amdgcn_exp2f(x); }
__device__ __forceinline__ float flog2(float x) { return __builtin_amdgcn_logf(x); }
__device__ __forceinline__ float frcp(float x) { return __builtin_amdgcn_rcpf(x); }
__device__ __forceinline__ float sigmoidf_(float x) { return frcp(1.f + fexp2(-LOG2E * x)); }
#define DPP_ADD(v, ctrl) ((v) + __builtin_bit_cast(float, __builtin_amdgcn_update_dpp(0, __builtin_bit_cast(int, (v)), (ctrl), 0xF, 0xF, true)))
__device__ __forceinline__ float row16_sum(float v) { v = DPP_ADD(v, 0xB1); v = DPP_ADD(v, 0x4E); v = DPP_ADD(v, 0x141); v = DPP_ADD(v, 0x140); return v; }
__device__ __forceinline__ float wave_sum(float v) {
    v = row16_sum(v); const int iv = __builtin_bit_cast(int, v);
    const float a = __builtin_bit_cast(float, __builtin_amdgcn_readlane(iv, 0)), b = __builtin_bit_cast(float, __builtin_amdgcn_readlane(iv, 16)),
                c = __builtin_bit_cast(float, __builtin_amdgcn_readlane(iv, 32)), d = __builtin_bit_cast(float, __builtin_amdgcn_readlane(iv, 48));
    return (a + b) + (c + d);
}
#define XB_TMO      128
#define XB_XCNT(j)  (256  + 64 * (j))
#define XB_XSUB(j)  (1280 + 64 * (j))
#define XB_XGEN(j)  (2304 + 64 * (j))
#define XB_TOP      3328
#define XB_TOPGEN   3392
#define XCD_BAR_WORDS 3456
#define XB_SPIN_CAP (1u << 18)

__device__ __forceinline__ unsigned xb_ld(unsigned* p)              { return __hip_atomic_load(p, __ATOMIC_RELAXED, __HIP_MEMORY_SCOPE_AGENT); }
__device__ __forceinline__ unsigned xb_add(unsigned* p, unsigned v) { return __hip_atomic_fetch_add(p, v, __ATOMIC_RELAXED, __HIP_MEMORY_SCOPE_AGENT); }
__device__ __forceinline__ unsigned xb_xcc_id() { return (unsigned)__builtin_amdgcn_s_getreg((3 << 11) | 20) & 0xFu; }
#define XB_SPIN(cond, bar) do { unsigned _sp = 0; while (cond) { __builtin_amdgcn_s_sleep(1); \
    if ((++_sp & 255u) == 0u) { if (xb_ld(&(bar)[XB_TMO])) break; if (_sp > XB_SPIN_CAP) { atomicAdd(&(bar)[XB_TMO], 1u); break; } } } } while (0)

struct XcdBarrier {
    unsigned* bar; unsigned x;
    volatile LAS unsigned* st;
};

__device__ __forceinline__ XcdBarrier xcd_barrier_post(unsigned* bar, volatile LAS unsigned* st) {
    XcdBarrier b; b.bar = bar; b.x = xb_xcc_id(); b.st = st;
    if (threadIdx.x == 0) (void)xb_add(&bar[XB_XCNT(b.x)], 1u);
    return b;
}
__device__ __forceinline__ void xcd_barrier_complete(unsigned* bar, unsigned x, unsigned& nloc, unsigned& nx) {
    const unsigned G = gridDim.x * gridDim.y * gridDim.z;
    unsigned sum, cnt, mine, sp = 0u;
    for (;;) {
        sum = 0u; cnt = 0u; mine = 0u;
#pragma unroll
        for (unsigned j = 0; j < 16; ++j) { const unsigned c = xb_ld(&bar[XB_XCNT(j)]); sum += c; cnt += (c > 0u) ? 1u : 0u; mine = (j == x) ? c : mine; }
        if (sum == G) break;
        __builtin_amdgcn_s_sleep(1);
        if ((++sp & 255u) == 0u) { if (xb_ld(&bar[XB_TMO])) break; if (sp > XB_SPIN_CAP) { atomicAdd(&bar[XB_TMO], 1u); break; } }
    }
    nloc = mine > 0u ? mine : 1u; nx = cnt > 0u ? cnt : 1u;
}

__device__ __forceinline__ void xcd_barrier(const XcdBarrier& b) {
    asm volatile("s_waitcnt vmcnt(0)" ::: "memory");
    __syncthreads();
    if (threadIdx.x == 0) {
        unsigned* bar = b.bar;
        __builtin_amdgcn_s_waitcnt(0);
        unsigned nloc = b.st[0], nx = b.st[1];
        if (nloc == 0u) { xcd_barrier_complete(bar, b.x, nloc, nx); b.st[0] = nloc; b.st[1] = nx; }
        const unsigned old = xb_add(&bar[XB_XSUB(b.x)], 1u);
        const unsigned gen = old / nloc;
        if (old + 1u == (gen + 1u) * nloc) {
            __builtin_amdgcn_fence(__ATOMIC_RELEASE, "agent");
            asm volatile("s_waitcnt vmcnt(0)" ::: "memory");
            const unsigned og = xb_add(&bar[XB_TOP], 1u);
            const unsigned tg = og / nx;
            if (og + 1u == (tg + 1u) * nx) xb_add(&bar[XB_TOPGEN], 1u);
            else XB_SPIN(xb_ld(&bar[XB_TOPGEN]) == tg, bar);
            __builtin_amdgcn_fence(__ATOMIC_ACQUIRE, "agent");
            xb_add(&bar[XB_XGEN(b.x)], 1u);
            asm volatile("s_waitcnt vmcnt(0)" ::: "memory");
        } else {
            XB_SPIN(xb_ld(&bar[XB_XGEN(b.x)]) == gen, bar);
            __builtin_amdgcn_fence(__ATOMIC_ACQUIRE, "agent");
            asm volatile("s_waitcnt vmcnt(0)" ::: "memory");
        }
    }
    __syncthreads();
}
using pg8::Unit;
struct NoHooks { __device__ __forceinline__ void a_ready(const Unit&) const {} __device__ __forceinline__ void done(const Unit&) const {} };

struct InprojSched : NoHooks {
    int G, c; const char* Hh; const char* Win;
    __device__ __forceinline__ bool next(int i, Unit& u) const {
        const int L = i * G + c; if (L >= 1792) return false;
        if (L < 1664) { pg8::tile_swz(L, 64, 26, u.pm, u.pn); u.ty = 0; u.A = Hh + (size_t)u.pm * 256 * 2048; u.B = Win + (size_t)u.pn * 256 * 2048; }
        else { const int j = L - 1664; u.pm = j & 1; u.pn = j >> 1; u.ty = 1; u.A = Win + (size_t)(NMAIN + 256 * u.pm) * 2048; u.B = Hh + (size_t)u.pn * 256 * 2048; }
        u.aux = 0; u.nv = 0; u.pad = 0; return true;
    }
};
struct EpiInproj {
    static constexpr bool PERM = true;
    bf16* ZC; bf16* G0; bf16* VT; const float* gate_b;
    __device__ __forceinline__ void operator()(const pg8::f32x4 (&acc)[2][2][4][2], const Unit& u, int wr, int wc, int fr, int fq) const {
        int row0 = u.pm * 256 + wr * 64 + fr; asm volatile("" : "+v"(row0));
        if (u.ty == 0 && u.pn >= 10 && u.pn < 14) {
            bf16* base = ZC + (size_t)5 * HTOK * 512; const int col0 = (u.pn - 10) * 128 + wc * 32 + 8 * fq;
#pragma unroll
            for (int ai = 0; ai < 2; ++ai)
#pragma unroll
                for (int m = 0; m < 4; ++m) { const pg8::f32x4 v0 = acc[ai][0][m][0] * acc[ai][1][m][0], v1 = acc[ai][0][m][1] * acc[ai][1][m][1];
                    v4u w; w.x = cvtpk(v0[0], v0[1]); w.y = cvtpk(v0[2], v0[3]); w.z = cvtpk(v1[0], v1[1]); w.w = cvtpk(v1[2], v1[3]);
                    *(v4u*)(base + (size_t)(row0 + ai * 128 + m * 16) * 512 + col0) = w; }
            return;
        }
        if (u.ty == 0 && u.pn >= 14) {
            const int b = (u.pn - 14) >> 2, col0 = ((u.pn - 14) & 3) * 256 + wc * 32 + 8 * fq; bf16* base = G0 + (size_t)b * HTOK * 1024; const float* gb = gate_b + b * 1024 + col0;
            pg8::f32x4 bv[2][2];
#pragma unroll
            for (int bj = 0; bj < 2; ++bj)
#pragma unroll
                for (int n = 0; n < 2; ++n) bv[bj][n] = *(const pg8::f32x4*)(gb + bj * 128 + 4 * n);
#pragma unroll
            for (int ai = 0; ai < 2; ++ai)
#pragma unroll
                for (int m = 0; m < 4; ++m) { bf16* rowp = base + (size_t)(row0 + ai * 128 + m * 16) * 1024 + col0;
#pragma unroll
                    for (int bj = 0; bj < 2; ++bj) { pg8::f32x4 v0 = acc[ai][bj][m][0] + bv[bj][0], v1 = acc[ai][bj][m][1] + bv[bj][1];
#pragma unroll
                        for (int j = 0; j < 4; ++j) { v0[j] = sigmoidf_(v0[j]); v1[j] = sigmoidf_(v1[j]); }
                        v4u w; w.x = cvtpk(v0[0], v0[1]); w.y = cvtpk(v0[2], v0[3]); w.z = cvtpk(v1[0], v1[1]); w.w = cvtpk(v1[2], v1[3]);
                        *(v4u*)(rowp + bj * 128) = w; } }
            return;
        }
        float sc = 1.f; const int t = u.pn >> 1;
        if (u.ty == 0 && t == 0) sc = C2;
#pragma unroll
        for (int ai = 0; ai < 2; ++ai)
#pragma unroll
            for (int m = 0; m < 4; ++m) { const int row = row0 + ai * 128 + m * 16;
#pragma unroll
                for (int bj = 0; bj < 2; ++bj) { const pg8::f32x4 v0 = acc[ai][bj][m][0] * sc, v1 = acc[ai][bj][m][1] * sc;
                    v4u w; w.x = cvtpk(v0[0], v0[1]); w.y = cvtpk(v0[2], v0[3]); w.z = cvtpk(v1[0], v1[1]); w.w = cvtpk(v1[2], v1[3]);
                    bf16* p;
                    if (u.ty == 1) { const int tok = u.pn * 256 + bj * 128 + wc * 32 + 8 * fq; p = VT + ((size_t)(row >> 6) * 256 + (tok >> 6)) * 4096 + (row & 63) * 64 + (tok & 63); }
                    else { const int col = (u.pn & 1) * 256 + bj * 128 + wc * 32 + 8 * fq;
                        if (t == 1) p = ZC + (size_t)HTOK * 512 + ((size_t)(col >> 6) * HTOK + row) * 64 + (col & 63);
                        else p = ZC + (size_t)t * HTOK * 512 + (size_t)row * 512 + col; }
                    *(v4u*)p = w; } }
    }
};

struct BranchSched : NoHooks {
    int G, c; const char* Y; const char* WBR;
    __device__ __forceinline__ bool next(int i, Unit& u) const {
        const int tile = (i / 3) * G + c, b = i % 3; if (tile >= 256) return false;
        pg8::tile_swz(tile, 64, 4, u.pm, u.pn); u.ty = b; u.aux = 0; u.nv = 0; u.pad = 0;
        u.A = Y + ((size_t)u.pm * 256 * 1536 + b * 512) * 2; u.B = WBR + ((size_t)u.pn * 256 * 1536 + b * 512) * 2; return true;
    }
};
struct EpiBranch {
    static constexpr bool PERM = true;
    const bf16* G0; bf16* MRG;
    __device__ __forceinline__ void operator()(const pg8::f32x4 (&acc)[2][2][4][2], const Unit& u, int wr, int wc, int fr, int fq) const {
        int row0 = u.pm * 256 + wr * 64 + fr; asm volatile("" : "+v"(row0)); const int col0 = u.pn * 256 + wc * 32 + 8 * fq; const bf16* gp = G0 + (size_t)u.ty * HTOK * 1024;
#pragma unroll
        for (int ai = 0; ai < 2; ++ai)
#pragma unroll
            for (int m = 0; m < 4; ++m) { const size_t off = (size_t)(row0 + ai * 128 + m * 16) * 1024 + col0;
#pragma unroll
                for (int bj = 0; bj < 2; ++bj) { const v4u gw = *(const v4u*)(gp + off + bj * 128); v4u ow = (v4u){0u, 0u, 0u, 0u}; if (u.ty != 0) ow = *(const v4u*)(MRG + off + bj * 128);
                    const pg8::f32x4 a0 = acc[ai][bj][m][0], a1 = acc[ai][bj][m][1]; v4u w;
                    w.x = cvtpk(bflo(ow.x) + bflo(gw.x) * a0[0], bfhi(ow.x) + bfhi(gw.x) * a0[1]); w.y = cvtpk(bflo(ow.y) + bflo(gw.y) * a0[2], bfhi(ow.y) + bfhi(gw.y) * a0[3]);
                    w.z = cvtpk(bflo(ow.z) + bflo(gw.z) * a1[0], bfhi(ow.z) + bfhi(gw.z) * a1[1]); w.w = cvtpk(bflo(ow.w) + bflo(gw.w) * a1[2], bfhi(ow.w) + bfhi(gw.w) * a1[3]);
                    *(v4u*)(MRG + off + bj * 128) = w; }
                if (m & 1) asm volatile("" ::: "memory"); }
    }
};

struct PlainSched : NoHooks {
    int G, c, nM, nN; const char* A; const char* B; size_t astep, bstep;
    __device__ __forceinline__ bool next(int i, Unit& u) const {
        const int L = i * G + c; if (L >= nM * nN) return false;
        pg8::tile_swz(L, nM, nN, u.pm, u.pn); u.ty = 0; u.aux = 0; u.nv = 0; u.pad = 0; u.A = A + (size_t)u.pm * astep; u.B = B + (size_t)u.pn * bstep; return true;
    }
};
struct EpiOutproj {
    static constexpr bool PERM = true;
    bf16* Hh;
    __device__ __forceinline__ void operator()(const pg8::f32x4 (&acc)[2][2][4][2], const Unit& u, int wr, int wc, int fr, int fq) const {
        int row0 = u.pm * 256 + wr * 64 + fr; asm volatile("" : "+v"(row0)); const int col0 = u.pn * 256 + wc * 32 + 8 * fq;
#pragma unroll
        for (int ai = 0; ai < 2; ++ai)
#pragma unroll
            for (int m = 0; m < 4; ++m) { bf16* rowp = Hh + (size_t)(row0 + ai * 128 + m * 16) * 1024 + col0;
#pragma unroll
                for (int bj = 0; bj < 2; ++bj) { const v4u ow = *(const v4u*)(rowp + bj * 128); const pg8::f32x4 a0 = acc[ai][bj][m][0], a1 = acc[ai][bj][m][1]; v4u w;
                    w.x = cvtpk(ALPHA * bflo(ow.x) + a0[0], ALPHA * bfhi(ow.x) + a0[1]); w.y = cvtpk(ALPHA * bflo(ow.y) + a0[2], ALPHA * bfhi(ow.y) + a0[3]);
                    w.z = cvtpk(ALPHA * bflo(ow.z) + a1[0], ALPHA * bfhi(ow.z) + a1[1]); w.w = cvtpk(ALPHA * bflo(ow.w) + a1[2], ALPHA * bfhi(ow.w) + a1[3]);
                    *(v4u*)(rowp + bj * 128) = w; }
                if (m == 3) asm volatile("" ::: "memory"); }
    }
};

struct MoeSched : NoHooks {
    int G, c; const LAS int* tab; const char* Abase; size_t atile; const char* Wbase; size_t wstride, bstep; const unsigned* list;
    __device__ __forceinline__ bool next(int i, Unit& u) const {
        const int L = i * G + c, NT = tab[16]; if (L >= NT * 4) return false;
        const int rt = L >> 2; int e = 0;
#pragma unroll 1
        while (e < 15 && rt >= tab[e + 1]) ++e;
        const int j = rt - tab[e];
        u.pm = rt; u.pn = L & 3; u.ty = e; u.aux = e * LISTCAP + j * 256; u.nv = tab[17 + e] - j * 256; u.pad = 0;
        u.A = Abase + (size_t)rt * atile; u.B = Wbase + (size_t)e * wstride + (size_t)u.pn * bstep; return true;
    }
    __device__ __forceinline__ int arow(const Unit& u, int r) const { return r < u.nv ? (int)(list[u.aux + r] >> 1) : 0; }
};
struct EpiGateUp {
    static constexpr bool PERM = true;
    bf16* HB;
    __device__ __forceinline__ void operator()(const pg8::f32x4 (&acc)[2][2][4][2], const Unit& u, int wr, int wc, int fr, int fq) const {
        int row0 = u.pm * 256 + wr * 64 + fr; asm volatile("" : "+v"(row0)); const int col0 = u.pn * 128 + wc * 32 + 8 * fq;
#pragma unroll
        for (int ai = 0; ai < 2; ++ai)
#pragma unroll
            for (int m = 0; m < 4; ++m) { pg8::f32x4 v0, v1;
#pragma unroll
                for (int j = 0; j < 4; ++j) { const float g0 = acc[ai][0][m][0][j], g1 = acc[ai][0][m][1][j]; v0[j] = g0 * sigmoidf_(g0) * acc[ai][1][m][0][j]; v1[j] = g1 * sigmoidf_(g1) * acc[ai][1][m][1][j]; }
                v4u w; w.x = cvtpk(v0[0], v0[1]); w.y = cvtpk(v0[2], v0[3]); w.z = cvtpk(v1[0], v1[1]); w.w = cvtpk(v1[2], v1[3]);
                *(v4u*)(HB + (size_t)(row0 + ai * 128 + m * 16) * 512 + col0) = w; }
    }
};
struct EpiDown {
    static constexpr bool PERM = true;
    bf16* FFN; const unsigned* list;
    __device__ __forceinline__ void operator()(const pg8::f32x4 (&acc)[2][2][4][2], const Unit& u, int wr, int wc, int fr, int fq) const {
        int r0 = wr * 64 + fr; asm volatile("" : "+v"(r0)); const int col0 = u.pn * 256 + wc * 32 + 8 * fq;
#pragma unroll
        for (int ai = 0; ai < 2; ++ai)
#pragma unroll
            for (int m = 0; m < 4; ++m) { const int r = r0 + ai * 128 + m * 16;
                if (r < u.nv) { const unsigned ent = list[u.aux + r]; bf16* rowp = FFN + ((size_t)(ent & 1u) * NTOK + (ent >> 1)) * 1024 + col0;
#pragma unroll
                    for (int bj = 0; bj < 2; ++bj) { const pg8::f32x4 v0 = acc[ai][bj][m][0], v1 = acc[ai][bj][m][1];
                        v4u w; w.x = cvtpk(v0[0], v0[1]); w.y = cvtpk(v0[2], v0[3]); w.z = cvtpk(v1[0], v1[1]); w.w = cvtpk(v1[2], v1[3]);
                        *(v4u*)(rowp + bj * 128) = w; } } }
    }
};

__device__ __forceinline__ void tr_item(const float* W, int N, int k0, int n0, bf16* dst, size_t drow0, int dpitch, int dk0, LAS float* scr, int lane) {
#pragma unroll 8
    for (int i = 0; i < 32; ++i) { const int kk = 2 * i + (lane >> 5); scr[kk * 33 + (lane & 31)] = W[(size_t)(k0 + kk) * N + n0 + (lane & 31)]; }
    LDS_WAIT(); asm volatile("" ::: "memory");
    const int c = lane & 7;
#pragma unroll
    for (int j = 0; j < 4; ++j) { const int n = (lane >> 3) + 8 * j; const LAS float* s = scr + (8 * c) * 33 + n;
        v4u o; o.x = pk2(s[0 * 33], s[1 * 33]); o.y = pk2(s[2 * 33], s[3 * 33]); o.z = pk2(s[4 * 33], s[5 * 33]); o.w = pk2(s[6 * 33], s[7 * 33]);
        *(v4u*)(dst + (drow0 + n) * (size_t)dpitch + dk0 + k0 + 8 * c) = o; }
    LDS_WAIT(); asm volatile("" ::: "memory");
}
__device__ __forceinline__ int map_in(int n0) {
    if (n0 < 1024) return n0;
    if (n0 < 1536) return NMAIN + (n0 - 1024);
    if (n0 < 3072) return n0 - 512;
    if (n0 < 3584) { const int c = n0 - 3072; return 2560 + (c >> 7) * 256 + (c & 127); }
    if (n0 < 4096) { const int c = n0 - 3584; return 2560 + (c >> 7) * 256 + 128 + (c & 127); }
    return n0 - 512;
}
struct Args { const float* in[28]; float* out; unsigned char* ws; };
typedef const __attribute__((address_space(4))) unsigned long long* KP;
struct KA { KP kp;
    __device__ __forceinline__ const float* in(int k) const { return (const float*)(const GAS float*)kp[k]; }
    __device__ __forceinline__ float* out() const { return (float*)(GAS float*)kp[28]; }
    __device__ __forceinline__ unsigned char* ws() const { return (unsigned char*)(GAS unsigned char*)kp[29]; } };

__device__ __forceinline__ void p0_prologue(const KA& a, LAS unsigned char* lds, int gw, int NGW, int wave, int lane) {
    LAS float* scr = (LAS float*)(lds + wave * 16384);
    unsigned char* ws = a.ws();
    constexpr int I_IN = 16 * 224, I_BR = 8 * 32, I_OUT = 16 * 32, I_G = 16 * 16, I_DN = 8 * 32, I_LRU = 2;
    constexpr int PER_LAYER = I_IN + 3 * I_BR + I_OUT + 16 * (2 * I_G + I_DN) + 32;
    for (int it = gw; it < DEPTH * PER_LAYER; it += NGW) {
        const int l = it / PER_LAYER; int r = it % PER_LAYER;
        if (r < I_IN) { const int kb = r / 224, nb = r % 224; tr_item(a.in(3) + (size_t)l * 1024 * PROJ, PROJ, 64 * kb, 32 * nb, (bf16*)(ws + WS_WIN) + (size_t)l * PROJ * 1024, (size_t)map_in(32 * nb), 1024, 0, scr, lane); continue; } r -= I_IN;
        if (r < 3 * I_BR) { const int b = r / I_BR, q = r % I_BR, kb = q / 32, nb = q % 32; tr_item(a.in(13 + b) + (size_t)l * 512 * 1024, 1024, 64 * kb, 32 * nb, (bf16*)(ws + WS_WBR) + (size_t)l * 1024 * 1536, (size_t)(32 * nb), 1536, b * 512, scr, lane); continue; } r -= 3 * I_BR;
        if (r < I_OUT) { const int kb = r / 32, nb = r % 32; tr_item(a.in(16) + (size_t)l * 1024 * 1024, 1024, 64 * kb, 32 * nb, (bf16*)(ws + WS_WOUT) + (size_t)l * 1024 * 1024, (size_t)(32 * nb), 1024, 0, scr, lane); continue; } r -= I_OUT;
        if (r < 16 * (2 * I_G + I_DN)) { const int e = r / (2 * I_G + I_DN); int q = r % (2 * I_G + I_DN);
            if (q < 2 * I_G) { const int up = q / I_G; q %= I_G; const int kb = q / 16, nb = q % 16, n0 = 32 * nb;
                tr_item(a.in(23 + up) + ((size_t)l * NEXP + e) * 1024 * 512, 512, 64 * kb, n0, (bf16*)(ws + WS_WGU) + ((size_t)l * NEXP + e) * 1024 * 1024, (size_t)((n0 >> 7) * 256 + up * 128 + (n0 & 127)), 1024, 0, scr, lane); }
            else { q -= 2 * I_G; const int kb = q / 32, nb = q % 32; tr_item(a.in(25) + ((size_t)l * NEXP + e) * 512 * 1024, 1024, 64 * kb, 32 * nb, (bf16*)(ws + WS_WDN) + ((size_t)l * NEXP + e) * 1024 * 512, (size_t)(32 * nb), 512, 0, scr, lane); }
            continue; } r -= 16 * (2 * I_G + I_DN);
        { const int gsel = r / 16, hd = (r % 16) / 2, nb = r % 2;
          tr_item(a.in(gsel ? 9 : 7) + ((size_t)l * 8 + hd) * 4096, 64, 0, 32 * nb, (bf16*)(ws + WS_LRUW) + (((size_t)l * 2 + gsel) * 8 + hd) * 4096, (size_t)(32 * nb), 64, 0, scr, lane); }
    }
    const float* gam = a.in(1); const float* bet = a.in(2); bf16* H = (bf16*)(ws + WS_H);
    for (int m = gw; m < NTOK; m += NGW) {
        const f32x4* xr = (const f32x4*)(a.in(0) + (size_t)m * D) + lane;
        f32x4 v[4]; float s = 0.f;
#pragma unroll
        for (int j = 0; j < 4; ++j) { v[j] = xr[64 * j]; s += (v[j].x + v[j].y) + (v[j].z + v[j].w); }
        const float mean = wave_sum(s) * (1.f / D); float s2 = 0.f;
#pragma unroll
        for (int j = 0; j < 4; ++j) { v[j] = v[j] - mean; s2 += (v[j].x * v[j].x + v[j].y * v[j].y) + (v[j].z * v[j].z + v[j].w * v[j].w); }
        const float rstd = 1.f / sqrtf(wave_sum(s2) * (1.f / D) + LN_EPS);
        unsigned long long* o8 = (unsigned long long*)(H + (size_t)m * D) + lane;
#pragma unroll
        for (int j = 0; j < 4; ++j) { const f32x4 g4 = ((const f32x4*)gam)[lane + 64 * j], b4 = ((const f32x4*)bet)[lane + 64 * j]; const f32x4 y = v[j] * rstd * g4 + b4;
            o8[64 * j] = (unsigned long long)pk2(y.x, y.y) | ((unsigned long long)pk2(y.z, y.w) << 32); }
    }
}

#define MFMA32(a, b, c) __builtin_amdgcn_mfma_f32_32x32x16_bf16((a), (b), (c), 0, 0, 0)
__device__ __forceinline__ int crow(int r, int hi) { return (r & 3) + 8 * (r >> 2) + 4 * hi; }
__device__ __forceinline__ bf16x8 pack8(const f32x16& x, int s) {
    v4u p; p.x = cvtpk(x[8 * s], x[8 * s + 1]); p.y = cvtpk(x[8 * s + 2], x[8 * s + 3]); p.z = cvtpk(x[8 * s + 4], x[8 * s + 5]); p.w = cvtpk(x[8 * s + 6], x[8 * s + 7]);
    return __builtin_bit_cast(bf16x8, p);
}
__device__ __forceinline__ float softplus2(float z) { return fmaxf(z, 0.f) + flog2(1.f + fexp2(-fabsf(z))); }

template <bool DIAG>
__device__ __forceinline__ bool sb_tile(const LAS unsigned char* kt_lds, const bf16x8 (&qf)[4], const bf16x8 (&tri)[2], bf16x8 mones,
                                        f32x16& o0, f32x16& o1, float& carry, int k0, int t0, int l32, int hi) {
    const int x = l32 & 7; const LAS unsigned char* krow = kt_lds + l32 * 128; const LAS unsigned char* vrow = kt_lds + 8192 + l32 * 128 + 8 * hi;
    f32x16 s0, s1;
#pragma unroll
    for (int r = 0; r < 16; ++r) { s0[r] = 0.f; s1[r] = 0.f; }
#pragma unroll
    for (int i = 0; i < 4; ++i) { const int po = ((2 * i + hi) ^ x) * 16;
        const bf16x8 ka = *(const LAS bf16x8*)(krow + po), kb = *(const LAS bf16x8*)(krow + 32 * 128 + po);
        s0 = MFMA32(ka, qf[i], s0); s1 = MFMA32(kb, qf[i], s1); }
    const float z00 = s0[0];
    v4u L[4];
#pragma unroll
    for (int f = 0; f < 2; ++f)
#pragma unroll
        for (int i = 0; i < 4; ++i) { const int r = 8 * f + 2 * i;
            float a0 = softplus2(s0[r]), a1 = softplus2(s0[r + 1]), b0 = softplus2(s1[r]), b1 = softplus2(s1[r + 1]);
            if (DIAG) { const int q = t0 + l32, ka = k0 + crow(r, hi), kb = k0 + crow(r + 1, hi); if (ka >= q) a0 = 0.f; if (kb >= q) a1 = 0.f; if (ka + 32 >= q) b0 = 0.f; if (kb + 32 >= q) b1 = 0.f; }
            L[f][i] = cvtpk(a0, a1); L[2 + f][i] = cvtpk(b0, b1); }
#pragma unroll
    for (int r = 0; r < 16; ++r) { s0[r] -= carry; s1[r] -= carry; }
    s0 = MFMA32(tri[0], __builtin_bit_cast(bf16x8, L[0]), s0); s0 = MFMA32(tri[1], __builtin_bit_cast(bf16x8, L[1]), s0); s0 = MFMA32(mones, __builtin_bit_cast(bf16x8, L[2]), s0); s0 = MFMA32(mones, __builtin_bit_cast(bf16x8, L[3]), s0);
    s1 = MFMA32(tri[0], __builtin_bit_cast(bf16x8, L[2]), s1); s1 = MFMA32(tri[1], __builtin_bit_cast(bf16x8, L[3]), s1);
    float tot = (z00 - carry) - s0[0];
    tot = __shfl(tot, l32);
    v4u P[4];
#pragma unroll
    for (int f = 0; f < 2; ++f)
#pragma unroll
        for (int i = 0; i < 4; ++i) { const int r = 8 * f + 2 * i;
            float a0 = fexp2(s0[r]), a1 = fexp2(s0[r + 1]), b0 = fexp2(s1[r]), b1 = fexp2(s1[r + 1]);
            if (DIAG) { const int q = t0 + l32, ka = k0 + crow(r, hi), kb = k0 + crow(r + 1, hi); if (ka >= q) a0 = 0.f; if (kb >= q) a1 = 0.f; if (ka + 32 >= q) b0 = 0.f; if (kb + 32 >= q) b1 = 0.f; }
            P[f][i] = cvtpk(a0, a1); P[2 + f][i] = cvtpk(b0, b1); }
    carry += tot;
#pragma unroll
    for (int db = 0; db < 2; ++db) {
        f32x16 o = db ? o1 : o0;
#pragma unroll
        for (int s = 0; s < 4; ++s) { const v2u lo = *(const LAS v2u*)(vrow + db * 32 * 128 + (((2 * s) ^ x) * 16)), hi8 = *(const LAS v2u*)(vrow + db * 32 * 128 + (((2 * s + 1) ^ x) * 16));
            o = MFMA32(__builtin_bit_cast(bf16x8, (v4u){lo.x, lo.y, hi8.x, hi8.y}), __builtin_bit_cast(bf16x8, P[s]), o); }
        if (db) o1 = o; else o0 = o;
    }
    return __all(carry > 150.f) != 0;
}
__device__ __forceinline__ void sb_attn_wg(const bf16* __restrict__ Q, const bf16* __restrict__ Kh, const bf16* __restrict__ VT, bf16* Y, LAS unsigned char* lds, int b, int hd, int qg, int wave, int lane) {
    const int l32 = lane & 31, hi = lane >> 5, seq0 = b * SEQ, T0 = qg * 256, t0 = T0 + 32 * wave, ktd = t0 >> 6, B = T0 >> 6;
    LAS int* FL = (LAS int*)(lds + LDSCTL_OFF + 2048);
    const int koff = (wave * 8 + (lane >> 3)) * 64 + (((lane & 7) ^ ((lane >> 3) & 7)) * 8);
    const bf16* ksrc = Kh + ((size_t)hd * HTOK + seq0) * 64 + koff; const bf16* vsrc = VT + ((size_t)hd * 256 + (seq0 >> 6)) * 4096 + koff;
#define SB_STAGE(kt) do { const unsigned so_ = (unsigned)(((kt) & 7) * 16384 + wave * 1024); \
        __builtin_amdgcn_global_load_lds((const unsigned*)(ksrc + (size_t)(kt) * 4096), (LAS unsigned*)(lds + so_), 16, 0, 0); \
        __builtin_amdgcn_global_load_lds((const unsigned*)(vsrc + (size_t)(kt) * 4096), (LAS unsigned*)(lds + so_ + 8192), 16, 0, 0); } while (0)
#pragma unroll
    for (int i = 0; i < 4; ++i) SB_STAGE(B + i);
    bf16x8 qf[4];
    { const bf16* qp = Q + (size_t)(seq0 + t0 + l32) * 512 + hd * 64 + 8 * hi;
#pragma unroll
      for (int i = 0; i < 4; ++i) qf[i] = *(const bf16x8*)(qp + 16 * i); }
    bf16x8 tri[2], mones;
#pragma unroll
    for (int i2 = 0; i2 < 2; ++i2)
#pragma unroll
        for (int j = 0; j < 8; ++j) { const int ko = 16 * i2 + 8 * (j >> 2) + 4 * hi + (j & 3); tri[i2][j] = (ko >= l32) ? (short)0xBF80 : (short)0; }
#pragma unroll
    for (int j = 0; j < 8; ++j) mones[j] = (short)0xBF80;
    f32x16 o0, o1;
#pragma unroll
    for (int r = 0; r < 16; ++r) { o0[r] = 0.f; o1[r] = 0.f; }
    float carry = 0.f; bool done = false;
    if (lane == 0) FL[wave] = 0;
#pragma unroll 1
    for (int j = 0; ; ++j) {
        asm volatile("s_waitcnt vmcnt(0)" ::: "memory");
        __syncthreads();
        const pg8::u32x4 f0 = *(const LAS pg8::u32x4*)(FL + (j & 1) * 8), f1 = *(const LAS pg8::u32x4*)(FL + (j & 1) * 8 + 4);
        if ((f0.x & f0.y & f0.z & f0.w & f1.x & f1.y & f1.z & f1.w) != 0u) break;
        if (B - j - 1 >= 0) SB_STAGE(B - j - 1);
        const int kt = ktd - j;
        if (!done) {
            if (kt < 0) done = true;
            else { const LAS unsigned char* tl = lds + (kt & 7) * 16384;
                if (j == 0) done = sb_tile<true>(tl, qf, tri, mones, o0, o1, carry, kt * 64, t0, l32, hi);
                else done = sb_tile<false>(tl, qf, tri, mones, o0, o1, carry, kt * 64, t0, l32, hi);
                if (kt == 0) done = true; }
        }
        if (lane == 0) FL[((j + 1) & 1) * 8 + wave] = done ? 1 : 0;
    }
#undef SB_STAGE
    bf16* yp = Y + (size_t)(seq0 + t0 + l32) * 1536 + hd * 64 + 4 * hi;
#pragma unroll
    for (int g = 0; g < 4; ++g) {
        *(v2u*)(yp + 8 * g) = (v2u){cvtpk(o0[4 * g], o0[4 * g + 1]), cvtpk(o0[4 * g + 2], o0[4 * g + 3])};
        *(v2u*)(yp + 32 + 8 * g) = (v2u){cvtpk(o1[4 * g], o1[4 * g + 1]), cvtpk(o1[4 * g + 2], o1[4 * g + 3])};
    }
    __syncthreads();
}

__device__ __forceinline__ void lru_local_task(const KA& a, int l, const bf16* __restrict__ LI, bf16* HLOC, bf16* CUMA, float* SUMA, float* SUMH, const bf16* __restrict__ LW,
                                               LAS bf16* U, int b, int ch, int hd, int lane) {
    const int seq0 = b * SEQ, t0 = ch * 64;
    { const int co = lane & 7, sub = lane >> 3, c0 = hd * 64 + co * 8;
      const float* cw = a.in(5) + (size_t)l * 4 * 512 + c0; const float* cb = a.in(6) + (size_t)l * 512 + c0;
      float w[4][8], bias[8];
#pragma unroll
      for (int k = 0; k < 4; ++k) { const f32x4 x0 = *(const f32x4*)(cw + k * 512), x1 = *(const f32x4*)(cw + k * 512 + 4);
          w[k][0] = x0.x; w[k][1] = x0.y; w[k][2] = x0.z; w[k][3] = x0.w; w[k][4] = x1.x; w[k][5] = x1.y; w[k][6] = x1.z; w[k][7] = x1.w; }
      { const f32x4 x0 = *(const f32x4*)(cb), x1 = *(const f32x4*)(cb + 4); bias[0] = x0.x; bias[1] = x0.y; bias[2] = x0.z; bias[3] = x0.w; bias[4] = x1.x; bias[5] = x1.y; bias[6] = x1.z; bias[7] = x1.w; }
#pragma unroll 2
      for (int it = 0; it < 8; ++it) { const int tl = it * 8 + sub, t = t0 + tl; float u[8];
#pragma unroll
          for (int j = 0; j < 8; ++j) u[j] = bias[j];
#pragma unroll
          for (int k = 0; k < 4; ++k) { const int tt = t - 3 + k; if (tt >= 0) { const v4u x = *(const v4u*)(LI + (size_t)(seq0 + tt) * 512 + c0);
              u[0] += w[k][0] * bflo(x.x); u[1] += w[k][1] * bfhi(x.x); u[2] += w[k][2] * bflo(x.y); u[3] += w[k][3] * bfhi(x.y);
              u[4] += w[k][4] * bflo(x.z); u[5] += w[k][5] * bfhi(x.z); u[6] += w[k][6] * bflo(x.w); u[7] += w[k][7] * bfhi(x.w); } }
          *(LAS v4u*)(U + tl * 72 + co * 8) = (v4u){pk2(u[0], u[1]), pk2(u[2], u[3]), pk2(u[4], u[5]), pk2(u[6], u[7])}; }
      LDS_WAIT(); asm volatile("" ::: "memory"); }
    const int l32 = lane & 31, hi = lane >> 5;
    bf16x8 af[2][4];
#pragma unroll
    for (int mb = 0; mb < 2; ++mb)
#pragma unroll
        for (int ks = 0; ks < 4; ++ks) af[mb][ks] = *(const LAS bf16x8*)(U + (mb * 32 + l32) * 72 + 16 * ks + 8 * hi);
    float Hrun = 0.f, Arun = 1.f;
#pragma unroll 1
    for (int nb = 0; nb < 2; ++nb) {
        const int chn = hd * 64 + nb * 32 + l32;
        const bf16* wa = LW + ((size_t)(l * 2 + 0) * 8 + hd) * 4096 + (nb * 32 + l32) * 64 + 8 * hi;
        const bf16* wx = LW + ((size_t)(l * 2 + 1) * 8 + hd) * 4096 + (nb * 32 + l32) * 64 + 8 * hi;
        f32x16 da[2], dx[2];
#pragma unroll
        for (int mb = 0; mb < 2; ++mb)
#pragma unroll
            for (int r = 0; r < 16; ++r) { da[mb][r] = 0.f; dx[mb][r] = 0.f; }
#pragma unroll
        for (int ks = 0; ks < 4; ++ks) { const bf16x8 ba = *(const bf16x8*)(wa + 16 * ks), bx = *(const bf16x8*)(wx + 16 * ks);
#pragma unroll
            for (int mb = 0; mb < 2; ++mb) { da[mb] = MFMA32(af[mb][ks], ba, da[mb]); dx[mb] = MFMA32(af[mb][ks], bx, dx[mb]); } }
        const float b_a = a.in(8)[l * 512 + chn], b_x = a.in(10)[l * 512 + chn], lam = a.in(11)[l * 512 + chn];
        const float c8 = -8.f * (fmaxf(-lam, 0.f) + log1pf(__expf(-fabsf(lam)))) * LOG2E;
        Hrun = 0.f; Arun = 1.f;
#pragma unroll
        for (int mb = 0; mb < 2; ++mb) {
            float hl[16], cA[16], gA[4], gB[4];
#pragma unroll
            for (int g = 0; g < 4; ++g) { float h = 0.f, A = 1.f;
#pragma unroll
                for (int j = 0; j < 4; ++j) { const int r = 4 * g + j, tl = mb * 32 + crow(r, hi);
                    const float ra = sigmoidf_(da[mb][r] + b_a), ix = sigmoidf_(dx[mb][r] + b_x);
                    const float la2 = c8 * ra, av = fexp2(la2), mult = sqrtf(fmaxf(1.f - fexp2(2.f * la2), 0.f));
                    const float uv = bf1(U[tl * 72 + nb * 32 + l32]);
                    const float dr = mult * ix * uv;
                    h = av * h + dr; A *= av; hl[r] = h; cA[r] = A; }
                gA[g] = A; gB[g] = h; }
#pragma unroll
            for (int g = 0; g < 4; ++g) {
                const float pA = __shfl_xor(gA[g], 32), pB = __shfl_xor(gB[g], 32);
                const float A0 = hi ? pA : gA[g], B0 = hi ? pB : gB[g], A1 = hi ? gA[g] : pA, B1 = hi ? gB[g] : pB;
                const float in0 = Hrun, inA0 = Arun; Hrun = A0 * Hrun + B0; Arun *= A0;
                const float in1 = Hrun, inA1 = Arun; Hrun = A1 * Hrun + B1; Arun *= A1;
                const float my_in = hi ? in1 : in0, my_inA = hi ? inA1 : inA0;
#pragma unroll
                for (int j = 0; j < 4; ++j) { const int r = 4 * g + j, tl = mb * 32 + crow(r, hi); const size_t o = (size_t)(seq0 + t0 + tl) * 512 + chn;
                    HLOC[o] = (bf16)f2bf(hl[r] + cA[r] * my_in); CUMA[o] = (bf16)f2bf(cA[r] * my_inA); }
            }
        }
        if (hi == 0) { const size_t so = ((size_t)b * 64 + ch) * 512 + chn; SUMA[so] = Arun; SUMH[so] = Hrun; }
    }
    LDS_WAIT(); asm volatile("" ::: "memory");
}
__device__ __forceinline__ void unpack8(const v4u w, float* v) { v[0] = bflo(w.x); v[1] = bfhi(w.x); v[2] = bflo(w.y); v[3] = bfhi(w.y); v[4] = bflo(w.z); v[5] = bfhi(w.z); v[6] = bflo(w.w); v[7] = bfhi(w.w); }
__device__ __forceinline__ v4u pack8f(const float* v) { return (v4u){cvtpk(v[0], v[1]), cvtpk(v[2], v[3]), cvtpk(v[4], v[5]), cvtpk(v[6], v[7])}; }
__device__ __forceinline__ void sc_pass(const KA& a, int l, const bf16* __restrict__ SB, const bf16* __restrict__ P, bf16* Y, int gt, int ngt) {
    const float* cw = a.in(12) + (size_t)l * 3 * 512;
    for (int it = gt; it < HTOK * 64; it += ngt) {
        const int row = it >> 6, c0 = (it & 63) * 8, t = row & (SEQ - 1);
        const v4u sb = *(const v4u*)(SB + (size_t)row * 512 + c0), p2 = *(const v4u*)(P + (size_t)row * 512 + c0);
        v4u p1 = (v4u){0u, 0u, 0u, 0u}, p0 = (v4u){0u, 0u, 0u, 0u};
        if (t >= 1) p1 = *(const v4u*)(P + (size_t)(row - 1) * 512 + c0);
        if (t >= 2) p0 = *(const v4u*)(P + (size_t)(row - 2) * 512 + c0);
        float w0[8], w1[8], w2[8];
#pragma unroll
        for (int h = 0; h < 2; ++h) { const f32x4 x0 = *(const f32x4*)(cw + c0 + 4 * h), x1 = *(const f32x4*)(cw + 512 + c0 + 4 * h), x2 = *(const f32x4*)(cw + 1024 + c0 + 4 * h);
#pragma unroll
            for (int j = 0; j < 4; ++j) { w0[4 * h + j] = x0[j]; w1[4 * h + j] = x1[j]; w2[4 * h + j] = x2[j]; } }
        const unsigned s_[4] = {sb.x, sb.y, sb.z, sb.w}, q0[4] = {p0.x, p0.y, p0.z, p0.w}, q1[4] = {p1.x, p1.y, p1.z, p1.w}, q2[4] = {p2.x, p2.y, p2.z, p2.w};
        unsigned o[4];
#pragma unroll
        for (int j = 0; j < 4; ++j) { const float lo = bflo(s_[j]) * (w0[2 * j] * bflo(q0[j]) + w1[2 * j] * bflo(q1[j]) + w2[2 * j] * bflo(q2[j]));
            const float hi = bfhi(s_[j]) * (w0[2 * j + 1] * bfhi(q0[j]) + w1[2 * j + 1] * bfhi(q1[j]) + w2[2 * j + 1] * bfhi(q2[j])); o[j] = cvtpk(lo, hi); }
        *(v4u*)(Y + (size_t)row * 1536 + 1024 + c0) = (v4u){o[0], o[1], o[2], o[3]};
    }
}
__device__ __forceinline__ float gelu_tanh_f(float x) { return x * sigmoidf_(2.f * 0.7978845608028654f * (x + 0.044715f * x * x * x)); }
__device__ __forceinline__ void lru_fix_task(const bf16* __restrict__ LG, const bf16* __restrict__ HLOC, const bf16* __restrict__ CUMA, const float* __restrict__ SUMA, const float* __restrict__ SUMH,
                                             bf16* Y, LAS float* CAR, int b, int ch, int tid) {
    { float carry = 0.f; const float* pa = SUMA + (size_t)b * 64 * 512 + tid; const float* ph = SUMH + (size_t)b * 64 * 512 + tid;
#pragma unroll 8
      for (int c = 0; c < ch; ++c) carry = pa[c * 512] * carry + ph[c * 512];
      CAR[tid] = carry; }
    __syncthreads();
    const int g8 = (tid & 63) * 8; float cr[8];
#pragma unroll
    for (int j = 0; j < 8; ++j) cr[j] = CAR[g8 + j];
    const size_t r0 = (size_t)b * SEQ + ch * 64;
#pragma unroll 2
    for (int k = 0; k < 8; ++k) { const size_t row = r0 + (tid >> 6) + 8 * k, o = row * 512 + g8;
        float x[8], h[8], c[8]; unpack8(*(const v4u*)(LG + o), x); unpack8(*(const v4u*)(HLOC + o), h); unpack8(*(const v4u*)(CUMA + o), c);
#pragma unroll
        for (int j = 0; j < 8; ++j) x[j] = gelu_tanh_f(x[j]) * (h[j] + c[j] * cr[j]);
        *(v4u*)(Y + row * 1536 + 512 + g8) = pack8f(x); }
    __syncthreads();
}

__device__ __forceinline__ void ln16(float (&v)[16], const float* gam, const float* bet, int lane) {
    float s = 0.f;
#pragma unroll
    for (int j = 0; j < 16; ++j) s += v[j];
    const float mean = wave_sum(s) * (1.f / D); float s2 = 0.f;
#pragma unroll
    for (int j = 0; j < 16; ++j) { v[j] -= mean; s2 += v[j] * v[j]; }
    const float rstd = 1.f / sqrtf(wave_sum(s2) * (1.f / D) + LN_EPS);
#pragma unroll
    for (int h = 0; h < 2; ++h)
#pragma unroll
        for (int q = 0; q < 2; ++q) { const f32x4 g4 = *(const f32x4*)(gam + 512 * h + 8 * lane + 4 * q), b4 = *(const f32x4*)(bet + 512 * h + 8 * lane + 4 * q);
#pragma unroll
            for (int j = 0; j < 4; ++j) v[8 * h + 4 * q + j] = v[8 * h + 4 * q + j] * rstd * g4[j] + b4[j]; }
}

__device__ __forceinline__ void p6_ln1_router(const KA& a, int l, LAS unsigned char* lds, int G, int tid, int wave, int lane) {
    unsigned char* ws = a.ws(); bf16* H = (bf16*)(ws + WS_H); float* WTS = (float*)(ws + WS_WTS); unsigned* LIST = (unsigned*)(ws + WS_LIST); gu32* ctl = (gu32*)(ws + WS_CTL);
    LAS float* RW = (LAS float*)lds;
    LAS int* ENT = (LAS int*)(lds + 81920);
    LAS int* RANK = ENT + 256;
    LAS unsigned* LCNT = (LAS unsigned*)(RANK + 256);
    LAS unsigned* LBASE = LCNT + 16;
    LAS float* LGS = (LAS float*)(lds + 81920 + 4096) + wave * (16 * 20 * 4);
    { const float* wg = a.in(19) + (size_t)l * 1024 * 4; const float* we = a.in(21) + (size_t)l * 1024 * 16;
      for (int i = tid; i < 1024 * 4; i += 512) RW[(i & 3) * 1024 + (i >> 2)] = wg[i];
      for (int i = tid; i < 1024 * 16; i += 512) RW[(4 + (i & 15)) * 1024 + (i >> 4)] = we[i]; }
    __syncthreads();
    const float* gam = a.in(17) + l * D; const float* bet = a.in(18) + l * D; const float* gbias = a.in(20) + l * 4; const float* ebias = a.in(22) + l * 16;
    for (int rb = blockIdx.x; rb < NTOK / 128; rb += G) {
        if (tid < 16) LCNT[tid] = 0u;
#pragma unroll 1
        for (int grp = 0; grp < 4; ++grp) {
            float v[4][16];
#pragma unroll
            for (int r = 0; r < 4; ++r) { bf16* hp = H + (size_t)(rb * 128 + wave * 16 + grp * 4 + r) * D; unpack8(*(const v4u*)(hp + 8 * lane), v[r]); unpack8(*(const v4u*)(hp + 512 + 8 * lane), v[r] + 8); }
#pragma unroll
            for (int r = 0; r < 4; ++r) { ln16(v[r], gam, bet, lane); bf16* hp = H + (size_t)(rb * 128 + wave * 16 + grp * 4 + r) * D; *(v4u*)(hp + 8 * lane) = pack8f(v[r]); *(v4u*)(hp + 512 + 8 * lane) = pack8f(v[r] + 8); }
#pragma unroll 2
            for (int o = 0; o < 20; ++o) { const LAS float* w = RW + o * 1024 + 8 * lane; float wv[16];
#pragma unroll
                for (int h = 0; h < 2; ++h) { const f32x4 w0 = *(const LAS f32x4*)(w + 512 * h), w1 = *(const LAS f32x4*)(w + 512 * h + 4);
                    wv[8 * h] = w0.x; wv[8 * h + 1] = w0.y; wv[8 * h + 2] = w0.z; wv[8 * h + 3] = w0.w; wv[8 * h + 4] = w1.x; wv[8 * h + 5] = w1.y; wv[8 * h + 6] = w1.z; wv[8 * h + 7] = w1.w; }
#pragma unroll
                for (int r = 0; r < 4; ++r) { float s = 0.f;
#pragma unroll
                    for (int j = 0; j < 16; ++j) s += v[r][j] * wv[j];
                    s = row16_sum(s);
                    if ((lane & 15) == 0) LGS[((grp * 4 + r) * 20 + o) * 4 + (lane >> 4)] = s; } }
        }
        LDS_WAIT(); asm volatile("" ::: "memory");
        if (lane < 16) {
            const int rl = wave * 16 + lane, row = rb * 128 + rl; float lg[20];
#pragma unroll
            for (int o = 0; o < 20; ++o) { const f32x4 p = *(const LAS f32x4*)(LGS + (lane * 20 + o) * 4); lg[o] = (p.x + p.y) + (p.z + p.w); }
            int gs = 0; float bestg = lg[0] + gbias[0];
#pragma unroll
            for (int g = 1; g < 4; ++g) { const float x = lg[g] + gbias[g]; if (x > bestg) { bestg = x; gs = g; } }
            const float gmax = fmaxf(fmaxf(lg[0], lg[1]), fmaxf(lg[2], lg[3]));
            float gden = 0.f, gnum = 0.f;
#pragma unroll
            for (int g = 0; g < 4; ++g) { const float e = __expf(lg[g] - gmax); gden += e; gnum = (g == gs) ? e : gnum; }
            const float gprob = gnum / gden;
            float ein[4], eb[4];
#pragma unroll
            for (int i = 0; i < 4; ++i) { ein[i] = gs == 0 ? lg[4 + i] : gs == 1 ? lg[8 + i] : gs == 2 ? lg[12 + i] : lg[16 + i]; eb[i] = ein[i] + ebias[gs * 4 + i]; }
            int i0 = 0; float b0 = eb[0];
#pragma unroll
            for (int i = 1; i < 4; ++i) if (eb[i] > b0) { b0 = eb[i]; i0 = i; }
            int i1 = -1; float b1 = 0.f;
#pragma unroll
            for (int i = 0; i < 4; ++i) if (i != i0 && (i1 < 0 || eb[i] > b1)) { b1 = eb[i]; i1 = i; }
            const float x0 = i0 == 0 ? ein[0] : i0 == 1 ? ein[1] : i0 == 2 ? ein[2] : ein[3], x1 = i1 == 0 ? ein[0] : i1 == 1 ? ein[1] : i1 == 2 ? ein[2] : ein[3];
            const float mx = fmaxf(x0, x1), e0 = __expf(x0 - mx), e1 = __expf(x1 - mx), inv = gprob / (e0 + e1);
            *(pg8::f32x2*)(WTS + (size_t)row * 2) = (pg8::f32x2){e0 * inv, e1 * inv}; ENT[rl * 2] = gs * 4 + i0; ENT[rl * 2 + 1] = gs * 4 + i1;
        }
        __syncthreads();
        if (tid < 256) RANK[tid] = (int)__hip_atomic_fetch_add((LAS unsigned*)&LCNT[ENT[tid]], 1u, __ATOMIC_RELAXED, __HIP_MEMORY_SCOPE_WORKGROUP);
        __syncthreads();
        if (tid < 16) LBASE[tid] = __hip_atomic_fetch_add(ctl + CW_CNT + (l * 16 + tid) * 64, LCNT[tid], RLX_AGENT);
        __syncthreads();
        if (tid < 256) { const int e = ENT[tid]; LIST[(size_t)e * LISTCAP + LBASE[e] + RANK[tid]] = (unsigned)((rb * 128 + (tid >> 1)) * 2 + (tid & 1)); }
        __syncthreads();
    }
}
__device__ __forceinline__ void moe_table(const KA& a, int l, LAS int* tab, int tid) {
    gu32* ctl = (gu32*)(a.ws() + WS_CTL);
    if (tid < 16) tab[17 + tid] = (int)__hip_atomic_load(ctl + CW_CNT + (l * 16 + tid) * 64, RLX_AGENT);
    __syncthreads();
    if (tid == 0) { int s = 0; for (int e = 0; e < 16; ++e) { tab[e] = s; s += (tab[17 + e] + 255) >> 8; } tab[16] = s; }
    __syncthreads();
}
__device__ __forceinline__ void p9_ln2(const KA& a, int l, int gw, int NGW, int lane) {
    unsigned char* ws = a.ws(); bf16* H = (bf16*)(ws + WS_H); const float* WTS = (const float*)(ws + WS_WTS); const bf16* F0 = (const bf16*)(ws + WS_FFN); const bf16* F1 = F0 + (size_t)NTOK * D;
    const float* gam = a.in(26) + l * D; const float* bet = a.in(27) + l * D;
    for (int row = gw; row < NTOK; row += NGW) {
        bf16* hp = H + (size_t)row * D; const bf16* f0 = F0 + (size_t)row * D; const bf16* f1 = F1 + (size_t)row * D; const float w0 = WTS[(size_t)row * 2], w1 = WTS[(size_t)row * 2 + 1];
        float v[16], x[8], y[8];
#pragma unroll
        for (int h = 0; h < 2; ++h) { unpack8(*(const v4u*)(hp + 512 * h + 8 * lane), v + 8 * h); unpack8(*(const v4u*)(f0 + 512 * h + 8 * lane), x); unpack8(*(const v4u*)(f1 + 512 * h + 8 * lane), y);
#pragma unroll
            for (int j = 0; j < 8; ++j) v[8 * h + j] = ALPHA * v[8 * h + j] + w0 * x[j] + w1 * y[j]; }
        ln16(v, gam, bet, lane);
        if (l == DEPTH - 1) { float* op = a.out() + (size_t)row * D;
#pragma unroll
            for (int h = 0; h < 2; ++h) { *(f32x4*)(op + 512 * h + 8 * lane) = (f32x4){v[8 * h], v[8 * h + 1], v[8 * h + 2], v[8 * h + 3]}; *(f32x4*)(op + 512 * h + 8 * lane + 4) = (f32x4){v[8 * h + 4], v[8 * h + 5], v[8 * h + 6], v[8 * h + 7]}; } }
        else { *(v4u*)(hp + 8 * lane) = pack8f(v); *(v4u*)(hp + 512 + 8 * lane) = pack8f(v + 8); }
    }
}

#ifndef PH_MASK
#define PH_MASK 0xFFFF
#endif
#ifndef REP_MASK
#define REP_MASK 0
#endif
#define REPS(bit) for (int rep_ = 0; rep_ < ((REP_MASK & (bit)) ? 2 : 1); ++rep_)
#ifndef STOP_AT
#define STOP_AT 0
#endif
#define STOP_DUMP(n, off) do { if (STOP_AT == (n) && l == 0 && hf == 0) { PHASE_BEGIN const bf16* H_ = (const bf16*)(ws + (off)); float* o_ = A_.out(); for (size_t i = (size_t)bx * 512 + tid; i < (size_t)NTOK * D; i += (size_t)G * 512) o_[i] = bf1(H_[i]); return; } } while (0)
#define STOP_HERE(n) do { if (STOP_AT == (n)) { PHASE_BEGIN const bf16* H_ = (const bf16*)(ws + WS_H); float* o_ = A_.out(); for (size_t i = (size_t)bx * 512 + tid; i < (size_t)NTOK * D; i += (size_t)G * 512) o_[i] = bf1(H_[i]); return; } } while (0)
__global__ void __launch_bounds__(NWAVES * 64, 2) hybrid_fwd(Args args) {
    extern __shared__ __attribute__((aligned(16))) unsigned char lds_raw[];
    LAS unsigned char* lds = (LAS unsigned char*)lds_raw;
    const int G = gridDim.x, bx = blockIdx.x;
#define PHASE_BEGIN KA A_; A_.kp = (KP)__builtin_amdgcn_kernarg_segment_ptr(); asm volatile("" : "+s"(A_.kp)); int tid = threadIdx.x; asm volatile("" : "+v"(tid)); \
    const int lane = tid & 63, wave = __builtin_amdgcn_readfirstlane(tid >> 6), gw = bx * NWAVES + wave, NGW = G * NWAVES; unsigned char* ws = A_.ws(); (void)lane; (void)gw; (void)NGW; (void)ws;
    XcdBarrier bar;
    { PHASE_BEGIN
      for (int u = tid; u < (LDS_BYTES - LDSCTL_OFF) / 4; u += NWAVES * 64) ((LAS unsigned*)(lds + LDSCTL_OFF))[u] = 0u;
      __syncthreads();
      bar = xcd_barrier_post((unsigned*)(ws + WS_CTL) + CW_BAR, (volatile LAS unsigned*)(lds + MISC_OFF) + 8);
      REPS(1) if (PH_MASK & 1) p0_prologue(A_, lds, gw, NGW, wave, lane); }
    xcd_barrier(bar);
    STOP_HERE(1);

#pragma unroll 1
    for (int l = 0; l < DEPTH; ++l) {
#pragma unroll 1
        for (int hf = 0; hf < 2; ++hf) {
            REPS(2) if (PH_MASK & 2) { PHASE_BEGIN
              InprojSched S; S.G = G; S.c = bx; S.Hh = (const char*)(ws + WS_H) + (size_t)hf * HTOK * D * 2; S.Win = (const char*)(ws + WS_WIN) + (size_t)l * PROJ * 1024 * 2;
              EpiInproj E{(bf16*)(ws + WS_ZC), (bf16*)(ws + WS_G), (bf16*)(ws + WS_VT), A_.in(4) + (size_t)l * 3 * 1024};
              pg8::gemm_phase<EpiInproj, InprojSched, true, false>(lds, pg8::Gemm{1024, 1024, 1024}, S, E); }
            xcd_barrier(bar);
            STOP_DUMP(10, WS_ZC); STOP_DUMP(11, WS_ZC + 64 * MiB); STOP_DUMP(12, WS_ZC + 128 * MiB); STOP_DUMP(13, WS_ZC + 144 * MiB);
            REPS(4) if (PH_MASK & 4) { PHASE_BEGIN
              bf16* ZC = (bf16*)(ws + WS_ZC); bf16* Y = (bf16*)(ws + WS_Y); bf16* HLOC = (bf16*)(ws + WS_MRG); bf16* CUMA = HLOC + (size_t)HTOK * 512; float* SUMA = (float*)(ws + WS_SUM); float* SUMH = SUMA + 4 * 64 * 512;
              LAS bf16* U = (LAS bf16*)(lds + wave * 9216);
              REPS(1024) for (int t = gw; t < 4 * 64 * 8; t += NGW) lru_local_task(A_, l, ZC + (size_t)2 * HTOK * 512, HLOC, CUMA, SUMA, SUMH, (const bf16*)(ws + WS_LRUW), U, t >> 9, (t >> 3) & 63, t & 7, lane);
              __syncthreads();
              REPS(2048) for (int t = bx; t < 4 * 8 * 16; t += G) sb_attn_wg(ZC, ZC + (size_t)HTOK * 512, (const bf16*)(ws + WS_VT), Y, lds, t >> 7, (t >> 4) & 7, t & 15, wave, lane);
              REPS(4096) sc_pass(A_, l, ZC + (size_t)4 * HTOK * 512, ZC + (size_t)5 * HTOK * 512, Y, bx * 512 + tid, G * 512); }
            xcd_barrier(bar);
            STOP_DUMP(20, WS_Y); STOP_DUMP(21, WS_MRG);
            REPS(8) if (PH_MASK & 8) { PHASE_BEGIN
              const bf16* HLOC = (const bf16*)(ws + WS_MRG); const bf16* CUMA = HLOC + (size_t)HTOK * 512; const float* SUMA = (const float*)(ws + WS_SUM); const float* SUMH = SUMA + 4 * 64 * 512;
              for (int t = bx; t < 4 * 64; t += G) lru_fix_task((const bf16*)(ws + WS_ZC) + (size_t)3 * HTOK * 512, HLOC, CUMA, SUMA, SUMH, (bf16*)(ws + WS_Y), (LAS float*)lds, t >> 6, t & 63, tid); }
            xcd_barrier(bar);
            STOP_DUMP(30, WS_Y);
            REPS(16) if (PH_MASK & 16) { PHASE_BEGIN
              BranchSched S; S.G = G; S.c = bx; S.Y = (const char*)(ws + WS_Y); S.WBR = (const char*)(ws + WS_WBR) + (size_t)l * 1024 * 1536 * 2;
              EpiBranch E{(const bf16*)(ws + WS_G), (bf16*)(ws + WS_MRG)};
              pg8::gemm_phase<EpiBranch, BranchSched, true, false>(lds, pg8::Gemm{512, 1536, 1536}, S, E); }
            xcd_barrier(bar);
            STOP_DUMP(40, WS_MRG);
            if (PH_MASK & 32) { PHASE_BEGIN
              PlainSched S; S.G = G; S.c = bx; S.nM = 64; S.nN = 4; S.A = (const char*)(ws + WS_MRG); S.B = (const char*)(ws + WS_WOUT) + (size_t)l * 1024 * 1024 * 2; S.astep = (size_t)256 * 1024 * 2; S.bstep = (size_t)256 * 1024 * 2;
              EpiOutproj E{(bf16*)(ws + WS_H) + (size_t)hf * HTOK * D};
              pg8::gemm_phase<EpiOutproj, PlainSched, true, false>(lds, pg8::Gemm{1024, 1024, 1024}, S, E); }
            xcd_barrier(bar);
            STOP_DUMP(50, WS_H);
        }
        STOP_HERE(2);
        if (PH_MASK & 64) { PHASE_BEGIN p6_ln1_router(A_, l, lds, G, tid, wave, lane); }
        xcd_barrier(bar);
        STOP_HERE(3);
        REPS(128) if (PH_MASK & 128) { PHASE_BEGIN
          LAS int* tab = (LAS int*)(lds + MOE_OFF);
          moe_table(A_, l, tab, tid);
          MoeSched S; S.G = G; S.c = bx; S.tab = tab; S.Abase = (const char*)(ws + WS_H); S.atile = 0; S.Wbase = (const char*)(ws + WS_WGU) + (size_t)l * NEXP * 1024 * 1024 * 2; S.wstride = (size_t)1024 * 1024 * 2; S.bstep = (size_t)256 * 1024 * 2;
          S.list = (const unsigned*)(ws + WS_LIST);
          EpiGateUp E{(bf16*)(ws + WS_HB)};
          pg8::gemm_phase<EpiGateUp, MoeSched, true, true>(lds, pg8::Gemm{1024, 1024, 1024}, S, E); }
        xcd_barrier(bar);
        REPS(256) if (PH_MASK & 256) { PHASE_BEGIN
          LAS int* tab = (LAS int*)(lds + MOE_OFF);
          moe_table(A_, l, tab, tid);
          MoeSched S; S.G = G; S.c = bx; S.tab = tab; S.Abase = (const char*)(ws + WS_HB); S.atile = (size_t)256 * 512 * 2; S.Wbase = (const char*)(ws + WS_WDN) + (size_t)l * NEXP * 1024 * 512 * 2; S.wstride = (size_t)1024 * 512 * 2; S.bstep = (size_t)256 * 512 * 2;
          S.list = (const unsigned*)(ws + WS_LIST);
          EpiDown E{(bf16*)(ws + WS_FFN), (const unsigned*)(ws + WS_LIST)};
          pg8::gemm_phase<EpiDown, MoeSched, true, false>(lds, pg8::Gemm{512, 512, 512}, S, E); }
        xcd_barrier(bar);
        if (PH_MASK & 512) { PHASE_BEGIN p9_ln2(A_, l, gw, NGW, lane); }
        if (l + 1 < DEPTH) xcd_barrier(bar);
        STOP_HERE(4);
    }
}

extern "C" void kernel_launch(void* const* d_in, const int* in_sizes, int n_in, void* d_out, int out_size, void* d_ws, size_t ws_size, hipStream_t stream) {
    static int grid = 0;
    if (grid == 0) {
        if (n_in != 28 || in_sizes[0] != NTOK * D || out_size != NTOK * D || ws_size < WS_END) { fprintf(stderr, "kernel_launch: unexpected shapes (n_in %d, in0 %d, out %d, ws %zu); nothing launched\n", n_in, n_in > 0 ? in_sizes[0] : -1, out_size, ws_size); grid = -1; return; }
        int dev = 0, cus = 0, per_cu = 0;
        if (hipGetDevice(&dev) != hipSuccess || hipDeviceGetAttribute(&cus, hipDeviceAttributeMultiprocessorCount, dev) != hipSuccess) { grid = -1; return; }
        if (hipFuncSetAttribute((const void*)hybrid_fwd, hipFuncAttributeMaxDynamicSharedMemorySize, LDS_BYTES) != hipSuccess) { fprintf(stderr, "kernel_launch: hipFuncSetAttribute failed\n"); grid = -1; return; }
        if (hipOccupancyMaxActiveBlocksPerMultiprocessor(&per_cu, (const void*)hybrid_fwd, NWAVES * 64, LDS_BYTES) != hipSuccess || per_cu < 1) fprintf(stderr, "kernel_launch: occupancy query reports %d\n", per_cu);
        (void)hipGetLastError();
        grid = cus;
    }
    if (grid < 0) return;
    if (hipMemsetAsync((char*)d_ws + WS_CTL, 0, CTL_ZERO_BYTES, stream) != hipSuccess) return;
    Args a{};
    for (int i = 0; i < 28; ++i) a.in[i] = (const float*)d_in[i];
    a.out = (float*)d_out; a.ws = (unsigned char*)d_ws;
    hipLaunchKernelGGL(hybrid_fwd, dim3(grid), dim3(NWAVES * 64), LDS_BYTES, stream, a);
}
```

```cpp
#include <hip/hip_runtime.h>
#include <cstdio>
#include <cstdint>
namespace pg8 {
#define PG8_LAS __attribute__((address_space(3)))
typedef unsigned short bf16_t;
typedef short bf16x8 __attribute__((ext_vector_type(8)));
typedef float f32x4 __attribute__((ext_vector_type(4)));
typedef float f32x2 __attribute__((ext_vector_type(2)));
typedef unsigned u32x4 __attribute__((ext_vector_type(4)));
typedef unsigned u32x2 __attribute__((ext_vector_type(2)));
typedef int i32x4 __attribute__((ext_vector_type(4)));
constexpr int BM = 256, BK = 64, HALF = 128, HTB = HALF * BK * 2  , STAGE_BYTES = 8 * HTB, NXCD = 8, WGM = 8;

__host__ __device__ __forceinline__ int lds_byte(int r, int c) { const int st = (r >> 4) * 2 + (c >> 5), rr = r & 15, cc = c & 31, ob = rr * 64 + cc * 2; return st * 1024 + (ob ^ (((ob >> 9) & 1) << 5)); }
__host__ __device__ __forceinline__ void stage_rc(int b, int& R, int& C) { const int st = b / 1024, sb = b % 1024, swz = sb ^ (((sb >> 9) & 1) << 5); R = (st >> 1) * 16 + swz / 64; C = (st & 1) * 32 + (swz % 64) / 2; }
__host__ __device__ __forceinline__ int perm32(int rho) { const int n = rho >> 4, i = rho & 15; return 8 * (i >> 2) + 4 * n + (i & 3); }

struct Unit { int pm, pn, ty, aux, nv, pad; const char* A; const char* B; };
struct Gemm { int K, lda, ldb; };

__device__ __forceinline__ void tile_swz(int L, int nM, int nN, int& pm, int& pn) {
    const int nwg = nM * nN; int wgid = L; { const int q = nwg / NXCD, r = nwg % NXCD, xcd = wgid % NXCD, off = wgid / NXCD; wgid = (xcd < r ? xcd * (q + 1) : r * (q + 1) + (xcd - r) * q) + off; }
    const int nig = WGM * nN, gid = wgid / nig, fm = gid * WGM, gsz = (nM - fm) < WGM ? (nM - fm) : WGM;
    pm = fm + ((wgid % nig) % gsz); pn = (wgid % nig) / gsz;
}
__device__ __forceinline__ unsigned cvt_pk_bf16(float lo, float hi) { unsigned r; asm volatile("v_cvt_pk_bf16_f32 %0, %1, %2" : "=v"(r) : "v"(lo), "v"(hi)); return r; }

template <class Epi, class Sched, bool ALIGN_EPI, bool GATHER, bool I8 = false>
__device__ __forceinline__ void gemm_phase(PG8_LAS unsigned char* lds, const Gemm g, const Sched& S, const Epi& E) {
    int tid = threadIdx.x; asm volatile("" : "+v"(tid));
    const int wid = __builtin_amdgcn_readfirstlane(tid >> 6), lane = tid & 63, wr = wid >> 2, wc = wid & 3, fr = lane & 15, fq = lane >> 4;
    const int K = g.K, nt = K / BK;
    int sR[2], sC[2];
    unsigned cvA[2][2], nvA[2][2], voffB[2];
#pragma unroll
    for (int i = 0; i < 2; ++i) { int R, C; stage_rc(tid * 16 + i * 8192, R, C); sR[i] = R; sC[i] = C; const int Rb = Epi::PERM ? ((R & ~31) + perm32(R & 31)) : R;
        voffB[i] = (unsigned)(Rb * g.ldb + C) * 2u;
#pragma unroll
        for (int h = 0; h < 2; ++h) { cvA[h][i] = (unsigned)((h * HALF + R) * g.lda + C) * 2u; nvA[h][i] = cvA[h][i]; } }
    const size_t kstep = (size_t)(BK * 2);
    const size_t hstepB = (size_t)HALF * g.ldb * 2;
    const unsigned ldsw = (unsigned)wid * 1024u;
    const int aoff = lds_byte(wr * 64 + fr, fq * 8), boff = lds_byte(wc * 32 + fr, fq * 8);
#define PG8_SA(b, h) (((b) * 2 + (h)) * HTB)
#define PG8_SB(b, h) ((4 + (b) * 2 + (h)) * HTB)
#define PG8_STAGE(bufoff, gbase, voff) do { _Pragma("unroll") for (int _i = 0; _i < 2; ++_i) \
        __builtin_amdgcn_global_load_lds((const unsigned*)((const char*)(gbase) + (voff)[_i]), (PG8_LAS unsigned*)(lds + (bufoff) + ldsw + _i * 8192), 16, 0, 0); } while (0)
#define PG8_LDA(dst, b, h) do { _Pragma("unroll") for (int m = 0; m < 4; ++m) _Pragma("unroll") for (int k = 0; k < 2; ++k) dst[m][k] = *(const PG8_LAS bf16x8*)(lds + PG8_SA(b, h) + aoff + m * 2048 + k * 1024); } while (0)
#define PG8_LDB(dst, b, h) do { _Pragma("unroll") for (int n = 0; n < 2; ++n) _Pragma("unroll") for (int k = 0; k < 2; ++k) dst[n][k] = *(const PG8_LAS bf16x8*)(lds + PG8_SB(b, h) + boff + n * 2048 + k * 1024); } while (0)
#define PG8_MMA(ai, bj, At, Bt) do { __builtin_amdgcn_s_setprio(1); _Pragma("unroll") for (int m = 0; m < 4; ++m) _Pragma("unroll") for (int n = 0; n < 2; ++n) _Pragma("unroll") for (int k = 0; k < 2; ++k) { \
        if constexpr (I8) acc[ai][bj][m][n] = __builtin_bit_cast(f32x4, __builtin_amdgcn_mfma_i32_16x16x64_i8(__builtin_bit_cast(i32x4, Bt[n][k]), __builtin_bit_cast(i32x4, At[m][k]), __builtin_bit_cast(i32x4, acc[ai][bj][m][n]), 0, 0, 0)); \
        else acc[ai][bj][m][n] = __builtin_amdgcn_mfma_f32_16x16x32_bf16(Bt[n][k], At[m][k], acc[ai][bj][m][n], 0, 0, 0); } __builtin_amdgcn_s_setprio(0); } while (0)
#define PG8_WAIT_V(n) asm volatile("s_waitcnt vmcnt(" #n ")" ::: "memory")
#define PG8_WAIT_L(n) asm volatile("s_waitcnt lgkmcnt(" #n ")" ::: "memory")
#define PG8_BAR __builtin_amdgcn_s_barrier()
#define PG8_SCHED __builtin_amdgcn_sched_barrier(0)
    Unit cur, nxt; int ui = 0;
    if (!S.next(0, cur)) return;
    f32x4 acc[2][2][4][2];
#pragma unroll
    for (int a = 0; a < 2; ++a)
#pragma unroll
        for (int b = 0; b < 2; ++b)
#pragma unroll
            for (int m = 0; m < 4; ++m)
#pragma unroll
                for (int n = 0; n < 2; ++n) acc[a][b][m][n] = (f32x4){0.f, 0.f, 0.f, 0.f};
    bf16x8 At[4][2], B0[2][2], B1[2][2];
    const char* cA = cur.A; const char* cB = cur.B;
    asm volatile("" : "+s"(cA), "+s"(cB));
    if constexpr (GATHER) {
#pragma unroll
        for (int h = 0; h < 2; ++h)
#pragma unroll
            for (int i = 0; i < 2; ++i) cvA[h][i] = (unsigned)(S.arow(cur, h * HALF + sR[i]) * g.lda + sC[i]) * 2u;
        PG8_WAIT_V(0);
    }
    S.a_ready(cur);
    PG8_STAGE(PG8_SB(0, 0), cB, voffB); PG8_STAGE(PG8_SB(0, 1), cB + hstepB, voffB); PG8_STAGE(PG8_SA(0, 0), cA, cvA[0]); PG8_STAGE(PG8_SA(0, 1), cA, cvA[1]);
    if (wr == 1) PG8_BAR;
    PG8_WAIT_V(2); PG8_BAR;
    PG8_STAGE(PG8_SB(1, 0), cB + kstep, voffB); PG8_STAGE(PG8_SA(1, 0), cA + kstep, cvA[0]); PG8_STAGE(PG8_SB(1, 1), cB + hstepB + kstep, voffB);
    PG8_WAIT_V(6); PG8_BAR;
    for (;;) {
        const bool has_next = S.next(ui + 1, nxt);
        const char* nA = has_next ? nxt.A : cA; const char* nB = has_next ? nxt.B : cB;
        asm volatile("" : "+s"(nA), "+s"(nB));
        if constexpr (GATHER) {
            if (has_next) {
#pragma unroll
                for (int h = 0; h < 2; ++h)
#pragma unroll
                    for (int i = 0; i < 2; ++i) nvA[h][i] = (unsigned)(S.arow(nxt, h * HALF + sR[i]) * g.lda + sC[i]) * 2u;
                PG8_WAIT_V(0);
            } else {
#pragma unroll
                for (int h = 0; h < 2; ++h)
#pragma unroll
                    for (int i = 0; i < 2; ++i) nvA[h][i] = cvA[h][i];
            }
        }
        for (int t = 0; t < nt; t += 2) {
            const bool last = (t == nt - 2);
            const char* a1 = cA + (size_t)(t + 1) * kstep;
            const char* a2 = last ? nA : cA + (size_t)(t + 2) * kstep; const char* b2 = last ? nB : cB + (size_t)(t + 2) * kstep;
            const char* a3 = a2 + kstep; const char* b3 = b2 + kstep;
            unsigned o2[2][2];
#pragma unroll
            for (int h = 0; h < 2; ++h)
#pragma unroll
                for (int i = 0; i < 2; ++i) o2[h][i] = (GATHER && last) ? nvA[h][i] : cvA[h][i];
            if (last && has_next) S.a_ready(nxt);
            PG8_LDB(B0, 0, 0); PG8_LDB(B1, 0, 1); PG8_SCHED; PG8_LDA(At, 0, 0); PG8_STAGE(PG8_SA(1, 1), a1, cvA[1]);
            PG8_WAIT_V(8); PG8_WAIT_L(0); PG8_BAR; PG8_MMA(0, 0, At, B0); PG8_MMA(0, 1, At, B1); PG8_BAR; PG8_SCHED;
            PG8_LDA(At, 0, 1); PG8_STAGE(PG8_SB(0, 0), b2, voffB); PG8_STAGE(PG8_SB(0, 1), b2 + hstepB, voffB); PG8_STAGE(PG8_SA(0, 0), a2, o2[0]);
            PG8_WAIT_V(8); PG8_WAIT_L(0); PG8_BAR; PG8_MMA(1, 0, At, B0); PG8_MMA(1, 1, At, B1); PG8_BAR; PG8_SCHED;
            PG8_LDB(B0, 1, 0); PG8_LDB(B1, 1, 1); PG8_SCHED; PG8_LDA(At, 1, 0); PG8_STAGE(PG8_SA(0, 1), a2, o2[1]);
            PG8_WAIT_V(8); PG8_WAIT_L(0); PG8_BAR; PG8_MMA(0, 0, At, B0); PG8_MMA(0, 1, At, B1); PG8_BAR; PG8_SCHED;
            PG8_LDA(At, 1, 1); PG8_STAGE(PG8_SB(1, 0), b3, voffB); PG8_STAGE(PG8_SB(1, 1), b3 + hstepB, voffB); PG8_STAGE(PG8_SA(1, 0), a3, o2[0]);
            PG8_WAIT_V(8); PG8_WAIT_L(0); PG8_BAR; PG8_MMA(1, 0, At, B0); PG8_MMA(1, 1, At, B1); PG8_BAR; PG8_SCHED;
        }
        if constexpr (ALIGN_EPI) { if (wr == 0) PG8_BAR; }
        E(acc, cur, wr, wc, fr, fq); S.done(cur);
        if (!has_next) break;
#pragma unroll
        for (int a = 0; a < 2; ++a)
#pragma unroll
            for (int b = 0; b < 2; ++b)
#pragma unroll
                for (int m = 0; m < 4; ++m)
#pragma unroll
                    for (int n = 0; n < 2; ++n) acc[a][b][m][n] = (f32x4){0.f, 0.f, 0.f, 0.f};
        cur = nxt; cA = nA; cB = nB; ++ui;
        if constexpr (GATHER) {
#pragma unroll
            for (int h = 0; h < 2; ++h)
#pragma unroll
                for (int i = 0; i < 2; ++i) cvA[h][i] = nvA[h][i];
        }
        if constexpr (ALIGN_EPI) { if (wr == 1) PG8_BAR; }
    }
    PG8_WAIT_V(0);
    if constexpr (!ALIGN_EPI) { if (wr == 0) PG8_BAR; }
    PG8_BAR;
#undef PG8_SA
#undef PG8_SB
#undef PG8_STAGE
#undef PG8_LDA
#undef PG8_LDB
#undef PG8_MMA
#undef PG8_WAIT_V
#undef PG8_WAIT_L
#undef PG8_BAR
#undef PG8_SCHED
}
}
constexpr int NWAVES = 8;
constexpr int D = 1024, NTOK = 32768, SEQ = 4096, HTOK = 16384  , DEPTH = 2, NEXP = 16;
constexpr int PROJ = 7168, NMAIN = 6656;
constexpr float ALPHA = 1.41421356237309515f;
constexpr float LN_EPS = 1e-5f;
constexpr float LOG2E = 1.4426950408889634f;
constexpr float C2 = 0.125f * LOG2E;
constexpr int LISTCAP = 32768;

constexpr size_t MiB = 1u << 20;
constexpr size_t WS_CTL = 0, CTL_ZERO_BYTES = 1 * MiB;
constexpr size_t WS_WIN = 1 * MiB;
constexpr size_t WS_WBR = 15 * MiB;
constexpr size_t WS_WOUT = 21 * MiB;
constexpr size_t WS_WGU = 25 * MiB;
constexpr size_t WS_WDN = 89 * MiB;
constexpr size_t WS_LRUW = 121 * MiB;
constexpr size_t WS_HQ = 122 * MiB;
constexpr size_t WS_H = 154 * MiB;
constexpr size_t WS_Y = 218 * MiB;
constexpr size_t WS_MRG = 266 * MiB;
constexpr size_t WS_ZC = 298 * MiB;
constexpr size_t WS_G = WS_ZC + 96 * MiB, WS_VT = WS_ZC + 192 * MiB;
constexpr size_t WS_SUM = 506 * MiB;
constexpr size_t WS_HS = 507 * MiB;
constexpr size_t WS_LIST = 298 * MiB;
constexpr size_t WS_WTS = 300 * MiB;
constexpr size_t WS_HB = 301 * MiB;
constexpr size_t WS_FFN = 369 * MiB;
constexpr size_t WS_END = 508 * MiB;
constexpr int CW_TMO = 0, CW_BAR = 4096, CW_CNT = 8192, CW_WS = 16384;

constexpr int RING_BYTES = 131072;
constexpr int LDSCTL_OFF = RING_BYTES, MISC_OFF = LDSCTL_OFF + 320, MOE_OFF = LDSCTL_OFF + 1024;
constexpr int LDS_BYTES = 147456;

#define GAS __attribute__((address_space(1)))
#define LAS __attribute__((address_space(3)))
typedef unsigned short bf16;
typedef unsigned v4u __attribute__((ext_vector_type(4)));
typedef unsigned v2u __attribute__((ext_vector_type(2)));
typedef float f32x4 __attribute__((ext_vector_type(4)));
typedef float f32x16 __attribute__((ext_vector_type(16)));
typedef short bf16x8 __attribute__((ext_vector_type(8)));
typedef GAS unsigned gu32;
#define RLX_AGENT __ATOMIC_RELAXED, __HIP_MEMORY_SCOPE_AGENT
#define LDS_WAIT() asm volatile("s_waitcnt lgkmcnt(0)" ::: "memory")
#define VM_WAIT() asm volatile("s_waitcnt vmcnt(0)" ::: "memory")
__device__ __forceinline__ unsigned f2bf(float f) { unsigned u = __builtin_bit_cast(unsigned, f); return (u + 0x7fffu + ((u >> 16) & 1u)) >> 16; }
__device__ __forceinline__ unsigned pk2(float lo, float hi) { return f2bf(lo) | (f2bf(hi) << 16); }
typedef float f32x2_t __attribute__((ext_vector_type(2))); typedef __bf16 bf16x2_t __attribute__((ext_vector_type(2)));
__device__ __forceinline__ unsigned cvtpk(float lo, float hi) { f32x2_t v = {lo, hi}; bf16x2_t b = __builtin_convertvector(v, bf16x2_t); return __builtin_bit_cast(unsigned, b); }
__device__ __forceinline__ float bflo(unsigned w) { return __builtin_bit_cast(float, w << 16); }
__device__ __forceinline__ float bfhi(unsigned w) { return __builtin_bit_cast(float, w & 0xffff0000u); }
__device__ __forceinline__ float bf1(bf16 b) { return __builtin_bit_cast(float, ((unsigned)b) << 16); }
__device__ __forceinline__ float fexp2(float x) { return __builtin_amdgcn_exp2f(x); }
__device__ __forceinline__ float flog2(float x) { return __builtin_amdgcn_logf(x); }
__device__ __forceinline__ float frcp(float x) { return __builtin_amdgcn_rcpf(x); }
__device__ __forceinline__ float sigmoidf_(float x) { return frcp(1.f + fexp2(-LOG2E * x)); }
#define DPP_ADD(v, ctrl) ((v) + __builtin_bit_cast(float, __builtin_amdgcn_update_dpp(0, __builtin_bit_cast(int, (v)), (ctrl), 0xF, 0xF, true)))
__device__ __forceinline__ float row16_sum(float v) { v = DPP_ADD(v, 0xB1); v = DPP_ADD(v, 0x4E); v = DPP_ADD(v, 0x141); v = DPP_ADD(v, 0x140); return v; }
#define DPP_MAX(v, ctrl) fmaxf((v), __builtin_bit_cast(float, __builtin_amdgcn_update_dpp(0, __builtin_bit_cast(int, (v)), (ctrl), 0xF, 0xF, true)))
__device__ __forceinline__ float wave_max(float v) {
    v = DPP_MAX(v, 0xB1); v = DPP_MAX(v, 0x4E); v = DPP_MAX(v, 0x141); v = DPP_MAX(v, 0x140); const int iv = __builtin_bit_cast(int, v);
    return fmaxf(fmaxf(__builtin_bit_cast(float, __builtin_amdgcn_readlane(iv, 0)), __builtin_bit_cast(float, __builtin_amdgcn_readlane(iv, 16))),
                 fmaxf(__builtin_bit_cast(float, __builtin_amdgcn_readlane(iv, 32)), __builtin_bit_cast(float, __builtin_amdgcn_readlane(iv, 48))));
}
__device__ __forceinline__ unsigned q4(float a, float b, float c, float d) { return ((unsigned)__float2int_rn(a) & 0xffu) | (((unsigned)__float2int_rn(b) & 0xffu) << 8) | (((unsigned)__float2int_rn(c) & 0xffu) << 16) | ((unsigned)__float2int_rn(d) << 24); }
__device__ __forceinline__ float wave_sum(float v) {
    v = row16_sum(v); const int iv = __builtin_bit_cast(int, v);
    const float a = __builtin_bit_cast(float, __builtin_amdgcn_readlane(iv, 0)), b = __builtin_bit_cast(float, __builtin_amdgcn_readlane(iv, 16)),
                c = __builtin_bit_cast(float, __builtin_amdgcn_readlane(iv, 32)), d = __builtin_bit_cast(float, __builtin_amdgcn_readlane(iv, 48));
    return (a + b) + (c + d);
}
__device__ __forceinline__ void unpack8(const v4u w, float* v) { v[0] = bflo(w.x); v[1] = bfhi(w.x); v[2] = bflo(w.y); v[3] = bfhi(w.y); v[4] = bflo(w.z); v[5] = bfhi(w.z); v[6] = bflo(w.w); v[7] = bfhi(w.w); }
__device__ __forceinline__ v4u pack8f(const float* v) { return (v4u){cvtpk(v[0], v[1]), cvtpk(v[2], v[3]), cvtpk(v[4], v[5]), cvtpk(v[6], v[7])}; }
__device__ __forceinline__ void ln16(float (&v)[16], const float* gam, const float* bet, int lane) {
    float s = 0.f;
#pragma unroll
    for (int j = 0; j < 16; ++j) s += v[j];
    const float mean = wave_sum(s) * (1.f / D); float s2 = 0.f;
#pragma unroll
    for (int j = 0; j < 16; ++j) { v[j] -= mean; s2 += v[j] * v[j]; }
    const float rstd = 1.f / sqrtf(wave_sum(s2) * (1.f / D) + LN_EPS);
#pragma unroll
    for (int h = 0; h < 2; ++h)
#pragma unroll
        for (int q = 0; q < 2; ++q) { const f32x4 g4 = *(const f32x4*)(gam + 512 * h + 8 * lane + 4 * q), b4 = *(const f32x4*)(bet + 512 * h + 8 * lane + 4 * q);
#pragma unroll
            for (int j = 0; j < 4; ++j) v[8 * h + 4 * q + j] = v[8 * h + 4 * q + j] * rstd * g4[j] + b4[j]; }
}

#define XB_TMO      128
#define XB_XCNT(j)  (256  + 64 * (j))
#define XB_XSUB(j)  (1280 + 64 * (j))
#define XB_XGEN(j)  (2304 + 64 * (j))
#define XB_TOP      3328
#define XB_TOPGEN   3392
#define XCD_BAR_WORDS 3456
#define XB_SPIN_CAP (1u << 18)

__device__ __forceinline__ unsigned xb_ld(unsigned* p)              { return __hip_atomic_load(p, __ATOMIC_RELAXED, __HIP_MEMORY_SCOPE_AGENT); }
__device__ __forceinline__ unsigned xb_add(unsigned* p, unsigned v) { return __hip_atomic_fetch_add(p, v, __ATOMIC_RELAXED, __HIP_MEMORY_SCOPE_AGENT); }
__device__ __forceinline__ unsigned xb_xcc_id() { return (unsigned)__builtin_amdgcn_s_getreg((3 << 11) | 20) & 0xFu; }
#define XB_SPIN(cond, bar) do { unsigned _sp = 0; while (cond) { __builtin_amdgcn_s_sleep(1); \
    if ((++_sp & 255u) == 0u) { if (xb_ld(&(bar)[XB_TMO])) break; if (_sp > XB_SPIN_CAP) { atomicAdd(&(bar)[XB_TMO], 1u); break; } } } } while (0)

struct XcdBarrier {
    unsigned* bar; unsigned x;
    volatile LAS unsigned* st;
};

__device__ __forceinline__ XcdBarrier xcd_barrier_post(unsigned* bar, volatile LAS unsigned* st) {
    XcdBarrier b; b.bar = bar; b.x = xb_xcc_id(); b.st = st;
    if (threadIdx.x == 0) (void)xb_add(&bar[XB_XCNT(b.x)], 1u);
    return b;
}
__device__ __forceinline__ void xcd_barrier_complete(unsigned* bar, unsigned x, unsigned& nloc, unsigned& nx) {
    const unsigned G = gridDim.x * gridDim.y * gridDim.z;
    unsigned sum, cnt, mine, sp = 0u;
    for (;;) {
        sum = 0u; cnt = 0u; mine = 0u;
#pragma unroll
        for (unsigned j = 0; j < 16; ++j) { const unsigned c = xb_ld(&bar[XB_XCNT(j)]); sum += c; cnt += (c > 0u) ? 1u : 0u; mine = (j == x) ? c : mine; }
        if (sum == G) break;
        __builtin_amdgcn_s_sleep(1);
        if ((++sp & 255u) == 0u) { if (xb_ld(&bar[XB_TMO])) break; if (sp > XB_SPIN_CAP) { atomicAdd(&bar[XB_TMO], 1u); break; } }
    }
    nloc = mine > 0u ? mine : 1u; nx = cnt > 0u ? cnt : 1u;
}

__device__ __forceinline__ void xcd_barrier(const XcdBarrier& b) {
    asm volatile("s_waitcnt vmcnt(0)" ::: "memory");
    __syncthreads();
    if (threadIdx.x == 0) {
        unsigned* bar = b.bar;
        __builtin_amdgcn_s_waitcnt(0);
        unsigned nloc = b.st[0], nx = b.st[1];
        if (nloc == 0u) { xcd_barrier_complete(bar, b.x, nloc, nx); b.st[0] = nloc; b.st[1] = nx; }
        const unsigned old = xb_add(&bar[XB_XSUB(b.x)], 1u);
        const unsigned gen = old / nloc;
        if (old + 1u == (gen + 1u) * nloc) {
            __builtin_amdgcn_fence(__ATOMIC_RELEASE, "agent");
            asm volatile("s_waitcnt vmcnt(0)" ::: "memory");
            const unsigned og = xb_add(&bar[XB_TOP], 1u);
            const unsigned tg = og / nx;
            if (og + 1u == (tg + 1u) * nx) xb_add(&bar[XB_TOPGEN], 1u);
            else XB_SPIN(xb_ld(&bar[XB_TOPGEN]) == tg, bar);
            __builtin_amdgcn_fence(__ATOMIC_ACQUIRE, "agent");
            xb_add(&bar[XB_XGEN(b.x)], 1u);
            asm volatile("s_waitcnt vmcnt(0)" ::: "memory");
        } else {
            XB_SPIN(xb_ld(&bar[XB_XGEN(b.x)]) == gen, bar);
            __builtin_amdgcn_fence(__ATOMIC_ACQUIRE, "agent");
            asm volatile("s_waitcnt vmcnt(0)" ::: "memory");
        }
    }
    __syncthreads();
}
using pg8::Unit;
struct NoHooks { __device__ __forceinline__ void a_ready(const Unit&) const {} __device__ __forceinline__ void done(const Unit&) const {} };

struct InprojSched : NoHooks {
    int G, c; const char* Hh; const char* Win;
    __device__ __forceinline__ bool next(int i, Unit& u) const {
        const int L = i * G + c; if (L >= 1792) return false;
        if (L < 1664) { pg8::tile_swz(L, 64, 26, u.pm, u.pn); u.ty = 0; u.A = Hh + (size_t)u.pm * 256 * 1024; u.B = Win + (size_t)u.pn * 256 * 1024; }
        else { const int j = L - 1664; u.pm = j & 1; u.pn = j >> 1; u.ty = 1; u.A = Win + (size_t)(NMAIN + 256 * u.pm) * 1024; u.B = Hh + (size_t)u.pn * 256 * 1024; }
        u.aux = 0; u.nv = 0; u.pad = 0; return true;
    }
};
struct EpiInproj {
    static constexpr bool PERM = true;
    bf16* ZC; bf16* G0; bf16* VT; const float* gate_b;
    const float* hs; const float* wsc;
    __device__ __forceinline__ void operator()(const pg8::f32x4 (&acc)[2][2][4][2], const Unit& u, int wr, int wc, int fr, int fq) const {
        int row0 = u.pm * 256 + wr * 64 + fr; asm volatile("" : "+v"(row0));
        const int cl = wc * 32 + 8 * fq;
        const float* rsp = (u.ty == 1) ? wsc + NMAIN : hs; const float* csp = (u.ty == 1) ? hs + u.pn * 256 : wsc + u.pn * 256;
        float rs[2][4]; pg8::f32x4 cs[2][2];
#pragma unroll
        for (int ai = 0; ai < 2; ++ai)
#pragma unroll
            for (int m = 0; m < 4; ++m) rs[ai][m] = rsp[row0 + ai * 128 + m * 16];
#pragma unroll
        for (int bj = 0; bj < 2; ++bj)
#pragma unroll
            for (int n = 0; n < 2; ++n) cs[bj][n] = *(const pg8::f32x4*)(csp + bj * 128 + cl + 4 * n);
#define ACCV(ai, bj, m, n) (__builtin_convertvector(__builtin_bit_cast(pg8::i32x4, acc[ai][bj][m][n]), pg8::f32x4) * (cs[bj][n] * rs[ai][m]))
        if (u.ty == 0 && u.pn >= 10 && u.pn < 14) {
            bf16* base = ZC + (size_t)5 * HTOK * 512; const int col0 = (u.pn - 10) * 128 + cl;
#pragma unroll
            for (int ai = 0; ai < 2; ++ai)
#pragma unroll
                for (int m = 0; m < 4; ++m) { const pg8::f32x4 v0 = ACCV(ai, 0, m, 0) * ACCV(ai, 1, m, 0), v1 = ACCV(ai, 0, m, 1) * ACCV(ai, 1, m, 1);
                    v4u w; w.x = cvtpk(v0[0], v0[1]); w.y = cvtpk(v0[2], v0[3]); w.z = cvtpk(v1[0], v1[1]); w.w = cvtpk(v1[2], v1[3]);
                    *(v4u*)(base + (size_t)(row0 + ai * 128 + m * 16) * 512 + col0) = w; }
            return;
        }
        if (u.ty == 0 && u.pn >= 14) {
            const int b = (u.pn - 14) >> 2, col0 = ((u.pn - 14) & 3) * 256 + cl; bf16* base = G0 + (size_t)b * HTOK * 1024; const float* gb = gate_b + b * 1024 + col0;
            pg8::f32x4 bv[2][2];
#pragma unroll
            for (int bj = 0; bj < 2; ++bj)
#pragma unroll
                for (int n = 0; n < 2; ++n) bv[bj][n] = *(const pg8::f32x4*)(gb + bj * 128 + 4 * n);
#pragma unroll
            for (int ai = 0; ai < 2; ++ai)
#pragma unroll
                for (int m = 0; m < 4; ++m) { bf16* rowp = base + (size_t)(row0 + ai * 128 + m * 16) * 1024 + col0;
#pragma unroll
                    for (int bj = 0; bj < 2; ++bj) { pg8::f32x4 v0 = ACCV(ai, bj, m, 0) + bv[bj][0], v1 = ACCV(ai, bj, m, 1) + bv[bj][1];
#pragma unroll
                        for (int j = 0; j < 4; ++j) { v0[j] = sigmoidf_(v0[j]); v1[j] = sigmoidf_(v1[j]); }
                        v4u w; w.x = cvtpk(v0[0], v0[1]); w.y = cvtpk(v0[2], v0[3]); w.z = cvtpk(v1[0], v1[1]); w.w = cvtpk(v1[2], v1[3]);
                        *(v4u*)(rowp + bj * 128) = w; } }
            return;
        }
        float sc = 1.f; const int t = u.pn >> 1;
        if (u.ty == 0 && t == 0) sc = C2;
#pragma unroll
        for (int ai = 0; ai < 2; ++ai)
#pragma unroll
            for (int m = 0; m < 4; ++m) { const int row = row0 + ai * 128 + m * 16;
#pragma unroll
                for (int bj = 0; bj < 2; ++bj) { const pg8::f32x4 v0 = ACCV(ai, bj, m, 0) * sc, v1 = ACCV(ai, bj, m, 1) * sc;
                    v4u w; w.x = cvtpk(v0[0], v0[1]); w.y = cvtpk(v0[2], v0[3]); w.z = cvtpk(v1[0], v1[1]); w.w = cvtpk(v1[2], v1[3]);
                    bf16* p;
                    if (u.ty == 1) { const int tok = u.pn * 256 + bj * 128 + cl; p = VT + ((size_t)(row >> 6) * 256 + (tok >> 6)) * 4096 + (row & 63) * 64 + (tok & 63); }
                    else { const int col = (u.pn & 1) * 256 + bj * 128 + cl;
                        if (t == 1) p = ZC + (size_t)HTOK * 512 + ((size_t)(col >> 6) * HTOK + row) * 64 + (col & 63);
                        else p = ZC + (size_t)t * HTOK * 512 + (size_t)row * 512 + col; }
                    *(v4u*)p = w; } }
#undef ACCV
    }
};

struct BranchSched : NoHooks {
    int G, c; const char* Y; const char* WBR;
    __device__ __forceinline__ bool next(int i, Unit& u) const {
        const int tile = (i / 3) * G + c, b = i % 3; if (tile >= 256) return false;
        pg8::tile_swz(tile, 64, 4, u.pm, u.pn); u.ty = b; u.aux = 0; u.nv = 0; u.pad = 0;
        u.A = Y + ((size_t)u.pm * 256 * 1536 + b * 512) * 2; u.B = WBR + ((size_t)u.pn * 256 * 1536 + b * 512) * 2; return true;
    }
};
struct EpiBranch {
    static constexpr bool PERM = true;
    const bf16* G0; bf16* MRG;
    __device__ __forceinline__ void operator()(const pg8::f32x4 (&acc)[2][2][4][2], const Unit& u, int wr, int wc, int fr, int fq) const {
        int row0 = u.pm * 256 + wr * 64 + fr; asm volatile("" : "+v"(row0)); const int col0 = u.pn * 256 + wc * 32 + 8 * fq; const bf16* gp = G0 + (size_t)u.ty * HTOK * 1024;
#pragma unroll
        for (int ai = 0; ai < 2; ++ai)
#pragma unroll
            for (int m = 0; m < 4; ++m) { const size_t off = (size_t)(row0 + ai * 128 + m * 16) * 1024 + col0;
#pragma unroll
                for (int bj = 0; bj < 2; ++bj) { const v4u gw = *(const v4u*)(gp + off + bj * 128); v4u ow = (v4u){0u, 0u, 0u, 0u}; if (u.ty != 0) ow = *(const v4u*)(MRG + off + bj * 128);
                    const pg8::f32x4 a0 = acc[ai][bj][m][0], a1 = acc[ai][bj][m][1]; v4u w;
                    w.x = cvtpk(bflo(ow.x) + bflo(gw.x) * a0[0], bfhi(ow.x) + bfhi(gw.x) * a0[1]); w.y = cvtpk(bflo(ow.y) + bflo(gw.y) * a0[2], bfhi(ow.y) + bfhi(gw.y) * a0[3]);
                    w.z = cvtpk(bflo(ow.z) + bflo(gw.z) * a1[0], bfhi(ow.z) + bfhi(gw.z) * a1[1]); w.w = cvtpk(bflo(ow.w) + bflo(gw.w) * a1[2], bfhi(ow.w) + bfhi(gw.w) * a1[3]);
                    *(v4u*)(MRG + off + bj * 128) = w; }
                if (m & 1) asm volatile("" ::: "memory"); }
    }
};

struct PlainSched : NoHooks {
    int G, c, nM, nN; const char* A; const char* B; size_t astep, bstep;
    __device__ __forceinline__ bool next(int i, Unit& u) const {
        const int L = i * G + c; if (L >= nM * nN) return false;
        pg8::tile_swz(L, nM, nN, u.pm, u.pn); u.ty = 0; u.aux = 0; u.nv = 0; u.pad = 0; u.A = A + (size_t)u.pm * astep; u.B = B + (size_t)u.pn * bstep; return true;
    }
};
struct EpiOutproj {
    static constexpr bool PERM = true;
    bf16* Hh;
    __device__ __forceinline__ void operator()(const pg8::f32x4 (&acc)[2][2][4][2], const Unit& u, int wr, int wc, int fr, int fq) const {
        int row0 = u.pm * 256 + wr * 64 + fr; asm volatile("" : "+v"(row0)); const int col0 = u.pn * 256 + wc * 32 + 8 * fq;
#pragma unroll
        for (int ai = 0; ai < 2; ++ai)
#pragma unroll
            for (int m = 0; m < 4; ++m) { bf16* rowp = Hh + (size_t)(row0 + ai * 128 + m * 16) * 1024 + col0;
#pragma unroll
                for (int bj = 0; bj < 2; ++bj) { const v4u ow = *(const v4u*)(rowp + bj * 128); const pg8::f32x4 a0 = acc[ai][bj][m][0], a1 = acc[ai][bj][m][1]; v4u w;
                    w.x = cvtpk(ALPHA * bflo(ow.x) + a0[0], ALPHA * bfhi(ow.x) + a0[1]); w.y = cvtpk(ALPHA * bflo(ow.y) + a0[2], ALPHA * bfhi(ow.y) + a0[3]);
                    w.z = cvtpk(ALPHA * bflo(ow.z) + a1[0], ALPHA * bfhi(ow.z) + a1[1]); w.w = cvtpk(ALPHA * bflo(ow.w) + a1[2], ALPHA * bfhi(ow.w) + a1[3]);
                    *(v4u*)(rowp + bj * 128) = w; }
                if (m == 3) asm volatile("" ::: "memory"); }
    }
};

struct MoeSched : NoHooks {
    int G, c; const LAS int* tab; const char* Abase; size_t atile; const char* Wbase; size_t wstride, bstep; const unsigned* list;
    __device__ __forceinline__ bool next(int i, Unit& u) const {
        const int L = i * G + c, NT = tab[16]; if (L >= NT * 4) return false;
        const int rt = L >> 2; int e = 0;
#pragma unroll 1
        while (e < 15 && rt >= tab[e + 1]) ++e;
        const int j = rt - tab[e];
        u.pm = rt; u.pn = L & 3; u.ty = e; u.aux = e * LISTCAP + j * 256; u.nv = tab[17 + e] - j * 256; u.pad = 0;
        u.A = Abase + (size_t)rt * atile; u.B = Wbase + (size_t)e * wstride + (size_t)u.pn * bstep; return true;
    }
    __device__ __forceinline__ int arow(const Unit& u, int r) const { return r < u.nv ? (int)(list[u.aux + r] >> 1) : 0; }
};
struct EpiGateUp {
    static constexpr bool PERM = true;
    bf16* HB;
    __device__ __forceinline__ void operator()(const pg8::f32x4 (&acc)[2][2][4][2], const Unit& u, int wr, int wc, int fr, int fq) const {
        int row0 = u.pm * 256 + wr * 64 + fr; asm volatile("" : "+v"(row0)); const int col0 = u.pn * 128 + wc * 32 + 8 * fq;
#pragma unroll
        for (int ai = 0; ai < 2; ++ai)
#pragma unroll
            for (int m = 0; m < 4; ++m) { pg8::f32x4 v0, v1;
#pragma unroll
                for (int j = 0; j < 4; ++j) { const float g0 = acc[ai][0][m][0][j], g1 = acc[ai][0][m][1][j]; v0[j] = g0 * sigmoidf_(g0) * acc[ai][1][m][0][j]; v1[j] = g1 * sigmoidf_(g1) * acc[ai][1][m][1][j]; }
                v4u w; w.x = cvtpk(v0[0], v0[1]); w.y = cvtpk(v0[2], v0[3]); w.z = cvtpk(v1[0], v1[1]); w.w = cvtpk(v1[2], v1[3]);
                *(v4u*)(HB + (size_t)(row0 + ai * 128 + m * 16) * 512 + col0) = w; }
    }
};
struct EpiDown {
    static constexpr bool PERM = true;
    bf16* FFN; const unsigned* list;
    __device__ __forceinline__ void operator()(const pg8::f32x4 (&acc)[2][2][4][2], const Unit& u, int wr, int wc, int fr, int fq) const {
        int r0 = wr * 64 + fr; asm volatile("" : "+v"(r0)); const int col0 = u.pn * 256 + wc * 32 + 8 * fq;
#pragma unroll
        for (int ai = 0; ai < 2; ++ai)
#pragma unroll
            for (int m = 0; m < 4; ++m) { const int r = r0 + ai * 128 + m * 16;
                if (r < u.nv) { const unsigned ent = list[u.aux + r]; bf16* rowp = FFN + ((size_t)(ent & 1u) * NTOK + (ent >> 1)) * 1024 + col0;
#pragma unroll
                    for (int bj = 0; bj < 2; ++bj) { const pg8::f32x4 v0 = acc[ai][bj][m][0], v1 = acc[ai][bj][m][1];
                        v4u w; w.x = cvtpk(v0[0], v0[1]); w.y = cvtpk(v0[2], v0[3]); w.z = cvtpk(v1[0], v1[1]); w.w = cvtpk(v1[2], v1[3]);
                        *(v4u*)(rowp + bj * 128) = w; } } }
    }
};

__device__ __forceinline__ void tr_item(const float* W, int N, int k0, int n0, bf16* dst, size_t drow0, int dpitch, int dk0, LAS float* scr, int lane) {
#pragma unroll 8
    for (int i = 0; i < 32; ++i) { const int kk = 2 * i + (lane >> 5); scr[kk * 33 + (lane & 31)] = W[(size_t)(k0 + kk) * N + n0 + (lane & 31)]; }
    LDS_WAIT(); asm volatile("" ::: "memory");
    const int c = lane & 7;
#pragma unroll
    for (int j = 0; j < 4; ++j) { const int n = (lane >> 3) + 8 * j; const LAS float* s = scr + (8 * c) * 33 + n;
        v4u o; o.x = pk2(s[0 * 33], s[1 * 33]); o.y = pk2(s[2 * 33], s[3 * 33]); o.z = pk2(s[4 * 33], s[5 * 33]); o.w = pk2(s[6 * 33], s[7 * 33]);
        *(v4u*)(dst + (drow0 + n) * (size_t)dpitch + dk0 + k0 + 8 * c) = o; }
    LDS_WAIT(); asm volatile("" ::: "memory");
}
__device__ __forceinline__ int map_in(int n0) {
    if (n0 < 1024) return n0;
    if (n0 < 1536) return NMAIN + (n0 - 1024);
    if (n0 < 3072) return n0 - 512;
    if (n0 < 3584) { const int c = n0 - 3072; return 2560 + (c >> 7) * 256 + (c & 127); }
    if (n0 < 4096) { const int c = n0 - 3584; return 2560 + (c >> 7) * 256 + 128 + (c & 127); }
    return n0 - 512;
}
struct Args { const float* in[28]; float* out; unsigned char* ws; };
typedef const __attribute__((address_space(4))) unsigned long long* KP;
struct KA { KP kp;
    __device__ __forceinline__ const float* in(int k) const { return (const float*)(const GAS float*)kp[k]; }
    __device__ __forceinline__ float* out() const { return (float*)(GAS float*)kp[28]; }
    __device__ __forceinline__ unsigned char* ws() const { return (unsigned char*)(GAS unsigned char*)kp[29]; } };

__device__ __forceinline__ void win_item_wg(const float* W, int n0, signed char* dst, float* scale_out, size_t drow0, LAS unsigned char* lds, int wave, int lane) {
    const int c = lane & 31, kp = lane >> 5; const float* wp = W + (size_t)(128 * wave) * PROJ + n0 + c;
    LAS float* MX = (LAS float*)(lds + 122880); LAS unsigned char* scr = lds + wave * 16384;
    float m = 0.f;
#pragma unroll 8
    for (int kk = 0; kk < 64; ++kk) m = fmaxf(m, fabsf(wp[(size_t)(2 * kk + kp) * PROJ]));
    m = fmaxf(m, __shfl_xor(m, 32));
    if (lane < 32) MX[wave * 32 + c] = m;
    __syncthreads();
    m = 1e-30f;
#pragma unroll
    for (int w = 0; w < 8; ++w) m = fmaxf(m, MX[w * 32 + c]);
    const float inv = 127.f / m;
    if (wave == 0 && lane < 32) scale_out[drow0 + c] = m * (1.f / 127.f);
#pragma unroll 8
    for (int kk = 0; kk < 64; ++kk) { const int k = 2 * kk + kp; scr[c * 144 + k] = (unsigned char)__float2int_rn(wp[(size_t)k * PROJ] * inv); }
    LDS_WAIT(); asm volatile("" ::: "memory");
#pragma unroll
    for (int j = 0; j < 4; ++j) { const int pc = lane + 64 * j, n = pc >> 3, piece = pc & 7;
        *(v4u*)(dst + (drow0 + n) * (size_t)1024 + wave * 128 + piece * 16) = *(const LAS v4u*)(scr + n * 144 + piece * 16); }
    __syncthreads();
}
__device__ __forceinline__ void quant_row16(const float (&v)[16], signed char* qrow, float* srow, int c0a, int c0b, int lane) {
    float m = 0.f;
#pragma unroll
    for (int j = 0; j < 16; ++j) m = fmaxf(m, fabsf(v[j]));
    m = fmaxf(wave_max(m), 1e-30f); const float inv = 127.f / m;
    *(v2u*)(qrow + c0a) = (v2u){q4(v[0] * inv, v[1] * inv, v[2] * inv, v[3] * inv), q4(v[4] * inv, v[5] * inv, v[6] * inv, v[7] * inv)};
    *(v2u*)(qrow + c0b) = (v2u){q4(v[8] * inv, v[9] * inv, v[10] * inv, v[11] * inv), q4(v[12] * inv, v[13] * inv, v[14] * inv, v[15] * inv)};
    if (lane == 0) *srow = m * (1.f / 127.f);
}
__device__ __forceinline__ void p0_prologue(const KA& a, LAS unsigned char* lds, int gw, int NGW, int wave, int lane) {
    LAS float* scr = (LAS float*)(lds + wave * 16384);
    unsigned char* ws = a.ws();
    for (int it = blockIdx.x; it < DEPTH * 224; it += gridDim.x) { const int l = it / 224, r = it % 224;
        win_item_wg(a.in(3) + (size_t)l * 1024 * PROJ, 32 * r, (signed char*)(ws + WS_WIN) + (size_t)l * PROJ * 1024, (float*)(ws + WS_CTL) + CW_WS + l * PROJ, (size_t)map_in(32 * r), lds, wave, lane); }
    constexpr int I_IN = 0, I_BR = 8 * 32, I_OUT = 16 * 32, I_G = 16 * 16, I_DN = 8 * 32;
    constexpr int PER_LAYER = I_IN + 3 * I_BR + I_OUT + 16 * (2 * I_G + I_DN) + 32;
    for (int it = gw; it < DEPTH * PER_LAYER; it += NGW) {
        const int l = it / PER_LAYER; int r = it % PER_LAYER;
        if (r < 3 * I_BR) { const int b = r / I_BR, q = r % I_BR, kb = q / 32, nb = q % 32; tr_item(a.in(13 + b) + (size_t)l * 512 * 1024, 1024, 64 * kb, 32 * nb, (bf16*)(ws + WS_WBR) + (size_t)l * 1024 * 1536, (size_t)(32 * nb), 1536, b * 512, scr, lane); continue; } r -= 3 * I_BR;
        if (r < I_OUT) { const int kb = r / 32, nb = r % 32; tr_item(a.in(16) + (size_t)l * 1024 * 1024, 1024, 64 * kb, 32 * nb, (bf16*)(ws + WS_WOUT) + (size_t)l * 1024 * 1024, (size_t)(32 * nb), 1024, 0, scr, lane); continue; } r -= I_OUT;
        if (r < 16 * (2 * I_G + I_DN)) { const int e = r / (2 * I_G + I_DN); int q = r % (2 * I_G + I_DN);
            if (q < 2 * I_G) { const int up = q / I_G; q %= I_G; const int kb = q / 16, nb = q % 16, n0 = 32 * nb;
                tr_item(a.in(23 + up) + ((size_t)l * NEXP + e) * 1024 * 512, 512, 64 * kb, n0, (bf16*)(ws + WS_WGU) + ((size_t)l * NEXP + e) * 1024 * 1024, (size_t)((n0 >> 7) * 256 + up * 128 + (n0 & 127)), 1024, 0, scr, lane); }
            else { q -= 2 * I_G; const int kb = q / 32, nb = q % 32; tr_item(a.in(25) + ((size_t)l * NEXP + e) * 512 * 1024, 1024, 64 * kb, 32 * nb, (bf16*)(ws + WS_WDN) + ((size_t)l * NEXP + e) * 1024 * 512, (size_t)(32 * nb), 512, 0, scr, lane); }
            continue; } r -= 16 * (2 * I_G + I_DN);
        { const int gsel = r / 16, hd = (r % 16) / 2, nb = r % 2;
          tr_item(a.in(gsel ? 9 : 7) + ((size_t)l * 8 + hd) * 4096, 64, 0, 32 * nb, (bf16*)(ws + WS_LRUW) + (((size_t)l * 2 + gsel) * 8 + hd) * 4096, (size_t)(32 * nb), 64, 0, scr, lane); }
    }
    const float* gam = a.in(1); const float* bet = a.in(2); bf16* H = (bf16*)(ws + WS_H); signed char* HQ = (signed char*)(ws + WS_HQ); float* HS = (float*)(ws + WS_HS);
    for (int m = gw; m < NTOK; m += NGW) {
        const float* xr = a.in(0) + (size_t)m * D; float v[16];
#pragma unroll
        for (int h = 0; h < 2; ++h) { const f32x4 x0 = *(const f32x4*)(xr + 512 * h + 8 * lane), x1 = *(const f32x4*)(xr + 512 * h + 8 * lane + 4);
            v[8 * h] = x0.x; v[8 * h + 1] = x0.y; v[8 * h + 2] = x0.z; v[8 * h + 3] = x0.w; v[8 * h + 4] = x1.x; v[8 * h + 5] = x1.y; v[8 * h + 6] = x1.z; v[8 * h + 7] = x1.w; }
        ln16(v, gam, bet, lane);
        bf16* hp = H + (size_t)m * D; *(v4u*)(hp + 8 * lane) = pack8f(v); *(v4u*)(hp + 512 + 8 * lane) = pack8f(v + 8);
        quant_row16(v, HQ + (size_t)m * D, HS + m, 8 * lane, 512 + 8 * lane, lane);
    }
}

#define MFMA32(a, b, c) __builtin_amdgcn_mfma_f32_32x32x16_bf16((a), (b), (c), 0, 0, 0)
__device__ __forceinline__ int crow(int r, int hi) { return (r & 3) + 8 * (r >> 2) + 4 * hi; }
__device__ __forceinline__ bf16x8 pack8(const f32x16& x, int s) {
    v4u p; p.x = cvtpk(x[8 * s], x[8 * s + 1]); p.y = cvtpk(x[8 * s + 2], x[8 * s + 3]); p.z = cvtpk(x[8 * s + 4], x[8 * s + 5]); p.w = cvtpk(x[8 * s + 6], x[8 * s + 7]);
    return __builtin_bit_cast(bf16x8, p);
}
__device__ __forceinline__ float softplus2(float z) { return fmaxf(z, 0.f) + flog2(1.f + fexp2(-fabsf(z))); }

template <bool DIAG>
__device__ __forceinline__ bool sb_tile(const LAS unsigned char* kt_lds, const bf16x8 (&qf)[4], const bf16x8 (&tri)[2], bf16x8 mones,
                                        f32x16& o0, f32x16& o1, float& carry, int k0, int t0, int l32, int hi) {
    const int x = l32 & 7; const LAS unsigned char* krow = kt_lds + l32 * 128; const LAS unsigned char* vrow = kt_lds + 8192 + l32 * 128 + 8 * hi;
    f32x16 s0, s1;
#pragma unroll
    for (int r = 0; r < 16; ++r) { s0[r] = 0.f; s1[r] = 0.f; }
#pragma unroll
    for (int i = 0; i < 4; ++i) { const int po = ((2 * i + hi) ^ x) * 16;
        const bf16x8 ka = *(const LAS bf16x8*)(krow + po), kb = *(const LAS bf16x8*)(krow + 32 * 128 + po);
        s0 = MFMA32(ka, qf[i], s0); s1 = MFMA32(kb, qf[i], s1); }
    const float z00 = s0[0];
    v4u L[4];
#pragma unroll
    for (int f = 0; f < 2; ++f)
#pragma unroll
        for (int i = 0; i < 4; ++i) { const int r = 8 * f + 2 * i;
            float a0 = softplus2(s0[r]), a1 = softplus2(s0[r + 1]), b0 = softplus2(s1[r]), b1 = softplus2(s1[r + 1]);
            if (DIAG) { const int q = t0 + l32, ka = k0 + crow(r, hi), kb = k0 + crow(r + 1, hi); if (ka >= q) a0 = 0.f; if (kb >= q) a1 = 0.f; if (ka + 32 >= q) b0 = 0.f; if (kb + 32 >= q) b1 = 0.f; }
            L[f][i] = cvtpk(a0, a1); L[2 + f][i] = cvtpk(b0, b1); }
#pragma unroll
    for (int r = 0; r < 16; ++r) { s0[r] -= carry; s1[r] -= carry; }
    s0 = MFMA32(tri[0], __builtin_bit_cast(bf16x8, L[0]), s0); s0 = MFMA32(tri[1], __builtin_bit_cast(bf16x8, L[1]), s0); s0 = MFMA32(mones, __builtin_bit_cast(bf16x8, L[2]), s0); s0 = MFMA32(mones, __builtin_bit_cast(bf16x8, L[3]), s0);
    s1 = MFMA32(tri[0], __builtin_bit_cast(bf16x8, L[2]), s1); s1 = MFMA32(tri[1], __builtin_bit_cast(bf16x8, L[3]), s1);
    float tot = (z00 - carry) - s0[0];
    tot = __shfl(tot, l32);
    v4u P[4];
#pragma unroll
    for (int f = 0; f < 2; ++f)
#pragma unroll
        for (int i = 0; i < 4; ++i) { const int r = 8 * f + 2 * i;
            float a0 = fexp2(s0[r]), a1 = fexp2(s0[r + 1]), b0 = fexp2(s1[r]), b1 = fexp2(s1[r + 1]);
            if (DIAG) { const int q = t0 + l32, ka = k0 + crow(r, hi), kb = k0 + crow(r + 1, hi); if (ka >= q) a0 = 0.f; if (kb >= q) a1 = 0.f; if (ka + 32 >= q) b0 = 0.f; if (kb + 32 >= q) b1 = 0.f; }
            P[f][i] = cvtpk(a0, a1); P[2 + f][i] = cvtpk(b0, b1); }
    carry += tot;
#pragma unroll
    for (int db = 0; db < 2; ++db) {
        f32x16 o = db ? o1 : o0;
#pragma unroll
        for (int s = 0; s < 4; ++s) { const v2u lo = *(const LAS v2u*)(vrow + db * 32 * 128 + (((2 * s) ^ x) * 16)), hi8 = *(const LAS v2u*)(vrow + db * 32 * 128 + (((2 * s + 1) ^ x) * 16));
            o = MFMA32(__builtin_bit_cast(bf16x8, (v4u){lo.x, lo.y, hi8.x, hi8.y}), __builtin_bit_cast(bf16x8, P[s]), o); }
        if (db) o1 = o; else o0 = o;
    }
    return __all(carry > 150.f) != 0;
}
__device__ __forceinline__ void sb_attn_wg(const bf16* __restrict__ Q, const bf16* __restrict__ Kh, const bf16* __restrict__ VT, bf16* Y, LAS unsigned char* lds, int b, int hd, int qg, int wave, int lane) {
    const int l32 = lane & 31, hi = lane >> 5, seq0 = b * SEQ, T0 = qg * 256, t0 = T0 + 32 * wave, ktd = t0 >> 6, B = T0 >> 6;
    LAS int* FL = (LAS int*)(lds + LDSCTL_OFF + 2048);
    const int koff = (wave * 8 + (lane >> 3)) * 64 + (((lane & 7) ^ ((lane >> 3) & 7)) * 8);
    const bf16* ksrc = Kh + ((size_t)hd * HTOK + seq0) * 64 + koff; const bf16* vsrc = VT + ((size_t)hd * 256 + (seq0 >> 6)) * 4096 + koff;
#define SB_STAGE(kt) do { const unsigned so_ = (unsigned)(((kt) & 7) * 16384 + wave * 1024); \
        __builtin_amdgcn_global_load_lds((const unsigned*)(ksrc + (size_t)(kt) * 4096), (LAS unsigned*)(lds + so_), 16, 0, 0); \
        __builtin_amdgcn_global_load_lds((const unsigned*)(vsrc + (size_t)(kt) * 4096), (LAS unsigned*)(lds + so_ + 8192), 16, 0, 0); } while (0)
#pragma unroll
    for (int i = 0; i < 4; ++i) SB_STAGE(B + i);
    bf16x8 qf[4];
    { const bf16* qp = Q + (size_t)(seq0 + t0 + l32) * 512 + hd * 64 + 8 * hi;
#pragma unroll
      for (int i = 0; i < 4; ++i) qf[i] = *(const bf16x8*)(qp + 16 * i); }
    bf16x8 tri[2], mones;
#pragma unroll
    for (int i2 = 0; i2 < 2; ++i2)
#pragma unroll
        for (int j = 0; j < 8; ++j) { const int ko = 16 * i2 + 8 * (j >> 2) + 4 * hi + (j & 3); tri[i2][j] = (ko >= l32) ? (short)0xBF80 : (short)0; }
#pragma unroll
    for (int j = 0; j < 8; ++j) mones[j] = (short)0xBF80;
    f32x16 o0, o1;
#pragma unroll
    for (int r = 0; r < 16; ++r) { o0[r] = 0.f; o1[r] = 0.f; }
    float carry = 0.f; bool done = false;
    if (lane == 0) FL[wave] = 0;
#pragma unroll 1
    for (int j = 0; ; ++j) {
        asm volatile("s_waitcnt vmcnt(0)" ::: "memory");
        __syncthreads();
        const pg8::u32x4 f0 = *(const LAS pg8::u32x4*)(FL + (j & 1) * 8), f1 = *(const LAS pg8::u32x4*)(FL + (j & 1) * 8 + 4);
        if ((f0.x & f0.y & f0.z & f0.w & f1.x & f1.y & f1.z & f1.w) != 0u) break;
        if (B - j - 1 >= 0) SB_STAGE(B - j - 1);
        const int kt = ktd - j;
        if (!done) {
            if (kt < 0) done = true;
            else { const LAS unsigned char* tl = lds + (kt & 7) * 16384;
                if (j == 0) done = sb_tile<true>(tl, qf, tri, mones, o0, o1, carry, kt * 64, t0, l32, hi);
                else done = sb_tile<false>(tl, qf, tri, mones, o0, o1, carry, kt * 64, t0, l32, hi);
                if (kt == 0) done = true; }
        }
        if (lane == 0) FL[((j + 1) & 1) * 8 + wave] = done ? 1 : 0;
    }
#undef SB_STAGE
    bf16* yp = Y + (size_t)(seq0 + t0 + l32) * 1536 + hd * 64 + 4 * hi;
#pragma unroll
    for (int g = 0; g < 4; ++g) {
        *(v2u*)(yp + 8 * g) = (v2u){cvtpk(o0[4 * g], o0[4 * g + 1]), cvtpk(o0[4 * g + 2], o0[4 * g + 3])};
        *(v2u*)(yp + 32 + 8 * g) = (v2u){cvtpk(o1[4 * g], o1[4 * g + 1]), cvtpk(o1[4 * g + 2], o1[4 * g + 3])};
    }
    __syncthreads();
}

__device__ __forceinline__ void lru_local_task(const KA& a, int l, const bf16* __restrict__ LI, bf16* HLOC, bf16* CUMA, float* SUMA, float* SUMH, const bf16* __restrict__ LW,
                                               LAS bf16* U, int b, int ch, int hd, int lane) {
    const int seq0 = b * SEQ, t0 = ch * 64;
    { const int co = lane & 7, sub = lane >> 3, c0 = hd * 64 + co * 8;
      const float* cw = a.in(5) + (size_t)l * 4 * 512 + c0; const float* cb = a.in(6) + (size_t)l * 512 + c0;
      float w[4][8], bias[8];
#pragma unroll
      for (int k = 0; k < 4; ++k) { const f32x4 x0 = *(const f32x4*)(cw + k * 512), x1 = *(const f32x4*)(cw + k * 512 + 4);
          w[k][0] = x0.x; w[k][1] = x0.y; w[k][2] = x0.z; w[k][3] = x0.w; w[k][4] = x1.x; w[k][5] = x1.y; w[k][6] = x1.z; w[k][7] = x1.w; }
      { const f32x4 x0 = *(const f32x4*)(cb), x1 = *(const f32x4*)(cb + 4); bias[0] = x0.x; bias[1] = x0.y; bias[2] = x0.z; bias[3] = x0.w; bias[4] = x1.x; bias[5] = x1.y; bias[6] = x1.z; bias[7] = x1.w; }
#pragma unroll 2
      for (int it = 0; it < 8; ++it) { const int tl = it * 8 + sub, t = t0 + tl; float u[8];
#pragma unroll
          for (int j = 0; j < 8; ++j) u[j] = bias[j];
#pragma unroll
          for (int k = 0; k < 4; ++k) { const int tt = t - 3 + k; if (tt >= 0) { const v4u x = *(const v4u*)(LI + (size_t)(seq0 + tt) * 512 + c0);
              u[0] += w[k][0] * bflo(x.x); u[1] += w[k][1] * bfhi(x.x); u[2] += w[k][2] * bflo(x.y); u[3] += w[k][3] * bfhi(x.y);
              u[4] += w[k][4] * bflo(x.z); u[5] += w[k][5] * bfhi(x.z); u[6] += w[k][6] * bflo(x.w); u[7] += w[k][7] * bfhi(x.w); } }
          *(LAS v4u*)(U + tl * 72 + co * 8) = (v4u){pk2(u[0], u[1]), pk2(u[2], u[3]), pk2(u[4], u[5]), pk2(u[6], u[7])}; }
      LDS_WAIT(); asm volatile("" ::: "memory"); }
    const int l32 = lane & 31, hi = lane >> 5;
    bf16x8 af[2][4];
#pragma unroll
    for (int mb = 0; mb < 2; ++mb)
#pragma unroll
        for (int ks = 0; ks < 4; ++ks) af[mb][ks] = *(const LAS bf16x8*)(U + (mb * 32 + l32) * 72 + 16 * ks + 8 * hi);
    float Hrun = 0.f, Arun = 1.f;
#pragma unroll 1
    for (int nb = 0; nb < 2; ++nb) {
        const int chn = hd * 64 + nb * 32 + l32;
        const bf16* wa = LW + ((size_t)(l * 2 + 0) * 8 + hd) * 4096 + (nb * 32 + l32) * 64 + 8 * hi;
        const bf16* wx = LW + ((size_t)(l * 2 + 1) * 8 + hd) * 4096 + (nb * 32 + l32) * 64 + 8 * hi;
        f32x16 da[2], dx[2];
#pragma unroll
        for (int mb = 0; mb < 2; ++mb)
#pragma unroll
            for (int r = 0; r < 16; ++r) { da[mb][r] = 0.f; dx[mb][r] = 0.f; }
#pragma unroll
        for (int ks = 0; ks < 4; ++ks) { const bf16x8 ba = *(const bf16x8*)(wa + 16 * ks), bx = *(const bf16x8*)(wx + 16 * ks);
#pragma unroll
            for (int mb = 0; mb < 2; ++mb) { da[mb] = MFMA32(af[mb][ks], ba, da[mb]); dx[mb] = MFMA32(af[mb][ks], bx, dx[mb]); } }
        const float b_a = a.in(8)[l * 512 + chn], b_x = a.in(10)[l * 512 + chn], lam = a.in(11)[l * 512 + chn];
        const float c8 = -8.f * (fmaxf(-lam, 0.f) + log1pf(__expf(-fabsf(lam)))) * LOG2E;
        Hrun = 0.f; Arun = 1.f;
#pragma unroll
        for (int mb = 0; mb < 2; ++mb) {
            float hl[16], cA[16], gA[4], gB[4];
#pragma unroll
            for (int g = 0; g < 4; ++g) { float h = 0.f, A = 1.f;
#pragma unroll
                for (int j = 0; j < 4; ++j) { const int r = 4 * g + j, tl = mb * 32 + crow(r, hi);
                    const float ra = sigmoidf_(da[mb][r] + b_a), ix = sigmoidf_(dx[mb][r] + b_x);
                    const float la2 = c8 * ra, av = fexp2(la2), mult = sqrtf(fmaxf(1.f - fexp2(2.f * la2), 0.f));
                    const float uv = bf1(U[tl * 72 + nb * 32 + l32]);
                    const float dr = mult * ix * uv;
                    h = av * h + dr; A *= av; hl[r] = h; cA[r] = A; }
                gA[g] = A; gB[g] = h; }
#pragma unroll
            for (int g = 0; g < 4; ++g) {
                const float pA = __shfl_xor(gA[g], 32), pB = __shfl_xor(gB[g], 32);
                const float A0 = hi ? pA : gA[g], B0 = hi ? pB : gB[g], A1 = hi ? gA[g] : pA, B1 = hi ? gB[g] : pB;
                const float in0 = Hrun, inA0 = Arun; Hrun = A0 * Hrun + B0; Arun *= A0;
                const float in1 = Hrun, inA1 = Arun; Hrun = A1 * Hrun + B1; Arun *= A1;
                const float my_in = hi ? in1 : in0, my_inA = hi ? inA1 : inA0;
#pragma unroll
                for (int j = 0; j < 4; ++j) { const int r = 4 * g + j, tl = mb * 32 + crow(r, hi); const size_t o = (size_t)(seq0 + t0 + tl) * 512 + chn;
                    HLOC[o] = (bf16)f2bf(hl[r] + cA[r] * my_in); CUMA[o] = (bf16)f2bf(cA[r] * my_inA); }
            }
        }
        if (hi == 0) { const size_t so = ((size_t)b * 64 + ch) * 512 + chn; SUMA[so] = Arun; SUMH[so] = Hrun; }
    }
    LDS_WAIT(); asm volatile("" ::: "memory");
}
__device__ __forceinline__ void sc_pass(const KA& a, int l, const bf16* __restrict__ SB, const bf16* __restrict__ P, bf16* Y, int gt, int ngt) {
    const float* cw = a.in(12) + (size_t)l * 3 * 512;
    for (int it = gt; it < HTOK * 64; it += ngt) {
        const int row = it >> 6, c0 = (it & 63) * 8, t = row & (SEQ - 1);
        const v4u sb = *(const v4u*)(SB + (size_t)row * 512 + c0), p2 = *(const v4u*)(P + (size_t)row * 512 + c0);
        v4u p1 = (v4u){0u, 0u, 0u, 0u}, p0 = (v4u){0u, 0u, 0u, 0u};
        if (t >= 1) p1 = *(const v4u*)(P + (size_t)(row - 1) * 512 + c0);
        if (t >= 2) p0 = *(const v4u*)(P + (size_t)(row - 2) * 512 + c0);
        float w0[8], w1[8], w2[8];
#pragma unroll
        for (int h = 0; h < 2; ++h) { const f32x4 x0 = *(const f32x4*)(cw + c0 + 4 * h), x1 = *(const f32x4*)(cw + 512 + c0 + 4 * h), x2 = *(const f32x4*)(cw + 1024 + c0 + 4 * h);
#pragma unroll
            for (int j = 0; j < 4; ++j) { w0[4 * h + j] = x0[j]; w1[4 * h + j] = x1[j]; w2[4 * h + j] = x2[j]; } }
        const unsigned s_[4] = {sb.x, sb.y, sb.z, sb.w}, q0[4] = {p0.x, p0.y, p0.z, p0.w}, q1[4] = {p1.x, p1.y, p1.z, p1.w}, q2[4] = {p2.x, p2.y, p2.z, p2.w};
        unsigned o[4];
#pragma unroll
        for (int j = 0; j < 4; ++j) { const float lo = bflo(s_[j]) * (w0[2 * j] * bflo(q0[j]) + w1[2 * j] * bflo(q1[j]) + w2[2 * j] * bflo(q2[j]));
            const float hi = bfhi(s_[j]) * (w0[2 * j + 1] * bfhi(q0[j]) + w1[2 * j + 1] * bfhi(q1[j]) + w2[2 * j + 1] * bfhi(q2[j])); o[j] = cvtpk(lo, hi); }
        *(v4u*)(Y + (size_t)row * 1536 + 1024 + c0) = (v4u){o[0], o[1], o[2], o[3]};
    }
}
__device__ __forceinline__ float gelu_tanh_f(float x) { return x * sigmoidf_(2.f * 0.7978845608028654f * (x + 0.044715f * x * x * x)); }
__device__ __forceinline__ void lru_fix_task(const bf16* __restrict__ LG, const bf16* __restrict__ HLOC, const bf16* __restrict__ CUMA, const float* __restrict__ SUMA, const float* __restrict__ SUMH,
                                             bf16* Y, LAS float* CAR, int b, int ch, int tid) {
    { float carry = 0.f; const float* pa = SUMA + (size_t)b * 64 * 512 + tid; const float* ph = SUMH + (size_t)b * 64 * 512 + tid;
#pragma unroll 8
      for (int c = 0; c < ch; ++c) carry = pa[c * 512] * carry + ph[c * 512];
      CAR[tid] = carry; }
    __syncthreads();
    const int g8 = (tid & 63) * 8; float cr[8];
#pragma unroll
    for (int j = 0; j < 8; ++j) cr[j] = CAR[g8 + j];
    const size_t r0 = (size_t)b * SEQ + ch * 64;
#pragma unroll 2
    for (int k = 0; k < 8; ++k) { const size_t row = r0 + (tid >> 6) + 8 * k, o = row * 512 + g8;
        float x[8], h[8], c[8]; unpack8(*(const v4u*)(LG + o), x); unpack8(*(const v4u*)(HLOC + o), h); unpack8(*(const v4u*)(CUMA + o), c);
#pragma unroll
        for (int j = 0; j < 8; ++j) x[j] = gelu_tanh_f(x[j]) * (h[j] + c[j] * cr[j]);
        *(v4u*)(Y + row * 1536 + 512 + g8) = pack8f(x); }
    __syncthreads();
}

__device__ __forceinline__ void p6_ln1_router(const KA& a, int l, LAS unsigned char* lds, int G, int tid, int wave, int lane) {
    unsigned char* ws = a.ws(); bf16* H = (bf16*)(ws + WS_H); float* WTS = (float*)(ws + WS_WTS); unsigned* LIST = (unsigned*)(ws + WS_LIST); gu32* ctl = (gu32*)(ws + WS_CTL);
    LAS float* RW = (LAS float*)lds;
    LAS int* ENT = (LAS int*)(lds + 81920);
    LAS int* RANK = ENT + 256;
    LAS unsigned* LCNT = (LAS unsigned*)(RANK + 256);
    LAS unsigned* LBASE = LCNT + 16;
    LAS float* LGS = (LAS float*)(lds + 81920 + 4096) + wave * (16 * 20 * 4);
    { const float* wg = a.in(19) + (size_t)l * 1024 * 4; const float* we = a.in(21) + (size_t)l * 1024 * 16;
      for (int i = tid; i < 1024 * 4; i += 512) RW[(i & 3) * 1024 + (i >> 2)] = wg[i];
      for (int i = tid; i < 1024 * 16; i += 512) RW[(4 + (i & 15)) * 1024 + (i >> 4)] = we[i]; }
    __syncthreads();
    const float* gam = a.in(17) + l * D; const float* bet = a.in(18) + l * D; const float* gbias = a.in(20) + l * 4; const float* ebias = a.in(22) + l * 16;
    for (int rb = blockIdx.x; rb < NTOK / 128; rb += G) {
        if (tid < 16) LCNT[tid] = 0u;
#pragma unroll 1
        for (int grp = 0; grp < 4; ++grp) {
            float v[4][16];
#pragma unroll
            for (int r = 0; r < 4; ++r) { bf16* hp = H + (size_t)(rb * 128 + wave * 16 + grp * 4 + r) * D; unpack8(*(const v4u*)(hp + 8 * lane), v[r]); unpack8(*(const v4u*)(hp + 512 + 8 * lane), v[r] + 8); }
#pragma unroll
            for (int r = 0; r < 4; ++r) { ln16(v[r], gam, bet, lane); bf16* hp = H + (size_t)(rb * 128 + wave * 16 + grp * 4 + r) * D; *(v4u*)(hp + 8 * lane) = pack8f(v[r]); *(v4u*)(hp + 512 + 8 * lane) = pack8f(v[r] + 8); }
#pragma unroll 2
            for (int o = 0; o < 20; ++o) { const LAS float* w = RW + o * 1024 + 8 * lane; float wv[16];
#pragma unroll
                for (int h = 0; h < 2; ++h) { const f32x4 w0 = *(const LAS f32x4*)(w + 512 * h), w1 = *(const LAS f32x4*)(w + 512 * h + 4);
                    wv[8 * h] = w0.x; wv[8 * h + 1] = w0.y; wv[8 * h + 2] = w0.z; wv[8 * h + 3] = w0.w; wv[8 * h + 4] = w1.x; wv[8 * h + 5] = w1.y; wv[8 * h + 6] = w1.z; wv[8 * h + 7] = w1.w; }
#pragma unroll
                for (int r = 0; r < 4; ++r) { float s = 0.f;
#pragma unroll
                    for (int j = 0; j < 16; ++j) s += v[r][j] * wv[j];
                    s = row16_sum(s);
                    if ((lane & 15) == 0) LGS[((grp * 4 + r) * 20 + o) * 4 + (lane >> 4)] = s; } }
        }
        LDS_WAIT(); asm volatile("" ::: "memory");
        if (lane < 16) {
            const int rl = wave * 16 + lane, row = rb * 128 + rl; float lg[20];
#pragma unroll
            for (int o = 0; o < 20; ++o) { const f32x4 p = *(const LAS f32x4*)(LGS + (lane * 20 + o) * 4); lg[o] = (p.x + p.y) + (p.z + p.w); }
            int gs = 0; float bestg = lg[0] + gbias[0];
#pragma unroll
            for (int g = 1; g < 4; ++g) { const float x = lg[g] + gbias[g]; if (x > bestg) { bestg = x; gs = g; } }
            const float gmax = fmaxf(fmaxf(lg[0], lg[1]), fmaxf(lg[2], lg[3]));
            float gden = 0.f, gnum = 0.f;
#pragma unroll
            for (int g = 0; g < 4; ++g) { const float e = __expf(lg[g] - gmax); gden += e; gnum = (g == gs) ? e : gnum; }
            const float gprob = gnum / gden;
            float ein[4], eb[4];
#pragma unroll
            for (int i = 0; i < 4; ++i) { ein[i] = gs == 0 ? lg[4 + i] : gs == 1 ? lg[8 + i] : gs == 2 ? lg[12 + i] : lg[16 + i]; eb[i] = ein[i] + ebias[gs * 4 + i]; }
            int i0 = 0; float b0 = eb[0];
#pragma unroll
            for (int i = 1; i < 4; ++i) if (eb[i] > b0) { b0 = eb[i]; i0 = i; }
            int i1 = -1; float b1 = 0.f;
#pragma unroll
            for (int i = 0; i < 4; ++i) if (i != i0 && (i1 < 0 || eb[i] > b1)) { b1 = eb[i]; i1 = i; }
            const float x0 = i0 == 0 ? ein[0] : i0 == 1 ? ein[1] : i0 == 2 ? ein[2] : ein[3], x1 = i1 == 0 ? ein[0] : i1 == 1 ? ein[1] : i1 == 2 ? ein[2] : ein[3];
            const float mx = fmaxf(x0, x1), e0 = __expf(x0 - mx), e1 = __expf(x1 - mx), inv = gprob / (e0 + e1);
            *(pg8::f32x2*)(WTS + (size_t)row * 2) = (pg8::f32x2){e0 * inv, e1 * inv}; ENT[rl * 2] = gs * 4 + i0; ENT[rl * 2 + 1] = gs * 4 + i1;
        }
        __syncthreads();
        if (tid < 256) RANK[tid] = (int)__hip_atomic_fetch_add((LAS unsigned*)&LCNT[ENT[tid]], 1u, __ATOMIC_RELAXED, __HIP_MEMORY_SCOPE_WORKGROUP);
        __syncthreads();
        if (tid < 16) LBASE[tid] = __hip_atomic_fetch_add(ctl + CW_CNT + (l * 16 + tid) * 64, LCNT[tid], RLX_AGENT);
        __syncthreads();
        if (tid < 256) { const int e = ENT[tid]; LIST[(size_t)e * LISTCAP + LBASE[e] + RANK[tid]] = (unsigned)((rb * 128 + (tid >> 1)) * 2 + (tid & 1)); }
        __syncthreads();
    }
}
__device__ __forceinline__ void moe_table(const KA& a, int l, LAS int* tab, int tid) {
    gu32* ctl = (gu32*)(a.ws() + WS_CTL);
    if (tid < 16) tab[17 + tid] = (int)__hip_atomic_load(ctl + CW_CNT + (l * 16 + tid) * 64, RLX_AGENT);
    __syncthreads();
    if (tid == 0) { int s = 0; for (int e = 0; e < 16; ++e) { tab[e] = s; s += (tab[17 + e] + 255) >> 8; } tab[16] = s; }
    __syncthreads();
}
__device__ __forceinline__ void p9_ln2(const KA& a, int l, int gw, int NGW, int lane) {
    unsigned char* ws = a.ws(); bf16* H = (bf16*)(ws + WS_H); const float* WTS = (const float*)(ws + WS_WTS); const bf16* F0 = (const bf16*)(ws + WS_FFN); const bf16* F1 = F0 + (size_t)NTOK * D;
    const float* gam = a.in(26) + l * D; const float* bet = a.in(27) + l * D;
    for (int row = gw; row < NTOK; row += NGW) {
        bf16* hp = H + (size_t)row * D; const bf16* f0 = F0 + (size_t)row * D; const bf16* f1 = F1 + (size_t)row * D; const float w0 = WTS[(size_t)row * 2], w1 = WTS[(size_t)row * 2 + 1];
        float v[16], x[8], y[8];
#pragma unroll
        for (int h = 0; h < 2; ++h) { unpack8(*(const v4u*)(hp + 512 * h + 8 * lane), v + 8 * h); unpack8(*(const v4u*)(f0 + 512 * h + 8 * lane), x); unpack8(*(const v4u*)(f1 + 512 * h + 8 * lane), y);
#pragma unroll
            for (int j = 0; j < 8; ++j) v[8 * h + j] = ALPHA * v[8 * h + j] + w0 * x[j] + w1 * y[j]; }
        ln16(v, gam, bet, lane);
        if (l == DEPTH - 1) { float* op = a.out() + (size_t)row * D;
#pragma unroll
            for (int h = 0; h < 2; ++h) { *(f32x4*)(op + 512 * h + 8 * lane) = (f32x4){v[8 * h], v[8 * h + 1], v[8 * h + 2], v[8 * h + 3]}; *(f32x4*)(op + 512 * h + 8 * lane + 4) = (f32x4){v[8 * h + 4], v[8 * h + 5], v[8 * h + 6], v[8 * h + 7]}; } }
        else { *(v4u*)(hp + 8 * lane) = pack8f(v); *(v4u*)(hp + 512 + 8 * lane) = pack8f(v + 8);
            quant_row16(v, (signed char*)(ws + WS_HQ) + (size_t)row * D, (float*)(ws + WS_HS) + row, 8 * lane, 512 + 8 * lane, lane); }
    }
}

#ifndef PH_MASK
#define PH_MASK 0xFFFF
#endif
#ifndef REP_MASK
#define REP_MASK 0
#endif
#define REPS(bit) for (int rep_ = 0; rep_ < ((REP_MASK & (bit)) ? 2 : 1); ++rep_)
#ifndef STOP_AT
#define STOP_AT 0
#endif
#define STOP_DUMP(n, off) do { if (STOP_AT == (n) && l == 0 && hf == 0) { PHASE_BEGIN const bf16* H_ = (const bf16*)(ws + (off)); float* o_ = A_.out(); for (size_t i = (size_t)bx * 512 + tid; i < (size_t)NTOK * D; i += (size_t)G * 512) o_[i] = bf1(H_[i]); return; } } while (0)
#define STOP_HERE(n) do { if (STOP_AT == (n)) { PHASE_BEGIN const bf16* H_ = (const bf16*)(ws + WS_H); float* o_ = A_.out(); for (size_t i = (size_t)bx * 512 + tid; i < (size_t)NTOK * D; i += (size_t)G * 512) o_[i] = bf1(H_[i]); return; } } while (0)
__global__ void __launch_bounds__(NWAVES * 64, 2) hybrid_fwd(Args args) {
    extern __shared__ __attribute__((aligned(16))) unsigned char lds_raw[];
    LAS unsigned char* lds = (LAS unsigned char*)lds_raw;
    const int G = gridDim.x, bx = blockIdx.x;
#define PHASE_BEGIN KA A_; A_.kp = (KP)__builtin_amdgcn_kernarg_segment_ptr(); asm volatile("" : "+s"(A_.kp)); int tid = threadIdx.x; asm volatile("" : "+v"(tid)); \
    const int lane = tid & 63, wave = __builtin_amdgcn_readfirstlane(tid >> 6), gw = bx * NWAVES + wave, NGW = G * NWAVES; unsigned char* ws = A_.ws(); (void)lane; (void)gw; (void)NGW; (void)ws;
    XcdBarrier bar;
    { PHASE_BEGIN
      for (int u = tid; u < (LDS_BYTES - LDSCTL_OFF) / 4; u += NWAVES * 64) ((LAS unsigned*)(lds + LDSCTL_OFF))[u] = 0u;
      __syncthreads();
      bar = xcd_barrier_post((unsigned*)(ws + WS_CTL) + CW_BAR, (volatile LAS unsigned*)(lds + MISC_OFF) + 8);
      REPS(1) if (PH_MASK & 1) p0_prologue(A_, lds, gw, NGW, wave, lane); }
    xcd_barrier(bar);
    STOP_HERE(1);

#pragma unroll 1
    for (int l = 0; l < DEPTH; ++l) {
#pragma unroll 1
        for (int hf = 0; hf < 2; ++hf) {
            REPS(2) if (PH_MASK & 2) { PHASE_BEGIN
              InprojSched S; S.G = G; S.c = bx; S.Hh = (const char*)(ws + WS_HQ) + (size_t)hf * HTOK * D; S.Win = (const char*)(ws + WS_WIN) + (size_t)l * PROJ * 1024;
              EpiInproj E{(bf16*)(ws + WS_ZC), (bf16*)(ws + WS_G), (bf16*)(ws + WS_VT), A_.in(4) + (size_t)l * 3 * 1024, (const float*)(ws + WS_HS) + hf * HTOK, (const float*)(ws + WS_CTL) + CW_WS + l * PROJ};
              pg8::gemm_phase<EpiInproj, InprojSched, true, false, true>(lds, pg8::Gemm{512, 512, 512}, S, E); }
            xcd_barrier(bar);
            STOP_DUMP(10, WS_ZC); STOP_DUMP(11, WS_ZC + 64 * MiB); STOP_DUMP(12, WS_ZC + 128 * MiB); STOP_DUMP(13, WS_ZC + 144 * MiB);
            REPS(4) if (PH_MASK & 4) { PHASE_BEGIN
              bf16* ZC = (bf16*)(ws + WS_ZC); bf16* Y = (bf16*)(ws + WS_Y); bf16* HLOC = (bf16*)(ws + WS_MRG); bf16* CUMA = HLOC + (size_t)HTOK * 512; float* SUMA = (float*)(ws + WS_SUM); float* SUMH = SUMA + 4 * 64 * 512;
              LAS bf16* U = (LAS bf16*)(lds + wave * 9216);
              REPS(1024) for (int t = gw; t < 4 * 64 * 8; t += NGW) lru_local_task(A_, l, ZC + (size_t)2 * HTOK * 512, HLOC, CUMA, SUMA, SUMH, (const bf16*)(ws + WS_LRUW), U, t >> 9, (t >> 3) & 63, t & 7, lane);
              __syncthreads();
              REPS(2048) for (int t = bx; t < 4 * 8 * 16; t += G) sb_attn_wg(ZC, ZC + (size_t)HTOK * 512, (const bf16*)(ws + WS_VT), Y, lds, t >> 7, (t >> 4) & 7, t & 15, wave, lane);
              REPS(4096) sc_pass(A_, l, ZC + (size_t)4 * HTOK * 512, ZC + (size_t)5 * HTOK * 512, Y, bx * 512 + tid, G * 512); }
            xcd_barrier(bar);
            STOP_DUMP(20, WS_Y); STOP_DUMP(21, WS_MRG);
            REPS(8) if (PH_MASK & 8) { PHASE_BEGIN
              const bf16* HLOC = (const bf16*)(ws + WS_MRG); const bf16* CUMA = HLOC + (size_t)HTOK * 512; const float* SUMA = (const float*)(ws + WS_SUM); const float* SUMH = SUMA + 4 * 64 * 512;
              for (int t = bx; t < 4 * 64; t += G) lru_fix_task((const bf16*)(ws + WS_ZC) + (size_t)3 * HTOK * 512, HLOC, CUMA, SUMA, SUMH, (bf16*)(ws + WS_Y), (LAS float*)lds, t >> 6, t & 63, tid); }
            xcd_barrier(bar);
            STOP_DUMP(30, WS_Y);
            REPS(16) if (PH_MASK & 16) { PHASE_BEGIN
              BranchSched S; S.G = G; S.c = bx; S.Y = (const char*)(ws + WS_Y); S.WBR = (const char*)(ws + WS_WBR) + (size_t)l * 1024 * 1536 * 2;
              EpiBranch E{(const bf16*)(ws + WS_G), (bf16*)(ws + WS_MRG)};
              pg8::gemm_phase<EpiBranch, BranchSched, true, false>(lds, pg8::Gemm{512, 1536, 1536}, S, E); }
            xcd_barrier(bar);
            STOP_DUMP(40, WS_MRG);
            if (PH_MASK & 32) { PHASE_BEGIN
              PlainSched S; S.G = G; S.c = bx; S.nM = 64; S.nN = 4; S.A = (const char*)(ws + WS_MRG); S.B = (const char*)(ws + WS_WOUT) + (size_t)l * 1024 * 1024 * 2; S.astep = (size_t)256 * 1024 * 2; S.bstep = (size_t)256 * 1024 * 2;
              EpiOutproj E{(bf16*)(ws + WS_H) + (size_t)hf * HTOK * D};
              pg8::gemm_phase<EpiOutproj, PlainSched, true, false>(lds, pg8::Gemm{1024, 1024, 1024}, S, E); }
            xcd_barrier(bar);
            STOP_DUMP(50, WS_H);
        }
        STOP_HERE(2);
        if (PH_MASK & 64) { PHASE_BEGIN p6_ln1_router(A_, l, lds, G, tid, wave, lane); }
        xcd_barrier(bar);
        STOP_HERE(3);
        REPS(128) if (PH_MASK & 128) { PHASE_BEGIN
          LAS int* tab = (LAS int*)(lds + MOE_OFF);
          moe_table(A_, l, tab, tid);
          MoeSched S; S.G = G; S.c = bx; S.tab = tab; S.Abase = (const char*)(ws + WS_H); S.atile = 0; S.Wbase = (const char*)(ws + WS_WGU) + (size_t)l * NEXP * 1024 * 1024 * 2; S.wstride = (size_t)1024 * 1024 * 2; S.bstep = (size_t)256 * 1024 * 2;
          S.list = (const unsigned*)(ws + WS_LIST);
          EpiGateUp E{(bf16*)(ws + WS_HB)};
          pg8::gemm_phase<EpiGateUp, MoeSched, true, true>(lds, pg8::Gemm{1024, 1024, 1024}, S, E); }
        xcd_barrier(bar);
        REPS(256) if (PH_MASK & 256) { PHASE_BEGIN
          LAS int* tab = (LAS int*)(lds + MOE_OFF);
          moe_table(A_, l, tab, tid);
          MoeSched S; S.G = G; S.c = bx; S.tab = tab; S.Abase = (const char*)(ws + WS_HB); S.atile = (size_t)256 * 512 * 2; S.Wbase = (const char*)(ws + WS_WDN) + (size_t)l * NEXP * 1024 * 512 * 2; S.wstride = (size_t)1024 * 512 * 2; S.bstep = (size_t)256 * 512 * 2;
          S.list = (const unsigned*)(ws + WS_LIST);
          EpiDown E{(bf16*)(ws + WS_FFN), (const unsigned*)(ws + WS_LIST)};
          pg8::gemm_phase<EpiDown, MoeSched, true, false>(lds, pg8::Gemm{512, 512, 512}, S, E); }
        xcd_barrier(bar);
        if (PH_MASK & 512) { PHASE_BEGIN p9_ln2(A_, l, gw, NGW, lane); }
        if (l + 1 < DEPTH) xcd_barrier(bar);
        STOP_HERE(4);
    }
}

extern "C" void kernel_launch(void* const* d_in, const int* in_sizes, int n_in, void* d_out, int out_size, void* d_ws, size_t ws_size, hipStream_t stream) {
    static int grid = 0;
    if (grid == 0) {
        if (n_in != 28 || in_sizes[0] != NTOK * D || out_size != NTOK * D || ws_size < WS_END) { fprintf(stderr, "kernel_launch: unexpected shapes (n_in %d, in0 %d, out %d, ws %zu); nothing launched\n", n_in, n_in > 0 ? in_sizes[0] : -1, out_size, ws_size); grid = -1; return; }
        int dev = 0, cus = 0, per_cu = 0;
        if (hipGetDevice(&dev) != hipSuccess || hipDeviceGetAttribute(&cus, hipDeviceAttributeMultiprocessorCount, dev) != hipSuccess) { grid = -1; return; }
        if (hipFuncSetAttribute((const void*)hybrid_fwd, hipFuncAttributeMaxDynamicSharedMemorySize, LDS_BYTES) != hipSuccess) { fprintf(stderr, "kernel_launch: hipFuncSetAttribute failed\n"); grid = -1; return; }
        if (hipOccupancyMaxActiveBlocksPerMultiprocessor(&per_cu, (const void*)hybrid_fwd, NWAVES * 64, LDS_BYTES) != hipSuccess || per_cu < 1) fprintf(stderr, "kernel_launch: occupancy query reports %d\n", per_cu);
        (void)hipGetLastError();
        grid = cus;
    }
    if (grid < 0) return;
    if (hipMemsetAsync((char*)d_ws + WS_CTL, 0, CTL_ZERO_BYTES, stream) != hipSuccess) return;
    Args a{};
    for (int i = 0; i < 28; ++i) a.in[i] = (const float*)d_in[i];
    a.out = (float*)d_out; a.ws = (unsigned char*)d_ws;
    hipLaunchKernelGGL(hybrid_fwd, dim3(grid), dim3(NWAVES * 64), LDS_BYTES, stream, a);
}
```

```cpp
#include <hip/hip_runtime.h>
#include <cstdio>
#include <cstdint>
namespace pg8 {
#define PG8_LAS __attribute__((address_space(3)))
typedef unsigned short bf16_t;
typedef short bf16x8 __attribute__((ext_vector_type(8)));
typedef float f32x4 __attribute__((ext_vector_type(4)));
typedef float f32x2 __attribute__((ext_vector_type(2)));
typedef unsigned u32x4 __attribute__((ext_vector_type(4)));
typedef unsigned u32x2 __attribute__((ext_vector_type(2)));
typedef int i32x4 __attribute__((ext_vector_type(4)));
constexpr int BM = 256, BK = 64, HALF = 128, HTB = HALF * BK * 2  , STAGE_BYTES = 8 * HTB, NXCD = 8, WGM = 8;

__host__ __device__ __forceinline__ int lds_byte(int r, int c) { const int st = (r >> 4) * 2 + (c >> 5), rr = r & 15, cc = c & 31, ob = rr * 64 + cc * 2; return st * 1024 + (ob ^ (((ob >> 9) & 1) << 5)); }
__host__ __device__ __forceinline__ void stage_rc(int b, int& R, int& C) { const int st = b / 1024, sb = b % 1024, swz = sb ^ (((sb >> 9) & 1) << 5); R = (st >> 1) * 16 + swz / 64; C = (st & 1) * 32 + (swz % 64) / 2; }
__host__ __device__ __forceinline__ int perm32(int rho) { const int n = rho >> 4, i = rho & 15; return 8 * (i >> 2) + 4 * n + (i & 3); }

struct Unit { int pm, pn, ty, aux, nv, pad; const char* A; const char* B; };
struct Gemm { int K, lda, ldb; };

__device__ __forceinline__ void tile_swz(int L, int nM, int nN, int& pm, int& pn) {
    const int nwg = nM * nN; int wgid = L; { const int q = nwg / NXCD, r = nwg % NXCD, xcd = wgid % NXCD, off = wgid / NXCD; wgid = (xcd < r ? xcd * (q + 1) : r * (q + 1) + (xcd - r) * q) + off; }
    const int nig = WGM * nN, gid = wgid / nig, fm = gid * WGM, gsz = (nM - fm) < WGM ? (nM - fm) : WGM;
    pm = fm + ((wgid % nig) % gsz); pn = (wgid % nig) / gsz;
}
__device__ __forceinline__ unsigned cvt_pk_bf16(float lo, float hi) { unsigned r; asm volatile("v_cvt_pk_bf16_f32 %0, %1, %2" : "=v"(r) : "v"(lo), "v"(hi)); return r; }

template <class Epi, class Sched, bool ALIGN_EPI, bool GATHER, bool I8 = false>
__device__ __forceinline__ void gemm_phase(PG8_LAS unsigned char* lds, const Gemm g, const Sched& S, const Epi& E) {
    int tid = threadIdx.x; asm volatile("" : "+v"(tid));
    const int wid = __builtin_amdgcn_readfirstlane(tid >> 6), lane = tid & 63, wr = wid >> 2, wc = wid & 3, fr = lane & 15, fq = lane >> 4;
    const int K = g.K, nt = K / BK;
    int sR[2], sC[2];
    unsigned cvA[2][2], nvA[2][2], voffB[2];
#pragma unroll
    for (int i = 0; i < 2; ++i) { int R, C; stage_rc(tid * 16 + i * 8192, R, C); sR[i] = R; sC[i] = C; const int Rb = Epi::PERM ? ((R & ~31) + perm32(R & 31)) : R;
        voffB[i] = (unsigned)(Rb * g.ldb + C) * 2u;
#pragma unroll
        for (int h = 0; h < 2; ++h) { cvA[h][i] = (unsigned)((h * HALF + R) * g.lda + C) * 2u; nvA[h][i] = cvA[h][i]; } }
    const size_t kstep = (size_t)(BK * 2);
    const size_t hstepB = (size_t)HALF * g.ldb * 2;
    const unsigned ldsw = (unsigned)wid * 1024u;
    const int aoff = lds_byte(wr * 64 + fr, fq * 8), boff = lds_byte(wc * 32 + fr, fq * 8);
#define PG8_SA(b, h) (((b) * 2 + (h)) * HTB)
#define PG8_SB(b, h) ((4 + (b) * 2 + (h)) * HTB)
#define PG8_STAGE(bufoff, gbase, voff) do { _Pragma("unroll") for (int _i = 0; _i < 2; ++_i) \
        __builtin_amdgcn_global_load_lds((const unsigned*)((const char*)(gbase) + (voff)[_i]), (PG8_LAS unsigned*)(lds + (bufoff) + ldsw + _i * 8192), 16, 0, 0); } while (0)
#define PG8_LDA(dst, b, h) do { _Pragma("unroll") for (int m = 0; m < 4; ++m) _Pragma("unroll") for (int k = 0; k < 2; ++k) dst[m][k] = *(const PG8_LAS bf16x8*)(lds + PG8_SA(b, h) + aoff + m * 2048 + k * 1024); } while (0)
#define PG8_LDB(dst, b, h) do { _Pragma("unroll") for (int n = 0; n < 2; ++n) _Pragma("unroll") for (int k = 0; k < 2; ++k) dst[n][k] = *(const PG8_LAS bf16x8*)(lds + PG8_SB(b, h) + boff + n * 2048 + k * 1024); } while (0)
#define PG8_MMA(ai, bj, At, Bt) do { __builtin_amdgcn_s_setprio(1); _Pragma("unroll") for (int m = 0; m < 4; ++m) _Pragma("unroll") for (int n = 0; n < 2; ++n) _Pragma("unroll") for (int k = 0; k < 2; ++k) { \
        if constexpr (I8) acc[ai][bj][m][n] = __builtin_bit_cast(f32x4, __builtin_amdgcn_mfma_i32_16x16x64_i8(__builtin_bit_cast(i32x4, Bt[n][k]), __builtin_bit_cast(i32x4, At[m][k]), __builtin_bit_cast(i32x4, acc[ai][bj][m][n]), 0, 0, 0)); \
        else acc[ai][bj][m][n] = __builtin_amdgcn_mfma_f32_16x16x32_bf16(Bt[n][k], At[m][k], acc[ai][bj][m][n], 0, 0, 0); } __builtin_amdgcn_s_setprio(0); } while (0)
#define PG8_WAIT_V(n) asm volatile("s_waitcnt vmcnt(" #n ")" ::: "memory")
#define PG8_WAIT_L(n) asm volatile("s_waitcnt lgkmcnt(" #n ")" ::: "memory")
#define PG8_BAR __builtin_amdgcn_s_barrier()
#define PG8_SCHED __builtin_amdgcn_sched_barrier(0)
    Unit cur, nxt; int ui = 0;
    if (!S.next(0, cur)) return;
    f32x4 acc[2][2][4][2];
#pragma unroll
    for (int a = 0; a < 2; ++a)
#pragma unroll
        for (int b = 0; b < 2; ++b)
#pragma unroll
            for (int m = 0; m < 4; ++m)
#pragma unroll
                for (int n = 0; n < 2; ++n) acc[a][b][m][n] = (f32x4){0.f, 0.f, 0.f, 0.f};
    bf16x8 At[4][2], B0[2][2], B1[2][2];
    const char* cA = cur.A; const char* cB = cur.B;
    asm volatile("" : "+s"(cA), "+s"(cB));
    if constexpr (GATHER) {
#pragma unroll
        for (int h = 0; h < 2; ++h)
#pragma unroll
            for (int i = 0; i < 2; ++i) cvA[h][i] = (unsigned)(S.arow(cur, h * HALF + sR[i]) * g.lda + sC[i]) * 2u;
        PG8_WAIT_V(0);
    }
    S.a_ready(cur);
    PG8_STAGE(PG8_SB(0, 0), cB, voffB); PG8_STAGE(PG8_SB(0, 1), cB + hstepB, voffB); PG8_STAGE(PG8_SA(0, 0), cA, cvA[0]); PG8_STAGE(PG8_SA(0, 1), cA, cvA[1]);
    if (wr == 1) PG8_BAR;
    PG8_WAIT_V(2); PG8_BAR;
    PG8_STAGE(PG8_SB(1, 0), cB + kstep, voffB); PG8_STAGE(PG8_SA(1, 0), cA + kstep, cvA[0]); PG8_STAGE(PG8_SB(1, 1), cB + hstepB + kstep, voffB);
    PG8_WAIT_V(6); PG8_BAR;
    for (;;) {
        const bool has_next = S.next(ui + 1, nxt);
        const char* nA = has_next ? nxt.A : cA; const char* nB = has_next ? nxt.B : cB;
        asm volatile("" : "+s"(nA), "+s"(nB));
        if constexpr (GATHER) {
            if (has_next) {
#pragma unroll
                for (int h = 0; h < 2; ++h)
#pragma unroll
                    for (int i = 0; i < 2; ++i) nvA[h][i] = (unsigned)(S.arow(nxt, h * HALF + sR[i]) * g.lda + sC[i]) * 2u;
                PG8_WAIT_V(0);
            } else {
#pragma unroll
                for (int h = 0; h < 2; ++h)
#pragma unroll
                    for (int i = 0; i < 2; ++i) nvA[h][i] = cvA[h][i];
            }
        }
        for (int t = 0; t < nt; t += 2) {
            const bool last = (t == nt - 2);
            const char* a1 = cA + (size_t)(t + 1) * kstep;
            const char* a2 = last ? nA : cA + (size_t)(t + 2) * kstep; const char* b2 = last ? nB : cB + (size_t)(t + 2) * kstep;
            const char* a3 = a2 + kstep; const char* b3 = b2 + kstep;
            unsigned o2[2][2];
#pragma unroll
            for (int h = 0; h < 2; ++h)
#pragma unroll
                for (int i = 0; i < 2; ++i) o2[h][i] = (GATHER && last) ? nvA[h][i] : cvA[h][i];
            if (last && has_next) S.a_ready(nxt);
            PG8_LDB(B0, 0, 0); PG8_LDB(B1, 0, 1); PG8_SCHED; PG8_LDA(At, 0, 0); PG8_STAGE(PG8_SA(1, 1), a1, cvA[1]);
            PG8_WAIT_V(8); PG8_WAIT_L(0); PG8_BAR; PG8_MMA(0, 0, At, B0); PG8_MMA(0, 1, At, B1); PG8_BAR; PG8_SCHED;
            PG8_LDA(At, 0, 1); PG8_STAGE(PG8_SB(0, 0), b2, voffB); PG8_STAGE(PG8_SB(0, 1), b2 + hstepB, voffB); PG8_STAGE(PG8_SA(0, 0), a2, o2[0]);
            PG8_WAIT_V(8); PG8_WAIT_L(0); PG8_BAR; PG8_MMA(1, 0, At, B0); PG8_MMA(1, 1, At, B1); PG8_BAR; PG8_SCHED;
            PG8_LDB(B0, 1, 0); PG8_LDB(B1, 1, 1); PG8_SCHED; PG8_LDA(At, 1, 0); PG8_STAGE(PG8_SA(0, 1), a2, o2[1]);
            PG8_WAIT_V(8); PG8_WAIT_L(0); PG8_BAR; PG8_MMA(0, 0, At, B0); PG8_MMA(0, 1, At, B1); PG8_BAR; PG8_SCHED;
            PG8_LDA(At, 1, 1); PG8_STAGE(PG8_SB(1, 0), b3, voffB); PG8_STAGE(PG8_SB(1, 1), b3 + hstepB, voffB); PG8_STAGE(PG8_SA(1, 0), a3, o2[0]);
            PG8_WAIT_V(8); PG8_WAIT_L(0); PG8_BAR; PG8_MMA(1, 0, At, B0); PG8_MMA(1, 1, At, B1); PG8_BAR; PG8_SCHED;
        }
        if constexpr (ALIGN_EPI) { if (wr == 0) PG8_BAR; }
        E(acc, cur, wr, wc, fr, fq); S.done(cur);
        if (!has_next) break;
#pragma unroll
        for (int a = 0; a < 2; ++a)
#pragma unroll
            for (int b = 0; b < 2; ++b)
#pragma unroll
                for (int m = 0; m < 4; ++m)
#pragma unroll
                    for (int n = 0; n < 2; ++n) acc[a][b][m][n] = (f32x4){0.f, 0.f, 0.f, 0.f};
        cur = nxt; cA = nA; cB = nB; ++ui;
        if constexpr (GATHER) {
#pragma unroll
            for (int h = 0; h < 2; ++h)
#pragma unroll
                for (int i = 0; i < 2; ++i) cvA[h][i] = nvA[h][i];
        }
        if constexpr (ALIGN_EPI) { if (wr == 1) PG8_BAR; }
    }
    PG8_WAIT_V(0);
    if constexpr (!ALIGN_EPI) { if (wr == 0) PG8_BAR; }
    PG8_BAR;
#undef PG8_SA
#undef PG8_SB
#undef PG8_STAGE
#undef PG8_LDA
#undef PG8_LDB
#undef PG8_MMA
#undef PG8_WAIT_V
#undef PG8_WAIT_L
#undef PG8_BAR
#undef PG8_SCHED
}
}
constexpr int NWAVES = 8;
constexpr int D = 1024, NTOK = 32768, SEQ = 4096, HTOK = 16384  , DEPTH = 2, NEXP = 16;
constexpr int PROJ = 7168, NMAIN = 6656;
constexpr float ALPHA = 1.41421356237309515f;
constexpr float LN_EPS = 1e-5f;
constexpr float LOG2E = 1.4426950408889634f;
constexpr float C2 = 0.125f * LOG2E;
constexpr int LISTCAP = 32768;

constexpr size_t MiB = 1u << 20;
constexpr size_t WS_CTL = 0, CTL_ZERO_BYTES = 1 * MiB;
constexpr size_t WS_WIN = 1 * MiB;
constexpr size_t WS_WBR = 15 * MiB;
constexpr size_t WS_WOUT = 21 * MiB;
constexpr size_t WS_WGU = 25 * MiB;
constexpr size_t WS_WDN = 89 * MiB;
constexpr size_t WS_LRUW = 121 * MiB;
constexpr size_t WS_HQ = 122 * MiB;
constexpr size_t WS_H = 154 * MiB;
constexpr size_t WS_Y = 218 * MiB;
constexpr size_t WS_MRG = 266 * MiB;
constexpr size_t WS_ZC = 298 * MiB;
constexpr size_t WS_G = WS_ZC + 96 * MiB, WS_VT = WS_ZC + 192 * MiB;
constexpr size_t WS_SUM = 506 * MiB;
constexpr size_t WS_HS = 507 * MiB;
constexpr size_t WS_WGUS = WS_HS + 256 * 1024;
constexpr size_t WS_LIST = 298 * MiB;
constexpr size_t WS_WTS = 300 * MiB;
constexpr size_t WS_HB = 301 * MiB;
constexpr size_t WS_FFN = 369 * MiB;
constexpr size_t WS_END = 508 * MiB;
constexpr int CW_TMO = 0, CW_BAR = 4096, CW_CNT = 8192, CW_WS = 16384;

constexpr int RING_BYTES = 131072;
constexpr int LDSCTL_OFF = RING_BYTES, MISC_OFF = LDSCTL_OFF + 320, MOE_OFF = LDSCTL_OFF + 1024;
constexpr int LDS_BYTES = 147456;

#define GAS __attribute__((address_space(1)))
#define LAS __attribute__((address_space(3)))
typedef unsigned short bf16;
typedef unsigned v4u __attribute__((ext_vector_type(4)));
typedef unsigned v2u __attribute__((ext_vector_type(2)));
typedef float f32x4 __attribute__((ext_vector_type(4)));
typedef float f32x16 __attribute__((ext_vector_type(16)));
typedef short bf16x8 __attribute__((ext_vector_type(8)));
typedef GAS unsigned gu32;
#define RLX_AGENT __ATOMIC_RELAXED, __HIP_MEMORY_SCOPE_AGENT
#define LDS_WAIT() asm volatile("s_waitcnt lgkmcnt(0)" ::: "memory")
#define VM_WAIT() asm volatile("s_waitcnt vmcnt(0)" ::: "memory")
__device__ __forceinline__ unsigned f2bf(float f) { unsigned u = __builtin_bit_cast(unsigned, f); return (u + 0x7fffu + ((u >> 16) & 1u)) >> 16; }
__device__ __forceinline__ unsigned pk2(float lo, float hi) { return f2bf(lo) | (f2bf(hi) << 16); }
typedef float f32x2_t __attribute__((ext_vector_type(2))); typedef __bf16 bf16x2_t __attribute__((ext_vector_type(2)));
__device__ __forceinline__ unsigned cvtpk(float lo, float hi) { f32x2_t v = {lo, hi}; bf16x2_t b = __builtin_convertvector(v, bf16x2_t); return __builtin_bit_cast(unsigned, b); }
__device__ __forceinline__ float bflo(unsigned w) { return __builtin_bit_cast(float, w << 16); }
__device__ __forceinline__ float bfhi(unsigned w) { return __builtin_bit_cast(float, w & 0xffff0000u); }
__device__ __forceinline__ float bf1(bf16 b) { return __builtin_bit_cast(float, ((unsigned)b) << 16); }
__device__ __forceinline__ float fexp2(float x) { return __builtin_amdgcn_exp2f(x); }
__device__ __forceinline__ float flog2(float x) { return __builtin_amdgcn_logf(x); }
__device__ __forceinline__ float frcp(float x) { return __builtin_amdgcn_rcpf(x); }
__device__ __forceinline__ float sigmoidf_(float x) { return frcp(1.f + fexp2(-LOG2E * x)); }
#define DPP_ADD(v, ctrl) ((v) + __builtin_bit_cast(float, __builtin_amdgcn_update_dpp(0, __builtin_bit_cast(int, (v)), (ctrl), 0xF, 0xF, true)))
__device__ __forceinline__ float row16_sum(float v) { v = DPP_ADD(v, 0xB1); v = DPP_ADD(v, 0x4E); v = DPP_ADD(v, 0x141); v = DPP_ADD(v, 0x140); return v; }
#define DPP_MAX(v, ctrl) fmaxf((v), __builtin_bit_cast(float, __builtin_amdgcn_update_dpp(0, __builtin_bit_cast(int, (v)), (ctrl), 0xF, 0xF, true)))
__device__ __forceinline__ float wave_max(float v) {
    v = DPP_MAX(v, 0xB1); v = DPP_MAX(v, 0x4E); v = DPP_MAX(v, 0x141); v = DPP_MAX(v, 0x140); const int iv = __builtin_bit_cast(int, v);
    return fmaxf(fmaxf(__builtin_bit_cast(float, __builtin_amdgcn_readlane(iv, 0)), __builtin_bit_cast(float, __builtin_amdgcn_readlane(iv, 16))),
                 fmaxf(__builtin_bit_cast(float, __builtin_amdgcn_readlane(iv, 32)), __builtin_bit_cast(float, __builtin_amdgcn_readlane(iv, 48))));
}
__device__ __forceinline__ unsigned q4(float a, float b, float c, float d) { return ((unsigned)__float2int_rn(a) & 0xffu) | (((unsigned)__float2int_rn(b) & 0xffu) << 8) | (((unsigned)__float2int_rn(c) & 0xffu) << 16) | ((unsigned)__float2int_rn(d) << 24); }
__device__ __forceinline__ float wave_sum(float v) {
    v = row16_sum(v); const int iv = __builtin_bit_cast(int, v);
    const float a = __builtin_bit_cast(float, __builtin_amdgcn_readlane(iv, 0)), b = __builtin_bit_cast(float, __builtin_amdgcn_readlane(iv, 16)),
                c = __builtin_bit_cast(float, __builtin_amdgcn_readlane(iv, 32)), d = __builtin_bit_cast(float, __builtin_amdgcn_readlane(iv, 48));
    return (a + b) + (c + d);
}
__device__ __forceinline__ void unpack8(const v4u w, float* v) { v[0] = bflo(w.x); v[1] = bfhi(w.x); v[2] = bflo(w.y); v[3] = bfhi(w.y); v[4] = bflo(w.z); v[5] = bfhi(w.z); v[6] = bflo(w.w); v[7] = bfhi(w.w); }
__device__ __forceinline__ v4u pack8f(const float* v) { return (v4u){cvtpk(v[0], v[1]), cvtpk(v[2], v[3]), cvtpk(v[4], v[5]), cvtpk(v[6], v[7])}; }
__device__ __forceinline__ void ln16(float (&v)[16], const float* gam, const float* bet, int lane) {
    float s = 0.f;
#pragma unroll
    for (int j = 0; j < 16; ++j) s += v[j];
    const float mean = wave_sum(s) * (1.f / D); float s2 = 0.f;
#pragma unroll
    for (int j = 0; j < 16; ++j) { v[j] -= mean; s2 += v[j] * v[j]; }
    const float rstd = 1.f / sqrtf(wave_sum(s2) * (1.f / D) + LN_EPS);
#pragma unroll
    for (int h = 0; h < 2; ++h)
#pragma unroll
        for (int q = 0; q < 2; ++q) { const f32x4 g4 = *(const f32x4*)(gam + 512 * h + 8 * lane + 4 * q), b4 = *(const f32x4*)(bet + 512 * h + 8 * lane + 4 * q);
#pragma unroll
            for (int j = 0; j < 4; ++j) v[8 * h + 4 * q + j] = v[8 * h + 4 * q + j] * rstd * g4[j] + b4[j]; }
}

#define XB_TMO      128
#define XB_XCNT(j)  (256  + 64 * (j))
#define XB_XSUB(j)  (1280 + 64 * (j))
#define XB_XGEN(j)  (2304 + 64 * (j))
#define XB_TOP      3328
#define XB_TOPGEN   3392
#define XCD_BAR_WORDS 3456
#define XB_SPIN_CAP (1u << 18)

__device__ __forceinline__ unsigned xb_ld(unsigned* p)              { return __hip_atomic_load(p, __ATOMIC_RELAXED, __HIP_MEMORY_SCOPE_AGENT); }
__device__ __forceinline__ unsigned xb_add(unsigned* p, unsigned v) { return __hip_atomic_fetch_add(p, v, __ATOMIC_RELAXED, __HIP_MEMORY_SCOPE_AGENT); }
__device__ __forceinline__ unsigned xb_xcc_id() { return (unsigned)__builtin_amdgcn_s_getreg((3 << 11) | 20) & 0xFu; }
#define XB_SPIN(cond, bar) do { unsigned _sp = 0; while (cond) { __builtin_amdgcn_s_sleep(1); \
    if ((++_sp & 255u) == 0u) { if (xb_ld(&(bar)[XB_TMO])) break; if (_sp > XB_SPIN_CAP) { atomicAdd(&(bar)[XB_TMO], 1u); break; } } } } while (0)

struct XcdBarrier {
    unsigned* bar; unsigned x;
    volatile LAS unsigned* st;
};

__device__ __forceinline__ XcdBarrier xcd_barrier_post(unsigned* bar, volatile LAS unsigned* st) {
    XcdBarrier b; b.bar = bar; b.x = xb_xcc_id(); b.st = st;
    if (threadIdx.x == 0) (void)xb_add(&bar[XB_XCNT(b.x)], 1u);
    return b;
}
__device__ __forceinline__ void xcd_barrier_complete(unsigned* bar, unsigned x, unsigned& nloc, unsigned& nx) {
    const unsigned G = gridDim.x * gridDim.y * gridDim.z;
    unsigned sum, cnt, mine, sp = 0u;
    for (;;) {
        sum = 0u; cnt = 0u; mine = 0u;
#pragma unroll
        for (unsigned j = 0; j < 16; ++j) { const unsigned c = xb_ld(&bar[XB_XCNT(j)]); sum += c; cnt += (c > 0u) ? 1u : 0u; mine = (j == x) ? c : mine; }
        if (sum == G) break;
        __builtin_amdgcn_s_sleep(1);
        if ((++sp & 255u) == 0u) { if (xb_ld(&bar[XB_TMO])) break; if (sp > XB_SPIN_CAP) { atomicAdd(&bar[XB_TMO], 1u); break; } }
    }
    nloc = mine > 0u ? mine : 1u; nx = cnt > 0u ? cnt : 1u;
}

__device__ __forceinline__ void xcd_barrier(const XcdBarrier& b) {
    asm volatile("s_waitcnt vmcnt(0)" ::: "memory");
    __syncthreads();
    if (threadIdx.x == 0) {
        unsigned* bar = b.bar;
        __builtin_amdgcn_s_waitcnt(0);
        unsigned nloc = b.st[0], nx = b.st[1];
        if (nloc == 0u) { xcd_barrier_complete(bar, b.x, nloc, nx); b.st[0] = nloc; b.st[1] = nx; }
        const unsigned old = xb_add(&bar[XB_XSUB(b.x)], 1u);
        const unsigned gen = old / nloc;
        if (old + 1u == (gen + 1u) * nloc) {
            __builtin_amdgcn_fence(__ATOMIC_RELEASE, "agent");
            asm volatile("s_waitcnt vmcnt(0)" ::: "memory");
            const unsigned og = xb_add(&bar[XB_TOP], 1u);
            const unsigned tg = og / nx;
            if (og + 1u == (tg + 1u) * nx) xb_add(&bar[XB_TOPGEN], 1u);
            else XB_SPIN(xb_ld(&bar[XB_TOPGEN]) == tg, bar);
            __builtin_amdgcn_fence(__ATOMIC_ACQUIRE, "agent");
            xb_add(&bar[XB_XGEN(b.x)], 1u);
            asm volatile("s_waitcnt vmcnt(0)" ::: "memory");
        } else {
            XB_SPIN(xb_ld(&bar[XB_XGEN(b.x)]) == gen, bar);
            __builtin_amdgcn_fence(__ATOMIC_ACQUIRE, "agent");
            asm volatile("s_waitcnt vmcnt(0)" ::: "memory");
        }
    }
    __syncthreads();
}
using pg8::Unit;
struct NoHooks { __device__ __forceinline__ void a_ready(const Unit&) const {} __device__ __forceinline__ void done(const Unit&) const {} };

struct InprojSched : NoHooks {
    int G, c; const char* Hh; const char* Win;
    __device__ __forceinline__ bool next(int i, Unit& u) const {
        const int L = i * G + c; if (L >= 1792) return false;
        if (L < 1664) { pg8::tile_swz(L, 64, 26, u.pm, u.pn); u.ty = 0; u.A = Hh + (size_t)u.pm * 256 * 1024; u.B = Win + (size_t)u.pn * 256 * 1024; }
        else { const int j = L - 1664; u.pm = j & 1; u.pn = j >> 1; u.ty = 1; u.A = Win + (size_t)(NMAIN + 256 * u.pm) * 1024; u.B = Hh + (size_t)u.pn * 256 * 1024; }
        u.aux = 0; u.nv = 0; u.pad = 0; return true;
    }
};
struct EpiInproj {
    static constexpr bool PERM = true;
    bf16* ZC; bf16* G0; bf16* VT; const float* gate_b;
    const float* hs; const float* wsc;
    __device__ __forceinline__ void operator()(const pg8::f32x4 (&acc)[2][2][4][2], const Unit& u, int wr, int wc, int fr, int fq) const {
        int row0 = u.pm * 256 + wr * 64 + fr; asm volatile("" : "+v"(row0));
        const int cl = wc * 32 + 8 * fq;
        const float* rsp = (u.ty == 1) ? wsc + NMAIN : hs; const float* csp = (u.ty == 1) ? hs + u.pn * 256 : wsc + u.pn * 256;
        float rs[2][4]; pg8::f32x4 cs[2][2];
#pragma unroll
        for (int ai = 0; ai < 2; ++ai)
#pragma unroll
            for (int m = 0; m < 4; ++m) rs[ai][m] = rsp[row0 + ai * 128 + m * 16];
#pragma unroll
        for (int bj = 0; bj < 2; ++bj)
#pragma unroll
            for (int n = 0; n < 2; ++n) cs[bj][n] = *(const pg8::f32x4*)(csp + bj * 128 + cl + 4 * n);
#define ACCV(ai, bj, m, n) (__builtin_convertvector(__builtin_bit_cast(pg8::i32x4, acc[ai][bj][m][n]), pg8::f32x4) * (cs[bj][n] * rs[ai][m]))
        if (u.ty == 0 && u.pn >= 10 && u.pn < 14) {
            bf16* base = ZC + (size_t)5 * HTOK * 512; const int col0 = (u.pn - 10) * 128 + cl;
#pragma unroll
            for (int ai = 0; ai < 2; ++ai)
#pragma unroll
                for (int m = 0; m < 4; ++m) { const pg8::f32x4 v0 = ACCV(ai, 0, m, 0) * ACCV(ai, 1, m, 0), v1 = ACCV(ai, 0, m, 1) * ACCV(ai, 1, m, 1);
                    v4u w; w.x = cvtpk(v0[0], v0[1]); w.y = cvtpk(v0[2], v0[3]); w.z = cvtpk(v1[0], v1[1]); w.w = cvtpk(v1[2], v1[3]);
                    *(v4u*)(base + (size_t)(row0 + ai * 128 + m * 16) * 512 + col0) = w; }
            return;
        }
        if (u.ty == 0 && u.pn >= 14) {
            const int b = (u.pn - 14) >> 2, col0 = ((u.pn - 14) & 3) * 256 + cl; bf16* base = G0 + (size_t)b * HTOK * 1024; const float* gb = gate_b + b * 1024 + col0;
            pg8::f32x4 bv[2][2];
#pragma unroll
            for (int bj = 0; bj < 2; ++bj)
#pragma unroll
                for (int n = 0; n < 2; ++n) bv[bj][n] = *(const pg8::f32x4*)(gb + bj * 128 + 4 * n);
#pragma unroll
            for (int ai = 0; ai < 2; ++ai)
#pragma unroll
                for (int m = 0; m < 4; ++m) { bf16* rowp = base + (size_t)(row0 + ai * 128 + m * 16) * 1024 + col0;
#pragma unroll
                    for (int bj = 0; bj < 2; ++bj) { pg8::f32x4 v0 = ACCV(ai, bj, m, 0) + bv[bj][0], v1 = ACCV(ai, bj, m, 1) + bv[bj][1];
#pragma unroll
                        for (int j = 0; j < 4; ++j) { v0[j] = sigmoidf_(v0[j]); v1[j] = sigmoidf_(v1[j]); }
                        v4u w; w.x = cvtpk(v0[0], v0[1]); w.y = cvtpk(v0[2], v0[3]); w.z = cvtpk(v1[0], v1[1]); w.w = cvtpk(v1[2], v1[3]);
                        *(v4u*)(rowp + bj * 128) = w; } }
            return;
        }
        float sc = 1.f; const int t = u.pn >> 1;
        if (u.ty == 0 && t == 0) sc = C2;
#pragma unroll
        for (int ai = 0; ai < 2; ++ai)
#pragma unroll
            for (int m = 0; m < 4; ++m) { const int row = row0 + ai * 128 + m * 16;
#pragma unroll
                for (int bj = 0; bj < 2; ++bj) { const pg8::f32x4 v0 = ACCV(ai, bj, m, 0) * sc, v1 = ACCV(ai, bj, m, 1) * sc;
                    v4u w; w.x = cvtpk(v0[0], v0[1]); w.y = cvtpk(v0[2], v0[3]); w.z = cvtpk(v1[0], v1[1]); w.w = cvtpk(v1[2], v1[3]);
                    bf16* p;
                    if (u.ty == 1) { const int tok = u.pn * 256 + bj * 128 + cl; p = VT + ((size_t)(row >> 6) * 256 + (tok >> 6)) * 4096 + (row & 63) * 64 + (tok & 63); }
                    else { const int col = (u.pn & 1) * 256 + bj * 128 + cl;
                        if (t == 1) p = ZC + (size_t)HTOK * 512 + ((size_t)(col >> 6) * HTOK + row) * 64 + (col & 63);
                        else p = ZC + (size_t)t * HTOK * 512 + (size_t)row * 512 + col; }
                    *(v4u*)p = w; } }
#undef ACCV
    }
};

struct BranchSched : NoHooks {
    int G, c; const char* Y; const char* WBR;
    __device__ __forceinline__ bool next(int i, Unit& u) const {
        const int tile = (i / 3) * G + c, b = i % 3; if (tile >= 256) return false;
        pg8::tile_swz(tile, 64, 4, u.pm, u.pn); u.ty = b; u.aux = 0; u.nv = 0; u.pad = 0;
        u.A = Y + ((size_t)u.pm * 256 * 1536 + b * 512) * 2; u.B = WBR + ((size_t)u.pn * 256 * 1536 + b * 512) * 2; return true;
    }
};
struct EpiBranch {
    static constexpr bool PERM = true;
    const bf16* G0; bf16* MRG;
    __device__ __forceinline__ void operator()(const pg8::f32x4 (&acc)[2][2][4][2], const Unit& u, int wr, int wc, int fr, int fq) const {
        int row0 = u.pm * 256 + wr * 64 + fr; asm volatile("" : "+v"(row0)); const int col0 = u.pn * 256 + wc * 32 + 8 * fq; const bf16* gp = G0 + (size_t)u.ty * HTOK * 1024;
#pragma unroll
        for (int ai = 0; ai < 2; ++ai)
#pragma unroll
            for (int m = 0; m < 4; ++m) { const size_t off = (size_t)(row0 + ai * 128 + m * 16) * 1024 + col0;
#pragma unroll
                for (int bj = 0; bj < 2; ++bj) { const v4u gw = *(const v4u*)(gp + off + bj * 128); v4u ow = (v4u){0u, 0u, 0u, 0u}; if (u.ty != 0) ow = *(const v4u*)(MRG + off + bj * 128);
                    const pg8::f32x4 a0 = acc[ai][bj][m][0], a1 = acc[ai][bj][m][1]; v4u w;
                    w.x = cvtpk(bflo(ow.x) + bflo(gw.x) * a0[0], bfhi(ow.x) + bfhi(gw.x) * a0[1]); w.y = cvtpk(bflo(ow.y) + bflo(gw.y) * a0[2], bfhi(ow.y) + bfhi(gw.y) * a0[3]);
                    w.z = cvtpk(bflo(ow.z) + bflo(gw.z) * a1[0], bfhi(ow.z) + bfhi(gw.z) * a1[1]); w.w = cvtpk(bflo(ow.w) + bflo(gw.w) * a1[2], bfhi(ow.w) + bfhi(gw.w) * a1[3]);
                    *(v4u*)(MRG + off + bj * 128) = w; }
                if (m & 1) asm volatile("" ::: "memory"); }
    }
};

struct PlainSched : NoHooks {
    int G, c, nM, nN; const char* A; const char* B; size_t astep, bstep;
    __device__ __forceinline__ bool next(int i, Unit& u) const {
        const int L = i * G + c; if (L >= nM * nN) return false;
        pg8::tile_swz(L, nM, nN, u.pm, u.pn); u.ty = 0; u.aux = 0; u.nv = 0; u.pad = 0; u.A = A + (size_t)u.pm * astep; u.B = B + (size_t)u.pn * bstep; return true;
    }
};
struct EpiOutproj {
    static constexpr bool PERM = true;
    bf16* Hh;
    __device__ __forceinline__ void operator()(const pg8::f32x4 (&acc)[2][2][4][2], const Unit& u, int wr, int wc, int fr, int fq) const {
        int row0 = u.pm * 256 + wr * 64 + fr; asm volatile("" : "+v"(row0)); const int col0 = u.pn * 256 + wc * 32 + 8 * fq;
#pragma unroll
        for (int ai = 0; ai < 2; ++ai)
#pragma unroll
            for (int m = 0; m < 4; ++m) { bf16* rowp = Hh + (size_t)(row0 + ai * 128 + m * 16) * 1024 + col0;
#pragma unroll
                for (int bj = 0; bj < 2; ++bj) { const v4u ow = *(const v4u*)(rowp + bj * 128); const pg8::f32x4 a0 = acc[ai][bj][m][0], a1 = acc[ai][bj][m][1]; v4u w;
                    w.x = cvtpk(ALPHA * bflo(ow.x) + a0[0], ALPHA * bfhi(ow.x) + a0[1]); w.y = cvtpk(ALPHA * bflo(ow.y) + a0[2], ALPHA * bfhi(ow.y) + a0[3]);
                    w.z = cvtpk(ALPHA * bflo(ow.z) + a1[0], ALPHA * bfhi(ow.z) + a1[1]); w.w = cvtpk(ALPHA * bflo(ow.w) + a1[2], ALPHA * bfhi(ow.w) + a1[3]);
                    *(v4u*)(rowp + bj * 128) = w; }
                if (m == 3) asm volatile("" ::: "memory"); }
    }
};

struct MoeSched : NoHooks {
    int G, c; const LAS int* tab; const char* Abase; size_t atile; const char* Wbase; size_t wstride, bstep; const unsigned* list;
    __device__ __forceinline__ bool next(int i, Unit& u) const {
        const int L = i * G + c, NT = tab[16]; if (L >= NT * 4) return false;
        const int rt = L >> 2; int e = 0;
#pragma unroll 1
        while (e < 15 && rt >= tab[e + 1]) ++e;
        const int j = rt - tab[e];
        u.pm = rt; u.pn = L & 3; u.ty = e; u.aux = e * LISTCAP + j * 256; u.nv = tab[17 + e] - j * 256; u.pad = 0;
        u.A = Abase + (size_t)rt * atile; u.B = Wbase + (size_t)e * wstride + (size_t)u.pn * bstep; return true;
    }
    __device__ __forceinline__ int arow(const Unit& u, int r) const { return r < u.nv ? (int)(list[u.aux + r] >> 1) : 0; }
};
struct EpiGateUp {
    static constexpr bool PERM = true;
    bf16* HB; const unsigned* list; const float* hs; const float* wsc;
    __device__ __forceinline__ void operator()(const pg8::f32x4 (&acc)[2][2][4][2], const Unit& u, int wr, int wc, int fr, int fq) const {
        int row0 = u.pm * 256 + wr * 64 + fr; asm volatile("" : "+v"(row0)); const int col0 = u.pn * 128 + wc * 32 + 8 * fq, r0 = wr * 64 + fr;
        const float* csp = wsc + u.ty * 1024 + u.pn * 256 + wc * 32 + 8 * fq;
        pg8::f32x4 cs[2][2];
#pragma unroll
        for (int bj = 0; bj < 2; ++bj)
#pragma unroll
            for (int n = 0; n < 2; ++n) cs[bj][n] = *(const pg8::f32x4*)(csp + bj * 128 + 4 * n);
#pragma unroll
        for (int ai = 0; ai < 2; ++ai)
#pragma unroll
            for (int m = 0; m < 4; ++m) { const int r = r0 + ai * 128 + m * 16; const float rs = hs[r < u.nv ? (list[u.aux + r] >> 1) : 0u]; pg8::f32x4 v0, v1;
                const pg8::f32x4 g0 = __builtin_convertvector(__builtin_bit_cast(pg8::i32x4, acc[ai][0][m][0]), pg8::f32x4) * (cs[0][0] * rs), g1 = __builtin_convertvector(__builtin_bit_cast(pg8::i32x4, acc[ai][0][m][1]), pg8::f32x4) * (cs[0][1] * rs);
                const pg8::f32x4 u0 = __builtin_convertvector(__builtin_bit_cast(pg8::i32x4, acc[ai][1][m][0]), pg8::f32x4) * (cs[1][0] * rs), u1 = __builtin_convertvector(__builtin_bit_cast(pg8::i32x4, acc[ai][1][m][1]), pg8::f32x4) * (cs[1][1] * rs);
#pragma unroll
                for (int j = 0; j < 4; ++j) { v0[j] = g0[j] * sigmoidf_(g0[j]) * u0[j]; v1[j] = g1[j] * sigmoidf_(g1[j]) * u1[j]; }
                v4u w; w.x = cvtpk(v0[0], v0[1]); w.y = cvtpk(v0[2], v0[3]); w.z = cvtpk(v1[0], v1[1]); w.w = cvtpk(v1[2], v1[3]);
                *(v4u*)(HB + (size_t)(row0 + ai * 128 + m * 16) * 512 + col0) = w; }
    }
};
struct EpiDown {
    static constexpr bool PERM = true;
    bf16* FFN; const unsigned* list;
    __device__ __forceinline__ void operator()(const pg8::f32x4 (&acc)[2][2][4][2], const Unit& u, int wr, int wc, int fr, int fq) const {
        int r0 = wr * 64 + fr; asm volatile("" : "+v"(r0)); const int col0 = u.pn * 256 + wc * 32 + 8 * fq;
#pragma unroll
        for (int ai = 0; ai < 2; ++ai)
#pragma unroll
            for (int m = 0; m < 4; ++m) { const int r = r0 + ai * 128 + m * 16;
                if (r < u.nv) { const unsigned ent = list[u.aux + r]; bf16* rowp = FFN + ((size_t)(ent & 1u) * NTOK + (ent >> 1)) * 1024 + col0;
#pragma unroll
                    for (int bj = 0; bj < 2; ++bj) { const pg8::f32x4 v0 = acc[ai][bj][m][0], v1 = acc[ai][bj][m][1];
                        v4u w; w.x = cvtpk(v0[0], v0[1]); w.y = cvtpk(v0[2], v0[3]); w.z = cvtpk(v1[0], v1[1]); w.w = cvtpk(v1[2], v1[3]);
                        *(v4u*)(rowp + bj * 128) = w; } } }
    }
};

__device__ __forceinline__ void tr_item(const float* W, int N, int k0, int n0, bf16* dst, size_t drow0, int dpitch, int dk0, LAS float* scr, int lane) {
#pragma unroll 8
    for (int i = 0; i < 32; ++i) { const int kk = 2 * i + (lane >> 5); scr[kk * 33 + (lane & 31)] = W[(size_t)(k0 + kk) * N + n0 + (lane & 31)]; }
    LDS_WAIT(); asm volatile("" ::: "memory");
    const int c = lane & 7;
#pragma unroll
    for (int j = 0; j < 4; ++j) { const int n = (lane >> 3) + 8 * j; const LAS float* s = scr + (8 * c) * 33 + n;
        v4u o; o.x = pk2(s[0 * 33], s[1 * 33]); o.y = pk2(s[2 * 33], s[3 * 33]); o.z = pk2(s[4 * 33], s[5 * 33]); o.w = pk2(s[6 * 33], s[7 * 33]);
        *(v4u*)(dst + (drow0 + n) * (size_t)dpitch + dk0 + k0 + 8 * c) = o; }
    LDS_WAIT(); asm volatile("" ::: "memory");
}
__device__ __forceinline__ int map_in(int n0) {
    if (n0 < 1024) return n0;
    if (n0 < 1536) return NMAIN + (n0 - 1024);
    if (n0 < 3072) return n0 - 512;
    if (n0 < 3584) { const int c = n0 - 3072; return 2560 + (c >> 7) * 256 + (c & 127); }
    if (n0 < 4096) { const int c = n0 - 3584; return 2560 + (c >> 7) * 256 + 128 + (c & 127); }
    return n0 - 512;
}
struct Args { const float* in[28]; float* out; unsigned char* ws; };
typedef const __attribute__((address_space(4))) unsigned long long* KP;
struct KA { KP kp;
    __device__ __forceinline__ const float* in(int k) const { return (const float*)(const GAS float*)kp[k]; }
    __device__ __forceinline__ float* out() const { return (float*)(GAS float*)kp[28]; }
    __device__ __forceinline__ unsigned char* ws() const { return (unsigned char*)(GAS unsigned char*)kp[29]; } };

__device__ __forceinline__ void win_item_wg(const float* W, int N, int n0, signed char* dst, float* scale_out, size_t drow0, LAS unsigned char* lds, int tid) {
    LAS float* T = (LAS float*)lds;
    LAS float* MX = (LAS float*)(lds + LDSCTL_OFF + 4096);
    { const float* wp = W + (size_t)(tid >> 3) * N + n0 + 4 * (tid & 7); f32x4 v[16];
#pragma unroll
      for (int i = 0; i < 16; ++i) v[i] = *(const f32x4*)(wp + (size_t)(64 * i) * N);
#pragma unroll
      for (int i = 0; i < 16; ++i) *(LAS f32x4*)(T + ((tid >> 3) + 64 * i) * 32 + 4 * (tid & 7)) = v[i]; }
    __syncthreads();
    const int c = tid & 31, s = tid >> 5;
    { float m = 0.f;
#pragma unroll 16
      for (int k = 0; k < 64; ++k) m = fmaxf(m, fabsf(T[(s * 64 + k) * 32 + c]));
      MX[s * 32 + c] = m; }
    __syncthreads();
    float m = 1e-30f;
#pragma unroll
    for (int w = 0; w < 16; ++w) m = fmaxf(m, MX[w * 32 + c]);
    const float inv = 127.f / m;
    if (tid < 32) scale_out[drow0 + c] = m * (1.f / 127.f);
#pragma unroll
    for (int j = 0; j < 4; ++j) { const int p = s + 16 * j; const LAS float* tp = T + (16 * p) * 32 + c; unsigned w[4];
#pragma unroll
        for (int q = 0; q < 4; ++q) w[q] = q4(tp[(4 * q) * 32] * inv, tp[(4 * q + 1) * 32] * inv, tp[(4 * q + 2) * 32] * inv, tp[(4 * q + 3) * 32] * inv);
        *(v4u*)(dst + (drow0 + c) * (size_t)1024 + 16 * p) = (v4u){w[0], w[1], w[2], w[3]}; }
    __syncthreads();
}
__device__ __forceinline__ void quant_row16(const float (&v)[16], signed char* qrow, float* srow, int c0a, int c0b, int lane) {
    float m = 0.f;
#pragma unroll
    for (int j = 0; j < 16; ++j) m = fmaxf(m, fabsf(v[j]));
    m = fmaxf(wave_max(m), 1e-30f); const float inv = 127.f / m;
    *(v2u*)(qrow + c0a) = (v2u){q4(v[0] * inv, v[1] * inv, v[2] * inv, v[3] * inv), q4(v[4] * inv, v[5] * inv, v[6] * inv, v[7] * inv)};
    *(v2u*)(qrow + c0b) = (v2u){q4(v[8] * inv, v[9] * inv, v[10] * inv, v[11] * inv), q4(v[12] * inv, v[13] * inv, v[14] * inv, v[15] * inv)};
    if (lane == 0) *srow = m * (1.f / 127.f);
}
__device__ __forceinline__ void p0_prologue(const KA& a, LAS unsigned char* lds, int gw, int NGW, int wave, int lane) {
    LAS float* scr = (LAS float*)(lds + wave * 16384);
    unsigned char* ws = a.ws();
    for (int it = blockIdx.x; it < DEPTH * 224; it += gridDim.x) { const int l = it / 224, r = it % 224;
        win_item_wg(a.in(3) + (size_t)l * 1024 * PROJ, PROJ, 32 * r, (signed char*)(ws + WS_WIN) + (size_t)l * PROJ * 1024, (float*)(ws + WS_CTL) + CW_WS + l * PROJ, (size_t)map_in(32 * r), lds, threadIdx.x); }
    for (int it = blockIdx.x; it < DEPTH * NEXP * 2 * 16; it += gridDim.x) { const int le = it >> 5, up = (it >> 4) & 1, n0 = (it & 15) * 32;
        win_item_wg(a.in(23 + up) + (size_t)le * 1024 * 512, 512, n0, (signed char*)(ws + WS_WGU) + (size_t)le * 1024 * 1024, (float*)(ws + WS_WGUS) + (size_t)le * 1024, (size_t)((n0 >> 7) * 256 + up * 128 + (n0 & 127)), lds, threadIdx.x); }
    constexpr int I_IN = 0, I_BR = 8 * 32, I_OUT = 16 * 32, I_G = 16 * 16, I_DN = 8 * 32;
    constexpr int PER_LAYER = I_IN + 3 * I_BR + I_OUT + 16 * I_DN + 32;
    for (int it = gw; it < DEPTH * PER_LAYER; it += NGW) {
        const int l = it / PER_LAYER; int r = it % PER_LAYER;
        if (r < 3 * I_BR) { const int b = r / I_BR, q = r % I_BR, kb = q / 32, nb = q % 32; tr_item(a.in(13 + b) + (size_t)l * 512 * 1024, 1024, 64 * kb, 32 * nb, (bf16*)(ws + WS_WBR) + (size_t)l * 1024 * 1536, (size_t)(32 * nb), 1536, b * 512, scr, lane); continue; } r -= 3 * I_BR;
        if (r < I_OUT) { const int kb = r / 32, nb = r % 32; tr_item(a.in(16) + (size_t)l * 1024 * 1024, 1024, 64 * kb, 32 * nb, (bf16*)(ws + WS_WOUT) + (size_t)l * 1024 * 1024, (size_t)(32 * nb), 1024, 0, scr, lane); continue; } r -= I_OUT;
        if (r < 16 * I_DN) { const int e = r / I_DN, q = r % I_DN, kb = q / 32, nb = q % 32; tr_item(a.in(25) + ((size_t)l * NEXP + e) * 512 * 1024, 1024, 64 * kb, 32 * nb, (bf16*)(ws + WS_WDN) + ((size_t)l * NEXP + e) * 1024 * 512, (size_t)(32 * nb), 512, 0, scr, lane);
            continue; } r -= 16 * I_DN;
        { const int gsel = r / 16, hd = (r % 16) / 2, nb = r % 2;
          tr_item(a.in(gsel ? 9 : 7) + ((size_t)l * 8 + hd) * 4096, 64, 0, 32 * nb, (bf16*)(ws + WS_LRUW) + (((size_t)l * 2 + gsel) * 8 + hd) * 4096, (size_t)(32 * nb), 64, 0, scr, lane); }
    }
    const float* gam = a.in(1); const float* bet = a.in(2); bf16* H = (bf16*)(ws + WS_H); signed char* HQ = (signed char*)(ws + WS_HQ); float* HS = (float*)(ws + WS_HS);
    for (int m = gw; m < NTOK; m += NGW) {
        const float* xr = a.in(0) + (size_t)m * D; float v[16];
#pragma unroll
        for (int h = 0; h < 2; ++h) { const f32x4 x0 = *(const f32x4*)(xr + 512 * h + 8 * lane), x1 = *(const f32x4*)(xr + 512 * h + 8 * lane + 4);
            v[8 * h] = x0.x; v[8 * h + 1] = x0.y; v[8 * h + 2] = x0.z; v[8 * h + 3] = x0.w; v[8 * h + 4] = x1.x; v[8 * h + 5] = x1.y; v[8 * h + 6] = x1.z; v[8 * h + 7] = x1.w; }
        ln16(v, gam, bet, lane);
        bf16* hp = H + (size_t)m * D; *(v4u*)(hp + 8 * lane) = pack8f(v); *(v4u*)(hp + 512 + 8 * lane) = pack8f(v + 8);
        quant_row16(v, HQ + (size_t)m * D, HS + m, 8 * lane, 512 + 8 * lane, lane);
    }
}

#define MFMA32(a, b, c) __builtin_amdgcn_mfma_f32_32x32x16_bf16((a), (b), (c), 0, 0, 0)
__device__ __forceinline__ int crow(int r, int hi) { return (r & 3) + 8 * (r >> 2) + 4 * hi; }
__device__ __forceinline__ bf16x8 pack8(const f32x16& x, int s) {
    v4u p; p.x = cvtpk(x[8 * s], x[8 * s + 1]); p.y = cvtpk(x[8 * s + 2], x[8 * s + 3]); p.z = cvtpk(x[8 * s + 4], x[8 * s + 5]); p.w = cvtpk(x[8 * s + 6], x[8 * s + 7]);
    return __builtin_bit_cast(bf16x8, p);
}
__device__ __forceinline__ float softplus2(float z) { return fmaxf(z, 0.f) + flog2(1.f + fexp2(-fabsf(z))); }

template <bool DIAG>
__device__ __forceinline__ bool sb_tile(const LAS unsigned char* kt_lds, const bf16x8 (&qf)[4], const bf16x8 (&tri)[2], bf16x8 mones,
                                        f32x16& o0, f32x16& o1, float& carry, int k0, int t0, int l32, int hi) {
    const int x = l32 & 7; const LAS unsigned char* krow = kt_lds + l32 * 128; const LAS unsigned char* vrow = kt_lds + 8192 + l32 * 128 + 8 * hi;
    f32x16 s0, s1;
#pragma unroll
    for (int r = 0; r < 16; ++r) { s0[r] = 0.f; s1[r] = 0.f; }
#pragma unroll
    for (int i = 0; i < 4; ++i) { const int po = ((2 * i + hi) ^ x) * 16;
        const bf16x8 ka = *(const LAS bf16x8*)(krow + po), kb = *(const LAS bf16x8*)(krow + 32 * 128 + po);
        s0 = MFMA32(ka, qf[i], s0); s1 = MFMA32(kb, qf[i], s1); }
    const float z00 = s0[0];
    v4u L[4];
#pragma unroll
    for (int f = 0; f < 2; ++f)
#pragma unroll
        for (int i = 0; i < 4; ++i) { const int r = 8 * f + 2 * i;
            float a0 = softplus2(s0[r]), a1 = softplus2(s0[r + 1]), b0 = softplus2(s1[r]), b1 = softplus2(s1[r + 1]);
            if (DIAG) { const int q = t0 + l32, ka = k0 + crow(r, hi), kb = k0 + crow(r + 1, hi); if (ka >= q) a0 = 0.f; if (kb >= q) a1 = 0.f; if (ka + 32 >= q) b0 = 0.f; if (kb + 32 >= q) b1 = 0.f; }
            L[f][i] = cvtpk(a0, a1); L[2 + f][i] = cvtpk(b0, b1); }
#pragma unroll
    for (int r = 0; r < 16; ++r) { s0[r] -= carry; s1[r] -= carry; }
    s0 = MFMA32(tri[0], __builtin_bit_cast(bf16x8, L[0]), s0); s0 = MFMA32(tri[1], __builtin_bit_cast(bf16x8, L[1]), s0); s0 = MFMA32(mones, __builtin_bit_cast(bf16x8, L[2]), s0); s0 = MFMA32(mones, __builtin_bit_cast(bf16x8, L[3]), s0);
    s1 = MFMA32(tri[0], __builtin_bit_cast(bf16x8, L[2]), s1); s1 = MFMA32(tri[1], __builtin_bit_cast(bf16x8, L[3]), s1);
    float tot = (z00 - carry) - s0[0];
    tot = __shfl(tot, l32);
    v4u P[4];
#pragma unroll
    for (int f = 0; f < 2; ++f)
#pragma unroll
        for (int i = 0; i < 4; ++i) { const int r = 8 * f + 2 * i;
            float a0 = fexp2(s0[r]), a1 = fexp2(s0[r + 1]), b0 = fexp2(s1[r]), b1 = fexp2(s1[r + 1]);
            if (DIAG) { const int q = t0 + l32, ka = k0 + crow(r, hi), kb = k0 + crow(r + 1, hi); if (ka >= q) a0 = 0.f; if (kb >= q) a1 = 0.f; if (ka + 32 >= q) b0 = 0.f; if (kb + 32 >= q) b1 = 0.f; }
            P[f][i] = cvtpk(a0, a1); P[2 + f][i] = cvtpk(b0, b1); }
    carry += tot;
#pragma unroll
    for (int db = 0; db < 2; ++db) {
        f32x16 o = db ? o1 : o0;
#pragma unroll
        for (int s = 0; s < 4; ++s) { const v2u lo = *(const LAS v2u*)(vrow + db * 32 * 128 + (((2 * s) ^ x) * 16)), hi8 = *(const LAS v2u*)(vrow + db * 32 * 128 + (((2 * s + 1) ^ x) * 16));
            o = MFMA32(__builtin_bit_cast(bf16x8, (v4u){lo.x, lo.y, hi8.x, hi8.y}), __builtin_bit_cast(bf16x8, P[s]), o); }
        if (db) o1 = o; else o0 = o;
    }
    return __all(carry > 150.f) != 0;
}
__device__ __forceinline__ void sb_attn_wg(const bf16* __restrict__ Q, const bf16* __restrict__ Kh, const bf16* __restrict__ VT, bf16* Y, LAS unsigned char* lds, int b, int hd, int qg, int wave, int lane) {
    const int l32 = lane & 31, hi = lane >> 5, seq0 = b * SEQ, T0 = qg * 256, t0 = T0 + 32 * wave, ktd = t0 >> 6, B = T0 >> 6;
    LAS int* FL = (LAS int*)(lds + LDSCTL_OFF + 2048);
    const int koff = (wave * 8 + (lane >> 3)) * 64 + (((lane & 7) ^ ((lane >> 3) & 7)) * 8);
    const bf16* ksrc = Kh + ((size_t)hd * HTOK + seq0) * 64 + koff; const bf16* vsrc = VT + ((size_t)hd * 256 + (seq0 >> 6)) * 4096 + koff;
#define SB_STAGE(kt) do { const unsigned so_ = (unsigned)(((kt) & 7) * 16384 + wave * 1024); \
        __builtin_amdgcn_global_load_lds((const unsigned*)(ksrc + (size_t)(kt) * 4096), (LAS unsigned*)(lds + so_), 16, 0, 0); \
        __builtin_amdgcn_global_load_lds((const unsigned*)(vsrc + (size_t)(kt) * 4096), (LAS unsigned*)(lds + so_ + 8192), 16, 0, 0); } while (0)
#pragma unroll
    for (int i = 0; i < 4; ++i) SB_STAGE(B + i);
    bf16x8 qf[4];
    { const bf16* qp = Q + (size_t)(seq0 + t0 + l32) * 512 + hd * 64 + 8 * hi;
#pragma unroll
      for (int i = 0; i < 4; ++i) qf[i] = *(const bf16x8*)(qp + 16 * i); }
    bf16x8 tri[2], mones;
#pragma unroll
    for (int i2 = 0; i2 < 2; ++i2)
#pragma unroll
        for (int j = 0; j < 8; ++j) { const int ko = 16 * i2 + 8 * (j >> 2) + 4 * hi + (j & 3); tri[i2][j] = (ko >= l32) ? (short)0xBF80 : (short)0; }
#pragma unroll
    for (int j = 0; j < 8; ++j) mones[j] = (short)0xBF80;
    f32x16 o0, o1;
#pragma unroll
    for (int r = 0; r < 16; ++r) { o0[r] = 0.f; o1[r] = 0.f; }
    float carry = 0.f; bool done = false;
    if (lane == 0) FL[wave] = 0;
#pragma unroll 1
    for (int j = 0; ; ++j) {
        asm volatile("s_waitcnt vmcnt(0)" ::: "memory");
        __syncthreads();
        const pg8::u32x4 f0 = *(const LAS pg8::u32x4*)(FL + (j & 1) * 8), f1 = *(const LAS pg8::u32x4*)(FL + (j & 1) * 8 + 4);
        if ((f0.x & f0.y & f0.z & f0.w & f1.x & f1.y & f1.z & f1.w) != 0u) break;
        if (B - j - 1 >= 0) SB_STAGE(B - j - 1);
        const int kt = ktd - j;
        if (!done) {
            if (kt < 0) done = true;
            else { const LAS unsigned char* tl = lds + (kt & 7) * 16384;
                if (j == 0) done = sb_tile<true>(tl, qf, tri, mones, o0, o1, carry, kt * 64, t0, l32, hi);
                else done = sb_tile<false>(tl, qf, tri, mones, o0, o1, carry, kt * 64, t0, l32, hi);
                if (kt == 0) done = true; }
        }
        if (lane == 0) FL[((j + 1) & 1) * 8 + wave] = done ? 1 : 0;
    }
#undef SB_STAGE
    bf16* yp = Y + (size_t)(seq0 + t0 + l32) * 1536 + hd * 64 + 4 * hi;
#pragma unroll
    for (int g = 0; g < 4; ++g) {
        *(v2u*)(yp + 8 * g) = (v2u){cvtpk(o0[4 * g], o0[4 * g + 1]), cvtpk(o0[4 * g + 2], o0[4 * g + 3])};
        *(v2u*)(yp + 32 + 8 * g) = (v2u){cvtpk(o1[4 * g], o1[4 * g + 1]), cvtpk(o1[4 * g + 2], o1[4 * g + 3])};
    }
    __syncthreads();
}

__device__ __forceinline__ void lru_local_task(const KA& a, int l, const bf16* __restrict__ LI, bf16* HLOC, bf16* CUMA, float* SUMA, float* SUMH, const bf16* __restrict__ LW,
                                               LAS bf16* U, int b, int ch, int hd, int lane) {
    const int seq0 = b * SEQ, t0 = ch * 64;
    { const int co = lane & 7, sub = lane >> 3, c0 = hd * 64 + co * 8;
      const float* cw = a.in(5) + (size_t)l * 4 * 512 + c0; const float* cb = a.in(6) + (size_t)l * 512 + c0;
      float w[4][8], bias[8];
#pragma unroll
      for (int k = 0; k < 4; ++k) { const f32x4 x0 = *(const f32x4*)(cw + k * 512), x1 = *(const f32x4*)(cw + k * 512 + 4);
          w[k][0] = x0.x; w[k][1] = x0.y; w[k][2] = x0.z; w[k][3] = x0.w; w[k][4] = x1.x; w[k][5] = x1.y; w[k][6] = x1.z; w[k][7] = x1.w; }
      { const f32x4 x0 = *(const f32x4*)(cb), x1 = *(const f32x4*)(cb + 4); bias[0] = x0.x; bias[1] = x0.y; bias[2] = x0.z; bias[3] = x0.w; bias[4] = x1.x; bias[5] = x1.y; bias[6] = x1.z; bias[7] = x1.w; }
#pragma unroll 2
      for (int it = 0; it < 8; ++it) { const int tl = it * 8 + sub, t = t0 + tl; float u[8];
#pragma unroll
          for (int j = 0; j < 8; ++j) u[j] = bias[j];
#pragma unroll
          for (int k = 0; k < 4; ++k) { const int tt = t - 3 + k; if (tt >= 0) { const v4u x = *(const v4u*)(LI + (size_t)(seq0 + tt) * 512 + c0);
              u[0] += w[k][0] * bflo(x.x); u[1] += w[k][1] * bfhi(x.x); u[2] += w[k][2] * bflo(x.y); u[3] += w[k][3] * bfhi(x.y);
              u[4] += w[k][4] * bflo(x.z); u[5] += w[k][5] * bfhi(x.z); u[6] += w[k][6] * bflo(x.w); u[7] += w[k][7] * bfhi(x.w); } }
          *(LAS v4u*)(U + tl * 72 + co * 8) = (v4u){pk2(u[0], u[1]), pk2(u[2], u[3]), pk2(u[4], u[5]), pk2(u[6], u[7])}; }
      LDS_WAIT(); asm volatile("" ::: "memory"); }
    const int l32 = lane & 31, hi = lane >> 5;
    bf16x8 af[2][4];
#pragma unroll
    for (int mb = 0; mb < 2; ++mb)
#pragma unroll
        for (int ks = 0; ks < 4; ++ks) af[mb][ks] = *(const LAS bf16x8*)(U + (mb * 32 + l32) * 72 + 16 * ks + 8 * hi);
    float Hrun = 0.f, Arun = 1.f;
#pragma unroll 1
    for (int nb = 0; nb < 2; ++nb) {
        const int chn = hd * 64 + nb * 32 + l32;
        const bf16* wa = LW + ((size_t)(l * 2 + 0) * 8 + hd) * 4096 + (nb * 32 + l32) * 64 + 8 * hi;
        const bf16* wx = LW + ((size_t)(l * 2 + 1) * 8 + hd) * 4096 + (nb * 32 + l32) * 64 + 8 * hi;
        f32x16 da[2], dx[2];
#pragma unroll
        for (int mb = 0; mb < 2; ++mb)
#pragma unroll
            for (int r = 0; r < 16; ++r) { da[mb][r] = 0.f; dx[mb][r] = 0.f; }
#pragma unroll
        for (int ks = 0; ks < 4; ++ks) { const bf16x8 ba = *(const bf16x8*)(wa + 16 * ks), bx = *(const bf16x8*)(wx + 16 * ks);
#pragma unroll
            for (int mb = 0; mb < 2; ++mb) { da[mb] = MFMA32(af[mb][ks], ba, da[mb]); dx[mb] = MFMA32(af[mb][ks], bx, dx[mb]); } }
        const float b_a = a.in(8)[l * 512 + chn], b_x = a.in(10)[l * 512 + chn], lam = a.in(11)[l * 512 + chn];
        const float c8 = -8.f * (fmaxf(-lam, 0.f) + log1pf(__expf(-fabsf(lam)))) * LOG2E;
        Hrun = 0.f; Arun = 1.f;
#pragma unroll
        for (int mb = 0; mb < 2; ++mb) {
            float hl[16], cA[16], gA[4], gB[4];
#pragma unroll
            for (int g = 0; g < 4; ++g) { float h = 0.f, A = 1.f;
#pragma unroll
                for (int j = 0; j < 4; ++j) { const int r = 4 * g + j, tl = mb * 32 + crow(r, hi);
                    const float ra = sigmoidf_(da[mb][r] + b_a), ix = sigmoidf_(dx[mb][r] + b_x);
                    const float la2 = c8 * ra, av = fexp2(la2), mult = sqrtf(fmaxf(1.f - fexp2(2.f * la2), 0.f));
                    const float uv = bf1(U[tl * 72 + nb * 32 + l32]);
                    const float dr = mult * ix * uv;
                    h = av * h + dr; A *= av; hl[r] = h; cA[r] = A; }
                gA[g] = A; gB[g] = h; }
#pragma unroll
            for (int g = 0; g < 4; ++g) {
                const float pA = __shfl_xor(gA[g], 32), pB = __shfl_xor(gB[g], 32);
                const float A0 = hi ? pA : gA[g], B0 = hi ? pB : gB[g], A1 = hi ? gA[g] : pA, B1 = hi ? gB[g] : pB;
                const float in0 = Hrun, inA0 = Arun; Hrun = A0 * Hrun + B0; Arun *= A0;
                const float in1 = Hrun, inA1 = Arun; Hrun = A1 * Hrun + B1; Arun *= A1;
                const float my_in = hi ? in1 : in0, my_inA = hi ? inA1 : inA0;
#pragma unroll
                for (int j = 0; j < 4; ++j) { const int r = 4 * g + j, tl = mb * 32 + crow(r, hi); const size_t o = (size_t)(seq0 + t0 + tl) * 512 + chn;
                    HLOC[o] = (bf16)f2bf(hl[r] + cA[r] * my_in); CUMA[o] = (bf16)f2bf(cA[r] * my_inA); }
            }
        }
        if (hi == 0) { const size_t so = ((size_t)b * 64 + ch) * 512 + chn; SUMA[so] = Arun; SUMH[so] = Hrun; }
    }
    LDS_WAIT(); asm volatile("" ::: "memory");
}
__device__ __forceinline__ void sc_pass(const KA& a, int l, const bf16* __restrict__ SB, const bf16* __restrict__ P, bf16* Y, int gt, int ngt) {
    const float* cw = a.in(12) + (size_t)l * 3 * 512;
    for (int it = gt; it < HTOK * 64; it += ngt) {
        const int row = it >> 6, c0 = (it & 63) * 8, t = row & (SEQ - 1);
        const v4u sb = *(const v4u*)(SB + (size_t)row * 512 + c0), p2 = *(const v4u*)(P + (size_t)row * 512 + c0);
        v4u p1 = (v4u){0u, 0u, 0u, 0u}, p0 = (v4u){0u, 0u, 0u, 0u};
        if (t >= 1) p1 = *(const v4u*)(P + (size_t)(row - 1) * 512 + c0);
        if (t >= 2) p0 = *(const v4u*)(P + (size_t)(row - 2) * 512 + c0);
        float w0[8], w1[8], w2[8];
#pragma unroll
        for (int h = 0; h < 2; ++h) { const f32x4 x0 = *(const f32x4*)(cw + c0 + 4 * h), x1 = *(const f32x4*)(cw + 512 + c0 + 4 * h), x2 = *(const f32x4*)(cw + 1024 + c0 + 4 * h);
#pragma unroll
            for (int j = 0; j < 4; ++j) { w0[4 * h + j] = x0[j]; w1[4 * h + j] = x1[j]; w2[4 * h + j] = x2[j]; } }
        const unsigned s_[4] = {sb.x, sb.y, sb.z, sb.w}, q0[4] = {p0.x, p0.y, p0.z, p0.w}, q1[4] = {p1.x, p1.y, p1.z, p1.w}, q2[4] = {p2.x, p2.y, p2.z, p2.w};
        unsigned o[4];
#pragma unroll
        for (int j = 0; j < 4; ++j) { const float lo = bflo(s_[j]) * (w0[2 * j] * bflo(q0[j]) + w1[2 * j] * bflo(q1[j]) + w2[2 * j] * bflo(q2[j]));
            const float hi = bfhi(s_[j]) * (w0[2 * j + 1] * bfhi(q0[j]) + w1[2 * j + 1] * bfhi(q1[j]) + w2[2 * j + 1] * bfhi(q2[j])); o[j] = cvtpk(lo, hi); }
        *(v4u*)(Y + (size_t)row * 1536 + 1024 + c0) = (v4u){o[0], o[1], o[2], o[3]};
    }
}
__device__ __forceinline__ float gelu_tanh_f(float x) { return x * sigmoidf_(2.f * 0.7978845608028654f * (x + 0.044715f * x * x * x)); }
__device__ __forceinline__ void lru_fix_task(const bf16* __restrict__ LG, const bf16* __restrict__ HLOC, const bf16* __restrict__ CUMA, const float* __restrict__ SUMA, const float* __restrict__ SUMH,
                                             bf16* Y, LAS float* CAR, int b, int ch, int tid) {
    { float carry = 0.f; const float* pa = SUMA + (size_t)b * 64 * 512 + tid; const float* ph = SUMH + (size_t)b * 64 * 512 + tid;
#pragma unroll 8
      for (int c = 0; c < ch; ++c) carry = pa[c * 512] * carry + ph[c * 512];
      CAR[tid] = carry; }
    __syncthreads();
    const int g8 = (tid & 63) * 8; float cr[8];
#pragma unroll
    for (int j = 0; j < 8; ++j) cr[j] = CAR[g8 + j];
    const size_t r0 = (size_t)b * SEQ + ch * 64;
#pragma unroll 2
    for (int k = 0; k < 8; ++k) { const size_t row = r0 + (tid >> 6) + 8 * k, o = row * 512 + g8;
        float x[8], h[8], c[8]; unpack8(*(const v4u*)(LG + o), x); unpack8(*(const v4u*)(HLOC + o), h); unpack8(*(const v4u*)(CUMA + o), c);
#pragma unroll
        for (int j = 0; j < 8; ++j) x[j] = gelu_tanh_f(x[j]) * (h[j] + c[j] * cr[j]);
        *(v4u*)(Y + row * 1536 + 512 + g8) = pack8f(x); }
    __syncthreads();
}

__device__ __forceinline__ void p6_ln1_router(const KA& a, int l, LAS unsigned char* lds, int G, int tid, int wave, int lane) {
    unsigned char* ws = a.ws(); bf16* H = (bf16*)(ws + WS_H); float* WTS = (float*)(ws + WS_WTS); unsigned* LIST = (unsigned*)(ws + WS_LIST); gu32* ctl = (gu32*)(ws + WS_CTL);
    LAS float* RW = (LAS float*)lds;
    LAS int* ENT = (LAS int*)(lds + 81920);
    LAS int* RANK = ENT + 256;
    LAS unsigned* LCNT = (LAS unsigned*)(RANK + 256);
    LAS unsigned* LBASE = LCNT + 16;
    LAS float* LGS = (LAS float*)(lds + 81920 + 4096) + wave * (16 * 20 * 4);
    { const float* wg = a.in(19) + (size_t)l * 1024 * 4; const float* we = a.in(21) + (size_t)l * 1024 * 16;
      for (int i = tid; i < 1024 * 4; i += 512) RW[(i & 3) * 1024 + (i >> 2)] = wg[i];
      for (int i = tid; i < 1024 * 16; i += 512) RW[(4 + (i & 15)) * 1024 + (i >> 4)] = we[i]; }
    __syncthreads();
    const float* gam = a.in(17) + l * D; const float* bet = a.in(18) + l * D; const float* gbias = a.in(20) + l * 4; const float* ebias = a.in(22) + l * 16;
    for (int rb = blockIdx.x; rb < NTOK / 128; rb += G) {
        if (tid < 16) LCNT[tid] = 0u;
#pragma unroll 1
        for (int grp = 0; grp < 4; ++grp) {
            float v[4][16];
#pragma unroll
            for (int r = 0; r < 4; ++r) { bf16* hp = H + (size_t)(rb * 128 + wave * 16 + grp * 4 + r) * D; unpack8(*(const v4u*)(hp + 8 * lane), v[r]); unpack8(*(const v4u*)(hp + 512 + 8 * lane), v[r] + 8); }
#pragma unroll
            for (int r = 0; r < 4; ++r) { ln16(v[r], gam, bet, lane); const size_t row_ = (size_t)(rb * 128 + wave * 16 + grp * 4 + r); bf16* hp = H + row_ * D; *(v4u*)(hp + 8 * lane) = pack8f(v[r]); *(v4u*)(hp + 512 + 8 * lane) = pack8f(v[r] + 8);
                quant_row16(v[r], (signed char*)(ws + WS_HQ) + row_ * D, (float*)(ws + WS_HS) + row_, 8 * lane, 512 + 8 * lane, lane); }
#pragma unroll 2
            for (int o = 0; o < 20; ++o) { const LAS float* w = RW + o * 1024 + 8 * lane; float wv[16];
#pragma unroll
                for (int h = 0; h < 2; ++h) { const f32x4 w0 = *(const LAS f32x4*)(w + 512 * h), w1 = *(const LAS f32x4*)(w + 512 * h + 4);
                    wv[8 * h] = w0.x; wv[8 * h + 1] = w0.y; wv[8 * h + 2] = w0.z; wv[8 * h + 3] = w0.w; wv[8 * h + 4] = w1.x; wv[8 * h + 5] = w1.y; wv[8 * h + 6] = w1.z; wv[8 * h + 7] = w1.w; }
#pragma unroll
                for (int r = 0; r < 4; ++r) { float s = 0.f;
#pragma unroll
                    for (int j = 0; j < 16; ++j) s += v[r][j] * wv[j];
                    s = row16_sum(s);
                    if ((lane & 15) == 0) LGS[((grp * 4 + r) * 20 + o) * 4 + (lane >> 4)] = s; } }
        }
        LDS_WAIT(); asm volatile("" ::: "memory");
        if (lane < 16) {
            const int rl = wave * 16 + lane, row = rb * 128 + rl; float lg[20];
#pragma unroll
            for (int o = 0; o < 20; ++o) { const f32x4 p = *(const LAS f32x4*)(LGS + (lane * 20 + o) * 4); lg[o] = (p.x + p.y) + (p.z + p.w); }
            int gs = 0; float bestg = lg[0] + gbias[0];
#pragma unroll
            for (int g = 1; g < 4; ++g) { const float x = lg[g] + gbias[g]; if (x > bestg) { bestg = x; gs = g; } }
            const float gmax = fmaxf(fmaxf(lg[0], lg[1]), fmaxf(lg[2], lg[3]));
            float gden = 0.f, gnum = 0.f;
#pragma unroll
            for (int g = 0; g < 4; ++g) { const float e = __expf(lg[g] - gmax); gden += e; gnum = (g == gs) ? e : gnum; }
            const float gprob = gnum / gden;
            float ein[4], eb[4];
#pragma unroll
            for (int i = 0; i < 4; ++i) { ein[i] = gs == 0 ? lg[4 + i] : gs == 1 ? lg[8 + i] : gs == 2 ? lg[12 + i] : lg[16 + i]; eb[i] = ein[i] + ebias[gs * 4 + i]; }
            int i0 = 0; float b0 = eb[0];
#pragma unroll
            for (int i = 1; i < 4; ++i) if (eb[i] > b0) { b0 = eb[i]; i0 = i; }
            int i1 = -1; float b1 = 0.f;
#pragma unroll
            for (int i = 0; i < 4; ++i) if (i != i0 && (i1 < 0 || eb[i] > b1)) { b1 = eb[i]; i1 = i; }
            const float x0 = i0 == 0 ? ein[0] : i0 == 1 ? ein[1] : i0 == 2 ? ein[2] : ein[3], x1 = i1 == 0 ? ein[0] : i1 == 1 ? ein[1] : i1 == 2 ? ein[2] : ein[3];
            const float mx = fmaxf(x0, x1), e0 = __expf(x0 - mx), e1 = __expf(x1 - mx), inv = gprob / (e0 + e1);
            *(pg8::f32x2*)(WTS + (size_t)row * 2) = (pg8::f32x2){e0 * inv, e1 * inv}; ENT[rl * 2] = gs * 4 + i0; ENT[rl * 2 + 1] = gs * 4 + i1;
        }
        __syncthreads();
        if (tid < 256) RANK[tid] = (int)__hip_atomic_fetch_add((LAS unsigned*)&LCNT[ENT[tid]], 1u, __ATOMIC_RELAXED, __HIP_MEMORY_SCOPE_WORKGROUP);
        __syncthreads();
        if (tid < 16) LBASE[tid] = __hip_atomic_fetch_add(ctl + CW_CNT + (l * 16 + tid) * 64, LCNT[tid], RLX_AGENT);
        __syncthreads();
        if (tid < 256) { const int e = ENT[tid]; LIST[(size_t)e * LISTCAP + LBASE[e] + RANK[tid]] = (unsigned)((rb * 128 + (tid >> 1)) * 2 + (tid & 1)); }
        __syncthreads();
    }
}
__device__ __forceinline__ void moe_table(const KA& a, int l, LAS int* tab, int tid) {
    gu32* ctl = (gu32*)(a.ws() + WS_CTL);
    if (tid < 16) tab[17 + tid] = (int)__hip_atomic_load(ctl + CW_CNT + (l * 16 + tid) * 64, RLX_AGENT);
    __syncthreads();
    if (tid == 0) { int s = 0; for (int e = 0; e < 16; ++e) { tab[e] = s; s += (tab[17 + e] + 255) >> 8; } tab[16] = s; }
    __syncthreads();
}
__device__ __forceinline__ void p9_ln2(const KA& a, int l, int gw, int NGW, int lane) {
    unsigned char* ws = a.ws(); bf16* H = (bf16*)(ws + WS_H); const float* WTS = (const float*)(ws + WS_WTS); const bf16* F0 = (const bf16*)(ws + WS_FFN); const bf16* F1 = F0 + (size_t)NTOK * D;
    const float* gam = a.in(26) + l * D; const float* bet = a.in(27) + l * D;
    for (int row = gw; row < NTOK; row += NGW) {
        bf16* hp = H + (size_t)row * D; const bf16* f0 = F0 + (size_t)row * D; const bf16* f1 = F1 + (size_t)row * D; const float w0 = WTS[(size_t)row * 2], w1 = WTS[(size_t)row * 2 + 1];
        float v[16], x[8], y[8];
#pragma unroll
        for (int h = 0; h < 2; ++h) { unpack8(*(const v4u*)(hp + 512 * h + 8 * lane), v + 8 * h); unpack8(*(const v4u*)(f0 + 512 * h + 8 * lane), x); unpack8(*(const v4u*)(f1 + 512 * h + 8 * lane), y);
#pragma unroll
            for (int j = 0; j < 8; ++j) v[8 * h + j] = ALPHA * v[8 * h + j] + w0 * x[j] + w1 * y[j]; }
        ln16(v, gam, bet, lane);
        if (l == DEPTH - 1) { float* op = a.out() + (size_t)row * D;
#pragma unroll
            for (int h = 0; h < 2; ++h) { *(f32x4*)(op + 512 * h + 8 * lane) = (f32x4){v[8 * h], v[8 * h + 1], v[8 * h + 2], v[8 * h + 3]}; *(f32x4*)(op + 512 * h + 8 * lane + 4) = (f32x4){v[8 * h + 4], v[8 * h + 5], v[8 * h + 6], v[8 * h + 7]}; } }
        else { *(v4u*)(hp + 8 * lane) = pack8f(v); *(v4u*)(hp + 512 + 8 * lane) = pack8f(v + 8);
            quant_row16(v, (signed char*)(ws + WS_HQ) + (size_t)row * D, (float*)(ws + WS_HS) + row, 8 * lane, 512 + 8 * lane, lane); }
    }
}

#ifndef PH_MASK
#define PH_MASK 0xFFFF
#endif
#ifndef REP_MASK
#define REP_MASK 0
#endif
#define REPS(bit) for (int rep_ = 0; rep_ < ((REP_MASK & (bit)) ? 2 : 1); ++rep_)
#ifndef STOP_AT
#define STOP_AT 0
#endif
#define STOP_DUMP(n, off) do { if (STOP_AT == (n) && l == 0 && hf == 0) { PHASE_BEGIN const bf16* H_ = (const bf16*)(ws + (off)); float* o_ = A_.out(); for (size_t i = (size_t)bx * 512 + tid; i < (size_t)NTOK * D; i += (size_t)G * 512) o_[i] = bf1(H_[i]); return; } } while (0)
#define STOP_HERE(n) do { if (STOP_AT == (n)) { PHASE_BEGIN const bf16* H_ = (const bf16*)(ws + WS_H); float* o_ = A_.out(); for (size_t i = (size_t)bx * 512 + tid; i < (size_t)NTOK * D; i += (size_t)G * 512) o_[i] = bf1(H_[i]); return; } } while (0)
__global__ void __launch_bounds__(NWAVES * 64, 2) hybrid_fwd(Args args) {
    extern __shared__ __attribute__((aligned(16))) unsigned char lds_raw[];
    LAS unsigned char* lds = (LAS unsigned char*)lds_raw;
    const int G = gridDim.x, bx = blockIdx.x;
#define PHASE_BEGIN KA A_; A_.kp = (KP)__builtin_amdgcn_kernarg_segment_ptr(); asm volatile("" : "+s"(A_.kp)); int tid = threadIdx.x; asm volatile("" : "+v"(tid)); \
    const int lane = tid & 63, wave = __builtin_amdgcn_readfirstlane(tid >> 6), gw = bx * NWAVES + wave, NGW = G * NWAVES; unsigned char* ws = A_.ws(); (void)lane; (void)gw; (void)NGW; (void)ws;
    XcdBarrier bar;
    { PHASE_BEGIN
      for (int u = tid; u < (LDS_BYTES - LDSCTL_OFF) / 4; u += NWAVES * 64) ((LAS unsigned*)(lds + LDSCTL_OFF))[u] = 0u;
      __syncthreads();
      bar = xcd_barrier_post((unsigned*)(ws + WS_CTL) + CW_BAR, (volatile LAS unsigned*)(lds + MISC_OFF) + 8);
      REPS(1) if (PH_MASK & 1) p0_prologue(A_, lds, gw, NGW, wave, lane); }
    xcd_barrier(bar);
    STOP_HERE(1);

#pragma unroll 1
    for (int l = 0; l < DEPTH; ++l) {
#pragma unroll 1
        for (int hf = 0; hf < 2; ++hf) {
            REPS(2) if (PH_MASK & 2) { PHASE_BEGIN
              InprojSched S; S.G = G; S.c = bx; S.Hh = (const char*)(ws + WS_HQ) + (size_t)hf * HTOK * D; S.Win = (const char*)(ws + WS_WIN) + (size_t)l * PROJ * 1024;
              EpiInproj E{(bf16*)(ws + WS_ZC), (bf16*)(ws + WS_G), (bf16*)(ws + WS_VT), A_.in(4) + (size_t)l * 3 * 1024, (const float*)(ws + WS_HS) + hf * HTOK, (const float*)(ws + WS_CTL) + CW_WS + l * PROJ};
              pg8::gemm_phase<EpiInproj, InprojSched, true, false, true>(lds, pg8::Gemm{512, 512, 512}, S, E); }
            xcd_barrier(bar);
            STOP_DUMP(10, WS_ZC); STOP_DUMP(11, WS_ZC + 64 * MiB); STOP_DUMP(12, WS_ZC + 128 * MiB); STOP_DUMP(13, WS_ZC + 144 * MiB);
            REPS(4) if (PH_MASK & 4) { PHASE_BEGIN
              bf16* ZC = (bf16*)(ws + WS_ZC); bf16* Y = (bf16*)(ws + WS_Y); bf16* HLOC = (bf16*)(ws + WS_MRG); bf16* CUMA = HLOC + (size_t)HTOK * 512; float* SUMA = (float*)(ws + WS_SUM); float* SUMH = SUMA + 4 * 64 * 512;
              LAS bf16* U = (LAS bf16*)(lds + wave * 9216);
              REPS(1024) for (int t = gw; t < 4 * 64 * 8; t += NGW) lru_local_task(A_, l, ZC + (size_t)2 * HTOK * 512, HLOC, CUMA, SUMA, SUMH, (const bf16*)(ws + WS_LRUW), U, t >> 9, (t >> 3) & 63, t & 7, lane);
              __syncthreads();
              REPS(2048) for (int t = bx; t < 4 * 8 * 16; t += G) sb_attn_wg(ZC, ZC + (size_t)HTOK * 512, (const bf16*)(ws + WS_VT), Y, lds, t >> 7, (t >> 4) & 7, t & 15, wave, lane);
              REPS(4096) sc_pass(A_, l, ZC + (size_t)4 * HTOK * 512, ZC + (size_t)5 * HTOK * 512, Y, bx * 512 + tid, G * 512); }
            xcd_barrier(bar);
            STOP_DUMP(20, WS_Y); STOP_DUMP(21, WS_MRG);
            REPS(8) if (PH_MASK & 8) { PHASE_BEGIN
              const bf16* HLOC = (const bf16*)(ws + WS_MRG); const bf16* CUMA = HLOC + (size_t)HTOK * 512; const float* SUMA = (const float*)(ws + WS_SUM); const float* SUMH = SUMA + 4 * 64 * 512;
              for (int t = bx; t < 4 * 64; t += G) lru_fix_task((const bf16*)(ws + WS_ZC) + (size_t)3 * HTOK * 512, HLOC, CUMA, SUMA, SUMH, (bf16*)(ws + WS_Y), (LAS float*)lds, t >> 6, t & 63, tid); }
            xcd_barrier(bar);
            STOP_DUMP(30, WS_Y);
            REPS(16) if (PH_MASK & 16) { PHASE_BEGIN
              BranchSched S; S.G = G; S.c = bx; S.Y = (const char*)(ws + WS_Y); S.WBR = (const char*)(ws + WS_WBR) + (size_t)l * 1024 * 1536 * 2;
              EpiBranch E{(const bf16*)(ws + WS_G), (bf16*)(ws + WS_MRG)};
              pg8::gemm_phase<EpiBranch, BranchSched, true, false>(lds, pg8::Gemm{512, 1536, 1536}, S, E); }
            xcd_barrier(bar);
            STOP_DUMP(40, WS_MRG);
            if (PH_MASK & 32) { PHASE_BEGIN
              PlainSched S; S.G = G; S.c = bx; S.nM = 64; S.nN = 4; S.A = (const char*)(ws + WS_MRG); S.B = (const char*)(ws + WS_WOUT) + (size_t)l * 1024 * 1024 * 2; S.astep = (size_t)256 * 1024 * 2; S.bstep = (size_t)256 * 1024 * 2;
              EpiOutproj E{(bf16*)(ws + WS_H) + (size_t)hf * HTOK * D};
              pg8::gemm_phase<EpiOutproj, PlainSched, true, false>(lds, pg8::Gemm{1024, 1024, 1024}, S, E); }
            xcd_barrier(bar);
            STOP_DUMP(50, WS_H);
        }
        STOP_HERE(2);
        if (PH_MASK & 64) { PHASE_BEGIN p6_ln1_router(A_, l, lds, G, tid, wave, lane); }
        xcd_barrier(bar);
        STOP_HERE(3);
        REPS(128) if (PH_MASK & 128) { PHASE_BEGIN
          LAS int* tab = (LAS int*)(lds + MOE_OFF);
          moe_table(A_, l, tab, tid);
          MoeSched S; S.G = G; S.c = bx; S.tab = tab; S.Abase = (const char*)(ws + WS_HQ); S.atile = 0; S.Wbase = (const char*)(ws + WS_WGU) + (size_t)l * NEXP * 1024 * 1024; S.wstride = (size_t)1024 * 1024; S.bstep = (size_t)256 * 1024;
          S.list = (const unsigned*)(ws + WS_LIST);
          EpiGateUp E{(bf16*)(ws + WS_HB), (const unsigned*)(ws + WS_LIST), (const float*)(ws + WS_HS), (const float*)(ws + WS_WGUS) + (size_t)l * NEXP * 1024};
          pg8::gemm_phase<EpiGateUp, MoeSched, true, true, true>(lds, pg8::Gemm{512, 512, 512}, S, E); }
        xcd_barrier(bar);
        REPS(256) if (PH_MASK & 256) { PHASE_BEGIN
          LAS int* tab = (LAS int*)(lds + MOE_OFF);
          moe_table(A_, l, tab, tid);
          MoeSched S; S.G = G; S.c = bx; S.tab = tab; S.Abase = (const char*)(ws + WS_HB); S.atile = (size_t)256 * 512 * 2; S.Wbase = (const char*)(ws + WS_WDN) + (size_t)l * NEXP * 1024 * 512 * 2; S.wstride = (size_t)1024 * 512 * 2; S.bstep = (size_t)256 * 512 * 2;
          S.list = (const unsigned*)(ws + WS_LIST);
          EpiDown E{(bf16*)(ws + WS_FFN), (const unsigned*)(ws + WS_LIST)};
          pg8::gemm_phase<EpiDown, MoeSched, true, false>(lds, pg8::Gemm{512, 512, 512}, S, E); }
        xcd_barrier(bar);
        if (PH_MASK & 512) { PHASE_BEGIN p9_ln2(A_, l, gw, NGW, lane); }
        if (l + 1 < DEPTH) xcd_barrier(bar);
        STOP_HERE(4);
    }
}

extern "C" void kernel_launch(void* const* d_in, const int* in_sizes, int n_in, void* d_out, int out_size, void* d_ws, size_t ws_size, hipStream_t stream) {
    static int grid = 0;
    if (grid == 0) {
        if (n_in != 28 || in_sizes[0] != NTOK * D || out_size != NTOK * D || ws_size < WS_END) { fprintf(stderr, "kernel_launch: unexpected shapes (n_in %d, in0 %d, out %d, ws %zu); nothing launched\n", n_in, n_in > 0 ? in_sizes[0] : -1, out_size, ws_size); grid = -1; return; }
        int dev = 0, cus = 0, per_cu = 0;
        if (hipGetDevice(&dev) != hipSuccess || hipDeviceGetAttribute(&cus, hipDeviceAttributeMultiprocessorCount, dev) != hipSuccess) { grid = -1; return; }
        if (hipFuncSetAttribute((const void*)hybrid_fwd, hipFuncAttributeMaxDynamicSharedMemorySize, LDS_BYTES) != hipSuccess) { fprintf(stderr, "kernel_launch: hipFuncSetAttribute failed\n"); grid = -1; return; }
        if (hipOccupancyMaxActiveBlocksPerMultiprocessor(&per_cu, (const void*)hybrid_fwd, NWAVES * 64, LDS_BYTES) != hipSuccess || per_cu < 1) fprintf(stderr, "kernel_launch: occupancy query reports %d\n", per_cu);
        (void)hipGetLastError();
        grid = cus;
    }
    if (grid < 0) return;
    if (hipMemsetAsync((char*)d_ws + WS_CTL, 0, CTL_ZERO_BYTES, stream) != hipSuccess) return;
    Args a{};
    for (int i = 0; i < 28; ++i) a.in[i] = (const float*)d_in[i];
    a.out = (float*)d_out; a.ws = (unsigned char*)d_ws;
    hipLaunchKernelGGL(hybrid_fwd, dim3(grid), dim3(NWAVES * 64), LDS_BYTES, stream, a);
}
```

```cpp
#include <hip/hip_runtime.h>
#include <cstdio>
#include <cstdint>
namespace pg8 {
#define PG8_LAS __attribute__((address_space(3)))
typedef unsigned short bf16_t;
typedef short bf16x8 __attribute__((ext_vector_type(8)));
typedef float f32x4 __attribute__((ext_vector_type(4)));
typedef float f32x2 __attribute__((ext_vector_type(2)));
typedef unsigned u32x4 __attribute__((ext_vector_type(4)));
typedef unsigned u32x2 __attribute__((ext_vector_type(2)));
typedef int i32x4 __attribute__((ext_vector_type(4)));
constexpr int BM = 256, BK = 64, HALF = 128, HTB = HALF * BK * 2  , STAGE_BYTES = 8 * HTB, NXCD = 8, WGM = 8;

__host__ __device__ __forceinline__ int lds_byte(int r, int c) { const int st = (r >> 4) * 2 + (c >> 5), rr = r & 15, cc = c & 31, ob = rr * 64 + cc * 2; return st * 1024 + (ob ^ (((ob >> 9) & 1) << 5)); }
__host__ __device__ __forceinline__ void stage_rc(int b, int& R, int& C) { const int st = b / 1024, sb = b % 1024, swz = sb ^ (((sb >> 9) & 1) << 5); R = (st >> 1) * 16 + swz / 64; C = (st & 1) * 32 + (swz % 64) / 2; }
__host__ __device__ __forceinline__ int perm32(int rho) { const int n = rho >> 4, i = rho & 15; return 8 * (i >> 2) + 4 * n + (i & 3); }

struct Unit { int pm, pn, ty, aux, nv, pad; const char* A; const char* B; };
struct Gemm { int K, lda, ldb; };

__device__ __forceinline__ void tile_swz(int L, int nM, int nN, int& pm, int& pn) {
    const int nwg = nM * nN; int wgid = L; { const int q = nwg / NXCD, r = nwg % NXCD, xcd = wgid % NXCD, off = wgid / NXCD; wgid = (xcd < r ? xcd * (q + 1) : r * (q + 1) + (xcd - r) * q) + off; }
    const int nig = WGM * nN, gid = wgid / nig, fm = gid * WGM, gsz = (nM - fm) < WGM ? (nM - fm) : WGM;
    pm = fm + ((wgid % nig) % gsz); pn = (wgid % nig) / gsz;
}
__device__ __forceinline__ unsigned cvt_pk_bf16(float lo, float hi) { unsigned r; asm volatile("v_cvt_pk_bf16_f32 %0, %1, %2" : "=v"(r) : "v"(lo), "v"(hi)); return r; }

template <class Epi, class Sched, bool ALIGN_EPI, bool GATHER, bool I8 = false>
__device__ __forceinline__ void gemm_phase(PG8_LAS unsigned char* lds, const Gemm g, const Sched& S, const Epi& E) {
    int tid = threadIdx.x; asm volatile("" : "+v"(tid));
    const int wid = __builtin_amdgcn_readfirstlane(tid >> 6), lane = tid & 63, wr = wid >> 2, wc = wid & 3, fr = lane & 15, fq = lane >> 4;
    const int K = g.K, nt = K / BK;
    int sR[2], sC[2];
    unsigned cvA[2][2], nvA[2][2], voffB[2];
#pragma unroll
    for (int i = 0; i < 2; ++i) { int R, C; stage_rc(tid * 16 + i * 8192, R, C); sR[i] = R; sC[i] = C; const int Rb = Epi::PERM ? ((R & ~31) + perm32(R & 31)) : R;
        voffB[i] = (unsigned)(Rb * g.ldb + C) * 2u;
#pragma unroll
        for (int h = 0; h < 2; ++h) { cvA[h][i] = (unsigned)((h * HALF + R) * g.lda + C) * 2u; nvA[h][i] = cvA[h][i]; } }
    const size_t kstep = (size_t)(BK * 2);
    const size_t hstepB = (size_t)HALF * g.ldb * 2;
    const unsigned ldsw = (unsigned)wid * 1024u;
    const int aoff = lds_byte(wr * 64 + fr, fq * 8), boff = lds_byte(wc * 32 + fr, fq * 8);
#define PG8_SA(b, h) (((b) * 2 + (h)) * HTB)
#define PG8_SB(b, h) ((4 + (b) * 2 + (h)) * HTB)
#define PG8_STAGE(bufoff, gbase, voff) do { _Pragma("unroll") for (int _i = 0; _i < 2; ++_i) \
        __builtin_amdgcn_global_load_lds((const unsigned*)((const char*)(gbase) + (voff)[_i]), (PG8_LAS unsigned*)(lds + (bufoff) + ldsw + _i * 8192), 16, 0, 0); } while (0)
#define PG8_LDA(dst, b, h) do { _Pragma("unroll") for (int m = 0; m < 4; ++m) _Pragma("unroll") for (int k = 0; k < 2; ++k) dst[m][k] = *(const PG8_LAS bf16x8*)(lds + PG8_SA(b, h) + aoff + m * 2048 + k * 1024); } while (0)
#define PG8_LDB(dst, b, h) do { _Pragma("unroll") for (int n = 0; n < 2; ++n) _Pragma("unroll") for (int k = 0; k < 2; ++k) dst[n][k] = *(const PG8_LAS bf16x8*)(lds + PG8_SB(b, h) + boff + n * 2048 + k * 1024); } while (0)
#define PG8_MMA(ai, bj, At, Bt) do { __builtin_amdgcn_s_setprio(1); _Pragma("unroll") for (int m = 0; m < 4; ++m) _Pragma("unroll") for (int n = 0; n < 2; ++n) _Pragma("unroll") for (int k = 0; k < 2; ++k) { \
        if constexpr (I8) acc[ai][bj][m][n] = __builtin_bit_cast(f32x4, __builtin_amdgcn_mfma_i32_16x16x64_i8(__builtin_bit_cast(i32x4, Bt[n][k]), __builtin_bit_cast(i32x4, At[m][k]), __builtin_bit_cast(i32x4, acc[ai][bj][m][n]), 0, 0, 0)); \
        else acc[ai][bj][m][n] = __builtin_amdgcn_mfma_f32_16x16x32_bf16(Bt[n][k], At[m][k], acc[ai][bj][m][n], 0, 0, 0); } __builtin_amdgcn_s_setprio(0); } while (0)
#define PG8_WAIT_V(n) asm volatile("s_waitcnt vmcnt(" #n ")" ::: "memory")
#define PG8_WAIT_L(n) asm volatile("s_waitcnt lgkmcnt(" #n ")" ::: "memory")
#define PG8_BAR __builtin_amdgcn_s_barrier()
#define PG8_SCHED __builtin_amdgcn_sched_barrier(0)
    Unit cur, nxt; int ui = 0;
    if (!S.next(0, cur)) return;
    f32x4 acc[2][2][4][2];
#pragma unroll
    for (int a = 0; a < 2; ++a)
#pragma unroll
        for (int b = 0; b < 2; ++b)
#pragma unroll
            for (int m = 0; m < 4; ++m)
#pragma unroll
                for (int n = 0; n < 2; ++n) acc[a][b][m][n] = (f32x4){0.f, 0.f, 0.f, 0.f};
    bf16x8 At[4][2], B0[2][2], B1[2][2];
    const char* cA = cur.A; const char* cB = cur.B;
    asm volatile("" : "+s"(cA), "+s"(cB));
    if constexpr (GATHER) {
#pragma unroll
        for (int h = 0; h < 2; ++h)
#pragma unroll
            for (int i = 0; i < 2; ++i) cvA[h][i] = (unsigned)(S.arow(cur, h * HALF + sR[i]) * g.lda + sC[i]) * 2u;
        PG8_WAIT_V(0);
    }
    S.a_ready(cur);
    PG8_STAGE(PG8_SB(0, 0), cB, voffB); PG8_STAGE(PG8_SB(0, 1), cB + hstepB, voffB); PG8_STAGE(PG8_SA(0, 0), cA, cvA[0]); PG8_STAGE(PG8_SA(0, 1), cA, cvA[1]);
    if (wr == 1) PG8_BAR;
    PG8_WAIT_V(2); PG8_BAR;
    PG8_STAGE(PG8_SB(1, 0), cB + kstep, voffB); PG8_STAGE(PG8_SA(1, 0), cA + kstep, cvA[0]); PG8_STAGE(PG8_SB(1, 1), cB + hstepB + kstep, voffB);
    PG8_WAIT_V(6); PG8_BAR;
    for (;;) {
        const bool has_next = S.next(ui + 1, nxt);
        const char* nA = has_next ? nxt.A : cA; const char* nB = has_next ? nxt.B : cB;
        asm volatile("" : "+s"(nA), "+s"(nB));
        if constexpr (GATHER) {
            if (has_next) {
#pragma unroll
                for (int h = 0; h < 2; ++h)
#pragma unroll
                    for (int i = 0; i < 2; ++i) nvA[h][i] = (unsigned)(S.arow(nxt, h * HALF + sR[i]) * g.lda + sC[i]) * 2u;
                PG8_WAIT_V(0);
            } else {
#pragma unroll
                for (int h = 0; h < 2; ++h)
#pragma unroll
                    for (int i = 0; i < 2; ++i) nvA[h][i] = cvA[h][i];
            }
        }
        for (int t = 0; t < nt; t += 2) {
            const bool last = (t == nt - 2);
            const char* a1 = cA + (size_t)(t + 1) * kstep;
            const char* a2 = last ? nA : cA + (size_t)(t + 2) * kstep; const char* b2 = last ? nB : cB + (size_t)(t + 2) * kstep;
            const char* a3 = a2 + kstep; const char* b3 = b2 + kstep;
            unsigned o2[2][2];
#pragma unroll
            for (int h = 0; h < 2; ++h)
#pragma unroll
                for (int i = 0; i < 2; ++i) o2[h][i] = (GATHER && last) ? nvA[h][i] : cvA[h][i];
            if (last && has_next) S.a_ready(nxt);
            PG8_LDB(B0, 0, 0); PG8_LDB(B1, 0, 1); PG8_SCHED; PG8_LDA(At, 0, 0); PG8_STAGE(PG8_SA(1, 1), a1, cvA[1]);
            PG8_WAIT_V(8); PG8_WAIT_L(0); PG8_BAR; PG8_MMA(0, 0, At, B0); PG8_MMA(0, 1, At, B1); PG8_BAR; PG8_SCHED;
            PG8_LDA(At, 0, 1); PG8_STAGE(PG8_SB(0, 0), b2, voffB); PG8_STAGE(PG8_SB(0, 1), b2 + hstepB, voffB); PG8_STAGE(PG8_SA(0, 0), a2, o2[0]);
            PG8_WAIT_V(8); PG8_WAIT_L(0); PG8_BAR; PG8_MMA(1, 0, At, B0); PG8_MMA(1, 1, At, B1); PG8_BAR; PG8_SCHED;
            PG8_LDB(B0, 1, 0); PG8_LDB(B1, 1, 1); PG8_SCHED; PG8_LDA(At, 1, 0); PG8_STAGE(PG8_SA(0, 1), a2, o2[1]);
            PG8_WAIT_V(8); PG8_WAIT_L(0); PG8_BAR; PG8_MMA(0, 0, At, B0); PG8_MMA(0, 1, At, B1); PG8_BAR; PG8_SCHED;
            PG8_LDA(At, 1, 1); PG8_STAGE(PG8_SB(1, 0), b3, voffB); PG8_STAGE(PG8_SB(1, 1), b3 + hstepB, voffB); PG8_STAGE(PG8_SA(1, 0), a3, o2[0]);
            PG8_WAIT_V(8); PG8_WAIT_L(0); PG8_BAR; PG8_MMA(1, 0, At, B0); PG8_MMA(1, 1, At, B1); PG8_BAR; PG8_SCHED;
        }
        if constexpr (ALIGN_EPI) { if (wr == 0) PG8_BAR; }
        E(acc, cur, wr, wc, fr, fq); S.done(cur);
        if (!has_next) break;
#pragma unroll
        for (int a = 0; a < 2; ++a)
#pragma unroll
            for (int b = 0; b < 2; ++b)
#pragma unroll
                for (int m = 0; m < 4; ++m)
#pragma unroll
                    for (int n = 0; n < 2; ++n) acc[a][b][m][n] = (f32x4){0.f, 0.f, 0.f, 0.f};
        cur = nxt; cA = nA; cB = nB; ++ui;
        if constexpr (GATHER) {
#pragma unroll
            for (int h = 0; h < 2; ++h)
#pragma unroll
                for (int i = 0; i < 2; ++i) cvA[h][i] = nvA[h][i];
        }
        if constexpr (ALIGN_EPI) { if (wr == 1) PG8_BAR; }
    }
    PG8_WAIT_V(0);
    if constexpr (!ALIGN_EPI) { if (wr == 0) PG8_BAR; }
    PG8_BAR;
#undef PG8_SA
#undef PG8_SB
#undef PG8_STAGE
#undef PG8_LDA
#undef PG8_LDB
#undef PG8_MMA
#undef PG8_WAIT_V
#undef PG8_WAIT_L
#undef PG8_BAR
#undef PG8_SCHED
}
}
constexpr int NWAVES = 8;
constexpr int D = 1024, NTOK = 32768, SEQ = 4096, HTOK = 16384  , DEPTH = 2, NEXP = 16;
constexpr int PROJ = 7168, NMAIN = 6656;
constexpr float ALPHA = 1.41421356237309515f;
constexpr float LN_EPS = 1e-5f;
constexpr float LOG2E = 1.4426950408889634f;
constexpr float C2 = 0.125f * LOG2E;
constexpr int LISTCAP = 32768;

constexpr size_t MiB = 1u << 20;
constexpr size_t WS_CTL = 0, CTL_ZERO_BYTES = 1 * MiB;
constexpr size_t WS_WIN = 1 * MiB;
constexpr size_t WS_WBR = 15 * MiB;
constexpr size_t WS_WOUT = 21 * MiB;
constexpr size_t WS_WGU = 25 * MiB;
constexpr size_t WS_WDN = 89 * MiB;
constexpr size_t WS_LRUW = 121 * MiB;
constexpr size_t WS_HQ = 122 * MiB;
constexpr size_t WS_H = 154 * MiB;
constexpr size_t WS_Y = 218 * MiB;
constexpr size_t WS_MRG = 266 * MiB;
constexpr size_t WS_ZC = 298 * MiB;
constexpr size_t WS_G = WS_ZC + 96 * MiB, WS_VT = WS_ZC + 192 * MiB;
constexpr size_t WS_SUM = 506 * MiB;
constexpr size_t WS_HS = 507 * MiB;
constexpr size_t WS_WGUS = WS_HS + 256 * 1024;
constexpr size_t WS_LIST = 298 * MiB;
constexpr size_t WS_WTS = 300 * MiB;
constexpr size_t WS_LSC = WS_WTS + 512 * 1024;
constexpr size_t WS_HB = 303 * MiB;
constexpr size_t WS_FFN = 371 * MiB;
constexpr size_t WS_END = 508 * MiB;
constexpr int CW_TMO = 0, CW_BAR = 4096, CW_CNT = 8192, CW_LRU = 12288, CW_WS = 16384;

constexpr int RING_BYTES = 131072;
constexpr int LDSCTL_OFF = RING_BYTES, MISC_OFF = LDSCTL_OFF + 320, MOE_OFF = LDSCTL_OFF + 1024;
constexpr int LDS_BYTES = 147456;

#define GAS __attribute__((address_space(1)))
#define LAS __attribute__((address_space(3)))
typedef unsigned short bf16;
typedef unsigned v4u __attribute__((ext_vector_type(4)));
typedef unsigned v2u __attribute__((ext_vector_type(2)));
typedef float f32x4 __attribute__((ext_vector_type(4)));
typedef float f32x16 __attribute__((ext_vector_type(16)));
typedef short bf16x8 __attribute__((ext_vector_type(8)));
typedef GAS unsigned gu32;
#define RLX_AGENT __ATOMIC_RELAXED, __HIP_MEMORY_SCOPE_AGENT
#define LDS_WAIT() asm volatile("s_waitcnt lgkmcnt(0)" ::: "memory")
#define VM_WAIT() asm volatile("s_waitcnt vmcnt(0)" ::: "memory")
__device__ __forceinline__ unsigned f2bf(float f) { unsigned u = __builtin_bit_cast(unsigned, f); return (u + 0x7fffu + ((u >> 16) & 1u)) >> 16; }
__device__ __forceinline__ unsigned pk2(float lo, float hi) { return f2bf(lo) | (f2bf(hi) << 16); }
typedef float f32x2_t __attribute__((ext_vector_type(2))); typedef __bf16 bf16x2_t __attribute__((ext_vector_type(2)));
__device__ __forceinline__ unsigned cvtpk(float lo, float hi) { f32x2_t v = {lo, hi}; bf16x2_t b = __builtin_convertvector(v, bf16x2_t); return __builtin_bit_cast(unsigned, b); }
__device__ __forceinline__ float bflo(unsigned w) { return __builtin_bit_cast(float, w << 16); }
__device__ __forceinline__ float bfhi(unsigned w) { return __builtin_bit_cast(float, w & 0xffff0000u); }
__device__ __forceinline__ float bf1(bf16 b) { return __builtin_bit_cast(float, ((unsigned)b) << 16); }
__device__ __forceinline__ float fexp2(float x) { return __builtin_amdgcn_exp2f(x); }
__device__ __forceinline__ float flog2(float x) { return __builtin_amdgcn_logf(x); }
__device__ __forceinline__ float frcp(float x) { return __builtin_amdgcn_rcpf(x); }
__device__ __forceinline__ float sigmoidf_(float x) { return frcp(1.f + fexp2(-LOG2E * x)); }
#define DPP_ADD(v, ctrl) ((v) + __builtin_bit_cast(float, __builtin_amdgcn_update_dpp(0, __builtin_bit_cast(int, (v)), (ctrl), 0xF, 0xF, true)))
__device__ __forceinline__ float row16_sum(float v) { v = DPP_ADD(v, 0xB1); v = DPP_ADD(v, 0x4E); v = DPP_ADD(v, 0x141); v = DPP_ADD(v, 0x140); return v; }
#define DPP_MAX(v, ctrl) fmaxf((v), __builtin_bit_cast(float, __builtin_amdgcn_update_dpp(0, __builtin_bit_cast(int, (v)), (ctrl), 0xF, 0xF, true)))
__device__ __forceinline__ float wave_max(float v) {
    v = DPP_MAX(v, 0xB1); v = DPP_MAX(v, 0x4E); v = DPP_MAX(v, 0x141); v = DPP_MAX(v, 0x140); const int iv = __builtin_bit_cast(int, v);
    return fmaxf(fmaxf(__builtin_bit_cast(float, __builtin_amdgcn_readlane(iv, 0)), __builtin_bit_cast(float, __builtin_amdgcn_readlane(iv, 16))),
                 fmaxf(__builtin_bit_cast(float, __builtin_amdgcn_readlane(iv, 32)), __builtin_bit_cast(float, __builtin_amdgcn_readlane(iv, 48))));
}
__device__ __forceinline__ unsigned q4(float a, float b, float c, float d) { return ((unsigned)__float2int_rn(a) & 0xffu) | (((unsigned)__float2int_rn(b) & 0xffu) << 8) | (((unsigned)__float2int_rn(c) & 0xffu) << 16) | ((unsigned)__float2int_rn(d) << 24); }
__device__ __forceinline__ float wave_sum(float v) {
    v = row16_sum(v); const int iv = __builtin_bit_cast(int, v);
    const float a = __builtin_bit_cast(float, __builtin_amdgcn_readlane(iv, 0)), b = __builtin_bit_cast(float, __builtin_amdgcn_readlane(iv, 16)),
                c = __builtin_bit_cast(float, __builtin_amdgcn_readlane(iv, 32)), d = __builtin_bit_cast(float, __builtin_amdgcn_readlane(iv, 48));
    return (a + b) + (c + d);
}
__device__ __forceinline__ void unpack8(const v4u w, float* v) { v[0] = bflo(w.x); v[1] = bfhi(w.x); v[2] = bflo(w.y); v[3] = bfhi(w.y); v[4] = bflo(w.z); v[5] = bfhi(w.z); v[6] = bflo(w.w); v[7] = bfhi(w.w); }
__device__ __forceinline__ v4u pack8f(const float* v) { return (v4u){cvtpk(v[0], v[1]), cvtpk(v[2], v[3]), cvtpk(v[4], v[5]), cvtpk(v[6], v[7])}; }
__device__ __forceinline__ void ln16(float (&v)[16], const float* gam, const float* bet, int lane) {
    float s = 0.f;
#pragma unroll
    for (int j = 0; j < 16; ++j) s += v[j];
    const float mean = wave_sum(s) * (1.f / D); float s2 = 0.f;
#pragma unroll
    for (int j = 0; j < 16; ++j) { v[j] -= mean; s2 += v[j] * v[j]; }
    const float rstd = 1.f / sqrtf(wave_sum(s2) * (1.f / D) + LN_EPS);
#pragma unroll
    for (int h = 0; h < 2; ++h)
#pragma unroll
        for (int q = 0; q < 2; ++q) { const f32x4 g4 = *(const f32x4*)(gam + 512 * h + 8 * lane + 4 * q), b4 = *(const f32x4*)(bet + 512 * h + 8 * lane + 4 * q);
#pragma unroll
            for (int j = 0; j < 4; ++j) v[8 * h + 4 * q + j] = v[8 * h + 4 * q + j] * rstd * g4[j] + b4[j]; }
}

#define XB_TMO      128
#define XB_XCNT(j)  (256  + 64 * (j))
#define XB_XSUB(j)  (1280 + 64 * (j))
#define XB_XGEN(j)  (2304 + 64 * (j))
#define XB_TOP      3328
#define XB_TOPGEN   3392
#define XCD_BAR_WORDS 3456
#define XB_SPIN_CAP (1u << 18)

__device__ __forceinline__ unsigned xb_ld(unsigned* p)              { return __hip_atomic_load(p, __ATOMIC_RELAXED, __HIP_MEMORY_SCOPE_AGENT); }
__device__ __forceinline__ unsigned xb_add(unsigned* p, unsigned v) { return __hip_atomic_fetch_add(p, v, __ATOMIC_RELAXED, __HIP_MEMORY_SCOPE_AGENT); }
__device__ __forceinline__ unsigned xb_xcc_id() { return (unsigned)__builtin_amdgcn_s_getreg((3 << 11) | 20) & 0xFu; }
#define XB_SPIN(cond, bar) do { unsigned _sp = 0; while (cond) { __builtin_amdgcn_s_sleep(1); \
    if ((++_sp & 255u) == 0u) { if (xb_ld(&(bar)[XB_TMO])) break; if (_sp > XB_SPIN_CAP) { atomicAdd(&(bar)[XB_TMO], 1u); break; } } } } while (0)

struct XcdBarrier {
    unsigned* bar; unsigned x;
    volatile LAS unsigned* st;
};

__device__ __forceinline__ XcdBarrier xcd_barrier_post(unsigned* bar, volatile LAS unsigned* st) {
    XcdBarrier b; b.bar = bar; b.x = xb_xcc_id(); b.st = st;
    if (threadIdx.x == 0) (void)xb_add(&bar[XB_XCNT(b.x)], 1u);
    return b;
}
__device__ __forceinline__ void xcd_barrier_complete(unsigned* bar, unsigned x, unsigned& nloc, unsigned& nx) {
    const unsigned G = gridDim.x * gridDim.y * gridDim.z;
    unsigned sum, cnt, mine, sp = 0u;
    for (;;) {
        sum = 0u; cnt = 0u; mine = 0u;
#pragma unroll
        for (unsigned j = 0; j < 16; ++j) { const unsigned c = xb_ld(&bar[XB_XCNT(j)]); sum += c; cnt += (c > 0u) ? 1u : 0u; mine = (j == x) ? c : mine; }
        if (sum == G) break;
        __builtin_amdgcn_s_sleep(1);
        if ((++sp & 255u) == 0u) { if (xb_ld(&bar[XB_TMO])) break; if (sp > XB_SPIN_CAP) { atomicAdd(&bar[XB_TMO], 1u); break; } }
    }
    nloc = mine > 0u ? mine : 1u; nx = cnt > 0u ? cnt : 1u;
}

__device__ __forceinline__ void xcd_barrier(const XcdBarrier& b) {
    asm volatile("s_waitcnt vmcnt(0)" ::: "memory");
    __syncthreads();
    if (threadIdx.x == 0) {
        unsigned* bar = b.bar;
        __builtin_amdgcn_s_waitcnt(0);
        unsigned nloc = b.st[0], nx = b.st[1];
        if (nloc == 0u) { xcd_barrier_complete(bar, b.x, nloc, nx); b.st[0] = nloc; b.st[1] = nx; }
        const unsigned old = xb_add(&bar[XB_XSUB(b.x)], 1u);
        const unsigned gen = old / nloc;
        if (old + 1u == (gen + 1u) * nloc) {
            __builtin_amdgcn_fence(__ATOMIC_RELEASE, "agent");
            asm volatile("s_waitcnt vmcnt(0)" ::: "memory");
            const unsigned og = xb_add(&bar[XB_TOP], 1u);
            const unsigned tg = og / nx;
            if (og + 1u == (tg + 1u) * nx) xb_add(&bar[XB_TOPGEN], 1u);
            else XB_SPIN(xb_ld(&bar[XB_TOPGEN]) == tg, bar);
            __builtin_amdgcn_fence(__ATOMIC_ACQUIRE, "agent");
            xb_add(&bar[XB_XGEN(b.x)], 1u);
            asm volatile("s_waitcnt vmcnt(0)" ::: "memory");
        } else {
            XB_SPIN(xb_ld(&bar[XB_XGEN(b.x)]) == gen, bar);
            __builtin_amdgcn_fence(__ATOMIC_ACQUIRE, "agent");
            asm volatile("s_waitcnt vmcnt(0)" ::: "memory");
        }
    }
    __syncthreads();
}
using pg8::Unit;
struct NoHooks { __device__ __forceinline__ void a_ready(const Unit&) const {} __device__ __forceinline__ void done(const Unit&) const {} };

struct InprojSched : NoHooks {
    int G, c; const char* Hh; const char* Win;
    __device__ __forceinline__ bool next(int i, Unit& u) const {
        const int L = i * G + c; if (L >= 1792) return false;
        if (L < 1664) { pg8::tile_swz(L, 64, 26, u.pm, u.pn); u.ty = 0; u.A = Hh + (size_t)u.pm * 256 * 1024; u.B = Win + (size_t)u.pn * 256 * 1024; }
        else { const int j = L - 1664; u.pm = j & 1; u.pn = j >> 1; u.ty = 1; u.A = Win + (size_t)(NMAIN + 256 * u.pm) * 1024; u.B = Hh + (size_t)u.pn * 256 * 1024; }
        u.aux = 0; u.nv = 0; u.pad = 0; return true;
    }
};
struct EpiInproj {
    static constexpr bool PERM = true;
    bf16* ZC; bf16* G0; bf16* VT; const float* gate_b;
    const float* hs; const float* wsc;
    __device__ __forceinline__ void operator()(const pg8::f32x4 (&acc)[2][2][4][2], const Unit& u, int wr, int wc, int fr, int fq) const {
        int row0 = u.pm * 256 + wr * 64 + fr; asm volatile("" : "+v"(row0));
        const int cl = wc * 32 + 8 * fq;
        const float* rsp = (u.ty == 1) ? wsc + NMAIN : hs; const float* csp = (u.ty == 1) ? hs + u.pn * 256 : wsc + u.pn * 256;
        float rs[2][4]; pg8::f32x4 cs[2][2];
#pragma unroll
        for (int ai = 0; ai < 2; ++ai)
#pragma unroll
            for (int m = 0; m < 4; ++m) rs[ai][m] = rsp[row0 + ai * 128 + m * 16];
#pragma unroll
        for (int bj = 0; bj < 2; ++bj)
#pragma unroll
            for (int n = 0; n < 2; ++n) cs[bj][n] = *(const pg8::f32x4*)(csp + bj * 128 + cl + 4 * n);
#define ACCV(ai, bj, m, n) (__builtin_convertvector(__builtin_bit_cast(pg8::i32x4, acc[ai][bj][m][n]), pg8::f32x4) * (cs[bj][n] * rs[ai][m]))
        if (u.ty == 0 && u.pn >= 10 && u.pn < 14) {
            bf16* base = ZC + (size_t)5 * HTOK * 512; const int col0 = (u.pn - 10) * 128 + cl;
#pragma unroll
            for (int ai = 0; ai < 2; ++ai)
#pragma unroll
                for (int m = 0; m < 4; ++m) { const pg8::f32x4 v0 = ACCV(ai, 0, m, 0) * ACCV(ai, 1, m, 0), v1 = ACCV(ai, 0, m, 1) * ACCV(ai, 1, m, 1);
                    v4u w; w.x = cvtpk(v0[0], v0[1]); w.y = cvtpk(v0[2], v0[3]); w.z = cvtpk(v1[0], v1[1]); w.w = cvtpk(v1[2], v1[3]);
                    *(v4u*)(base + (size_t)(row0 + ai * 128 + m * 16) * 512 + col0) = w; }
            return;
        }
        if (u.ty == 0 && u.pn >= 14) {
            const int b = (u.pn - 14) >> 2, col0 = ((u.pn - 14) & 3) * 256 + cl; unsigned char* base = (unsigned char*)G0 + (size_t)b * HTOK * 1024; const float* gb = gate_b + b * 1024 + col0;
            pg8::f32x4 bv[2][2];
#pragma unroll
            for (int bj = 0; bj < 2; ++bj)
#pragma unroll
                for (int n = 0; n < 2; ++n) bv[bj][n] = *(const pg8::f32x4*)(gb + bj * 128 + 4 * n);
#pragma unroll
            for (int ai = 0; ai < 2; ++ai)
#pragma unroll
                for (int m = 0; m < 4; ++m) { unsigned char* rowp = base + (size_t)(row0 + ai * 128 + m * 16) * 1024 + col0;
#pragma unroll
                    for (int bj = 0; bj < 2; ++bj) { pg8::f32x4 v0 = ACCV(ai, bj, m, 0) + bv[bj][0], v1 = ACCV(ai, bj, m, 1) + bv[bj][1];
#pragma unroll
                        for (int j = 0; j < 4; ++j) { v0[j] = 255.f * sigmoidf_(v0[j]); v1[j] = 255.f * sigmoidf_(v1[j]); }
                        unsigned w0 = 0u, w1 = 0u;
#pragma unroll
                        for (int j = 0; j < 4; ++j) { w0 = __builtin_amdgcn_cvt_pk_u8_f32(v0[j], j, w0); w1 = __builtin_amdgcn_cvt_pk_u8_f32(v1[j], j, w1); }
                        *(v2u*)(rowp + bj * 128) = (v2u){w0, w1}; } }
            return;
        }
        float sc = 1.f; const int t = u.pn >> 1;
        if (u.ty == 0 && t == 0) sc = C2;
#pragma unroll
        for (int ai = 0; ai < 2; ++ai)
#pragma unroll
            for (int m = 0; m < 4; ++m) { const int row = row0 + ai * 128 + m * 16;
#pragma unroll
                for (int bj = 0; bj < 2; ++bj) { const pg8::f32x4 v0 = ACCV(ai, bj, m, 0) * sc, v1 = ACCV(ai, bj, m, 1) * sc;
                    v4u w; w.x = cvtpk(v0[0], v0[1]); w.y = cvtpk(v0[2], v0[3]); w.z = cvtpk(v1[0], v1[1]); w.w = cvtpk(v1[2], v1[3]);
                    bf16* p;
                    if (u.ty == 1) { const int tok = u.pn * 256 + bj * 128 + cl; p = VT + ((size_t)(row >> 6) * 256 + (tok >> 6)) * 4096 + (row & 63) * 64 + (tok & 63); }
                    else { const int col = (u.pn & 1) * 256 + bj * 128 + cl;
                        if (t == 1) p = ZC + (size_t)HTOK * 512 + ((size_t)(col >> 6) * HTOK + row) * 64 + (col & 63);
                        else p = ZC + (size_t)t * HTOK * 512 + (size_t)row * 512 + col; }
                    *(v4u*)p = w; } }
#undef ACCV
    }
};

struct BranchSched : NoHooks {
    int G, c; const char* Y; const char* WBR;
    __device__ __forceinline__ bool next(int i, Unit& u) const {
        const int tile = (i / 3) * G + c, b = i % 3; if (tile >= 256) return false;
        pg8::tile_swz(tile, 64, 4, u.pm, u.pn); u.ty = b; u.aux = 0; u.nv = 0; u.pad = 0;
        u.A = Y + ((size_t)u.pm * 256 * 1536 + b * 512) * 2; u.B = WBR + ((size_t)u.pn * 256 * 1536 + b * 512) * 2; return true;
    }
};
struct EpiBranch {
    static constexpr bool PERM = true;
    const unsigned char* G0; bf16* MRG;
    __device__ __forceinline__ void operator()(const pg8::f32x4 (&acc)[2][2][4][2], const Unit& u, int wr, int wc, int fr, int fq) const {
        int row0 = u.pm * 256 + wr * 64 + fr; asm volatile("" : "+v"(row0)); const int col0 = u.pn * 256 + wc * 32 + 8 * fq; const unsigned char* gp = G0 + (size_t)u.ty * HTOK * 1024;
        constexpr float I255 = 1.f / 255.f;
#pragma unroll
        for (int ai = 0; ai < 2; ++ai)
#pragma unroll
            for (int m = 0; m < 4; ++m) { const size_t off = (size_t)(row0 + ai * 128 + m * 16) * 1024 + col0;
#pragma unroll
                for (int bj = 0; bj < 2; ++bj) { const v2u gw = *(const v2u*)(gp + off + bj * 128); v4u ow = (v4u){0u, 0u, 0u, 0u}; if (u.ty != 0) ow = *(const v4u*)(MRG + off + bj * 128);
                    const pg8::f32x4 a0 = acc[ai][bj][m][0] * I255, a1 = acc[ai][bj][m][1] * I255; v4u w;
                    w.x = cvtpk(bflo(ow.x) + (float)(gw.x & 0xffu) * a0[0], bfhi(ow.x) + (float)((gw.x >> 8) & 0xffu) * a0[1]); w.y = cvtpk(bflo(ow.y) + (float)((gw.x >> 16) & 0xffu) * a0[2], bfhi(ow.y) + (float)(gw.x >> 24) * a0[3]);
                    w.z = cvtpk(bflo(ow.z) + (float)(gw.y & 0xffu) * a1[0], bfhi(ow.z) + (float)((gw.y >> 8) & 0xffu) * a1[1]); w.w = cvtpk(bflo(ow.w) + (float)((gw.y >> 16) & 0xffu) * a1[2], bfhi(ow.w) + (float)(gw.y >> 24) * a1[3]);
                    *(v4u*)(MRG + off + bj * 128) = w; }
                if (m & 1) asm volatile("" ::: "memory"); }
    }
};

struct PlainSched : NoHooks {
    int G, c, nM, nN; const char* A; const char* B; size_t astep, bstep;
    __device__ __forceinline__ bool next(int i, Unit& u) const {
        const int L = i * G + c; if (L >= nM * nN) return false;
        pg8::tile_swz(L, nM, nN, u.pm, u.pn); u.ty = 0; u.aux = 0; u.nv = 0; u.pad = 0; u.A = A + (size_t)u.pm * astep; u.B = B + (size_t)u.pn * bstep; return true;
    }
};
struct EpiOutproj {
    static constexpr bool PERM = true;
    bf16* Hh;
    __device__ __forceinline__ void operator()(const pg8::f32x4 (&acc)[2][2][4][2], const Unit& u, int wr, int wc, int fr, int fq) const {
        int row0 = u.pm * 256 + wr * 64 + fr; asm volatile("" : "+v"(row0)); const int col0 = u.pn * 256 + wc * 32 + 8 * fq;
#pragma unroll
        for (int ai = 0; ai < 2; ++ai)
#pragma unroll
            for (int m = 0; m < 4; ++m) { bf16* rowp = Hh + (size_t)(row0 + ai * 128 + m * 16) * 1024 + col0;
#pragma unroll
                for (int bj = 0; bj < 2; ++bj) { const v4u ow = *(const v4u*)(rowp + bj * 128); const pg8::f32x4 a0 = acc[ai][bj][m][0], a1 = acc[ai][bj][m][1]; v4u w;
                    w.x = cvtpk(ALPHA * bflo(ow.x) + a0[0], ALPHA * bfhi(ow.x) + a0[1]); w.y = cvtpk(ALPHA * bflo(ow.y) + a0[2], ALPHA * bfhi(ow.y) + a0[3]);
                    w.z = cvtpk(ALPHA * bflo(ow.z) + a1[0], ALPHA * bfhi(ow.z) + a1[1]); w.w = cvtpk(ALPHA * bflo(ow.w) + a1[2], ALPHA * bfhi(ow.w) + a1[3]);
                    *(v4u*)(rowp + bj * 128) = w; }
                if (m == 3) asm volatile("" ::: "memory"); }
    }
};

struct MoeSched : NoHooks {
    int G, c; const LAS int* tab; const char* Abase; size_t atile; const char* Wbase; size_t wstride, bstep; const unsigned* list;
    __device__ __forceinline__ bool next(int i, Unit& u) const {
        const int L = i * G + c, NT = tab[16]; if (L >= NT * 4) return false;
        const int rt = L >> 2; int e = 0;
#pragma unroll 1
        while (e < 15 && rt >= tab[e + 1]) ++e;
        const int j = rt - tab[e];
        u.pm = rt; u.pn = L & 3; u.ty = e; u.aux = e * LISTCAP + j * 256; u.nv = tab[17 + e] - j * 256; u.pad = 0;
        u.A = Abase + (size_t)rt * atile; u.B = Wbase + (size_t)e * wstride + (size_t)u.pn * bstep; return true;
    }
    __device__ __forceinline__ int arow(const Unit& u, int r) const { return r < u.nv ? (int)(list[u.aux + r] >> 1) : 0; }
};
struct EpiGateUp {
    static constexpr bool PERM = true;
    bf16* HB; const float* lsc; const float* wsc;
    __device__ __forceinline__ void operator()(const pg8::f32x4 (&acc)[2][2][4][2], const Unit& u, int wr, int wc, int fr, int fq) const {
        int row0 = u.pm * 256 + wr * 64 + fr; asm volatile("" : "+v"(row0)); const int col0 = u.pn * 128 + wc * 32 + 8 * fq, r0 = wr * 64 + fr;
        const float* csp = wsc + u.ty * 1024 + u.pn * 256 + wc * 32 + 8 * fq;
        pg8::f32x4 cs[2][2];
#pragma unroll
        for (int bj = 0; bj < 2; ++bj)
#pragma unroll
            for (int n = 0; n < 2; ++n) cs[bj][n] = *(const pg8::f32x4*)(csp + bj * 128 + 4 * n);
#pragma unroll
        for (int ai = 0; ai < 2; ++ai)
#pragma unroll
            for (int m = 0; m < 4; ++m) { const int r = r0 + ai * 128 + m * 16; const float rs = lsc[u.aux + (r < u.nv ? r : 0)]; pg8::f32x4 v0, v1;
                const pg8::f32x4 g0 = __builtin_convertvector(__builtin_bit_cast(pg8::i32x4, acc[ai][0][m][0]), pg8::f32x4) * (cs[0][0] * rs), g1 = __builtin_convertvector(__builtin_bit_cast(pg8::i32x4, acc[ai][0][m][1]), pg8::f32x4) * (cs[0][1] * rs);
                const pg8::f32x4 u0 = __builtin_convertvector(__builtin_bit_cast(pg8::i32x4, acc[ai][1][m][0]), pg8::f32x4) * (cs[1][0] * rs), u1 = __builtin_convertvector(__builtin_bit_cast(pg8::i32x4, acc[ai][1][m][1]), pg8::f32x4) * (cs[1][1] * rs);
#pragma unroll
                for (int j = 0; j < 4; ++j) { v0[j] = g0[j] * sigmoidf_(g0[j]) * u0[j]; v1[j] = g1[j] * sigmoidf_(g1[j]) * u1[j]; }
                v4u w; w.x = cvtpk(v0[0], v0[1]); w.y = cvtpk(v0[2], v0[3]); w.z = cvtpk(v1[0], v1[1]); w.w = cvtpk(v1[2], v1[3]);
                *(v4u*)(HB + (size_t)(row0 + ai * 128 + m * 16) * 512 + col0) = w; }
    }
};
struct EpiDown {
    static constexpr bool PERM = true;
    bf16* FFN; const unsigned* list;
    __device__ __forceinline__ void operator()(const pg8::f32x4 (&acc)[2][2][4][2], const Unit& u, int wr, int wc, int fr, int fq) const {
        int r0 = wr * 64 + fr; asm volatile("" : "+v"(r0)); const int col0 = u.pn * 256 + wc * 32 + 8 * fq;
#pragma unroll
        for (int ai = 0; ai < 2; ++ai)
#pragma unroll
            for (int m = 0; m < 4; ++m) { const int r = r0 + ai * 128 + m * 16;
                if (r < u.nv) { const unsigned ent = list[u.aux + r]; bf16* rowp = FFN + ((size_t)(ent & 1u) * NTOK + (ent >> 1)) * 1024 + col0;
#pragma unroll
                    for (int bj = 0; bj < 2; ++bj) { const pg8::f32x4 v0 = acc[ai][bj][m][0], v1 = acc[ai][bj][m][1];
                        v4u w; w.x = cvtpk(v0[0], v0[1]); w.y = cvtpk(v0[2], v0[3]); w.z = cvtpk(v1[0], v1[1]); w.w = cvtpk(v1[2], v1[3]);
                        *(v4u*)(rowp + bj * 128) = w; } } }
    }
};

__device__ __forceinline__ void tr_item(const float* W, int N, int k0, int n0, bf16* dst, size_t drow0, int dpitch, int dk0, LAS float* scr, int lane) {
#pragma unroll 8
    for (int i = 0; i < 32; ++i) { const int kk = 2 * i + (lane >> 5); scr[kk * 33 + (lane & 31)] = W[(size_t)(k0 + kk) * N + n0 + (lane & 31)]; }
    LDS_WAIT(); asm volatile("" ::: "memory");
    const int c = lane & 7;
#pragma unroll
    for (int j = 0; j < 4; ++j) { const int n = (lane >> 3) + 8 * j; const LAS float* s = scr + (8 * c) * 33 + n;
        v4u o; o.x = pk2(s[0 * 33], s[1 * 33]); o.y = pk2(s[2 * 33], s[3 * 33]); o.z = pk2(s[4 * 33], s[5 * 33]); o.w = pk2(s[6 * 33], s[7 * 33]);
        *(v4u*)(dst + (drow0 + n) * (size_t)dpitch + dk0 + k0 + 8 * c) = o; }
    LDS_WAIT(); asm volatile("" ::: "memory");
}
__device__ __forceinline__ int map_in(int n0) {
    if (n0 < 1024) return n0;
    if (n0 < 1536) return NMAIN + (n0 - 1024);
    if (n0 < 3072) return n0 - 512;
    if (n0 < 3584) { const int c = n0 - 3072; return 2560 + (c >> 7) * 256 + (c & 127); }
    if (n0 < 4096) { const int c = n0 - 3584; return 2560 + (c >> 7) * 256 + 128 + (c & 127); }
    return n0 - 512;
}
struct Args { const float* in[28]; float* out; unsigned char* ws; };
typedef const __attribute__((address_space(4))) unsigned long long* KP;
struct KA { KP kp;
    __device__ __forceinline__ const float* in(int k) const { return (const float*)(const GAS float*)kp[k]; }
    __device__ __forceinline__ float* out() const { return (float*)(GAS float*)kp[28]; }
    __device__ __forceinline__ unsigned char* ws() const { return (unsigned char*)(GAS unsigned char*)kp[29]; } };

__device__ __forceinline__ void win_item_wg(const float* W, int N, int n0, signed char* dst, float* scale_out, size_t drow0, LAS unsigned char* lds, int tid) {
    LAS float* T = (LAS float*)lds;
    LAS float* MX = (LAS float*)(lds + LDSCTL_OFF + 4096);
    { const float* wp = W + (size_t)(tid >> 3) * N + n0 + 4 * (tid & 7); f32x4 v[16];
#pragma unroll
      for (int i = 0; i < 16; ++i) v[i] = *(const f32x4*)(wp + (size_t)(64 * i) * N);
#pragma unroll
      for (int i = 0; i < 16; ++i) *(LAS f32x4*)(T + ((tid >> 3) + 64 * i) * 32 + 4 * (tid & 7)) = v[i]; }
    __syncthreads();
    const int c = tid & 31, s = tid >> 5;
    { float m = 0.f;
#pragma unroll 16
      for (int k = 0; k < 64; ++k) m = fmaxf(m, fabsf(T[(s * 64 + k) * 32 + c]));
      MX[s * 32 + c] = m; }
    __syncthreads();
    float m = 1e-30f;
#pragma unroll
    for (int w = 0; w < 16; ++w) m = fmaxf(m, MX[w * 32 + c]);
    const float inv = 127.f / m;
    if (tid < 32) scale_out[drow0 + c] = m * (1.f / 127.f);
#pragma unroll
    for (int j = 0; j < 4; ++j) { const int p = s + 16 * j; const LAS float* tp = T + (16 * p) * 32 + c; unsigned w[4];
#pragma unroll
        for (int q = 0; q < 4; ++q) w[q] = q4(tp[(4 * q) * 32] * inv, tp[(4 * q + 1) * 32] * inv, tp[(4 * q + 2) * 32] * inv, tp[(4 * q + 3) * 32] * inv);
        *(v4u*)(dst + (drow0 + c) * (size_t)1024 + 16 * p) = (v4u){w[0], w[1], w[2], w[3]}; }
    __syncthreads();
}
__device__ __forceinline__ float quant_row16(const float (&v)[16], signed char* qrow, float* srow, int c0a, int c0b, int lane) {
    float m = 0.f;
#pragma unroll
    for (int j = 0; j < 16; ++j) m = fmaxf(m, fabsf(v[j]));
    m = fmaxf(wave_max(m), 1e-30f); const float inv = 127.f / m;
    *(v2u*)(qrow + c0a) = (v2u){q4(v[0] * inv, v[1] * inv, v[2] * inv, v[3] * inv), q4(v[4] * inv, v[5] * inv, v[6] * inv, v[7] * inv)};
    *(v2u*)(qrow + c0b) = (v2u){q4(v[8] * inv, v[9] * inv, v[10] * inv, v[11] * inv), q4(v[12] * inv, v[13] * inv, v[14] * inv, v[15] * inv)};
    if (lane == 0) *srow = m * (1.f / 127.f);
    return m * (1.f / 127.f);
}
__device__ __forceinline__ void p0_prologue(const KA& a, LAS unsigned char* lds, int gw, int NGW, int wave, int lane) {
    LAS float* scr = (LAS float*)(lds + wave * 16384);
    unsigned char* ws = a.ws();
    for (int it = blockIdx.x; it < DEPTH * 224; it += gridDim.x) { const int l = it / 224, r = it % 224;
        win_item_wg(a.in(3) + (size_t)l * 1024 * PROJ, PROJ, 32 * r, (signed char*)(ws + WS_WIN) + (size_t)l * PROJ * 1024, (float*)(ws + WS_CTL) + CW_WS + l * PROJ, (size_t)map_in(32 * r), lds, threadIdx.x); }
    for (int it = blockIdx.x; it < DEPTH * NEXP * 2 * 16; it += gridDim.x) { const int le = it >> 5, up = (it >> 4) & 1, n0 = (it & 15) * 32;
        win_item_wg(a.in(23 + up) + (size_t)le * 1024 * 512, 512, n0, (signed char*)(ws + WS_WGU) + (size_t)le * 1024 * 1024, (float*)(ws + WS_WGUS) + (size_t)le * 1024, (size_t)((n0 >> 7) * 256 + up * 128 + (n0 & 127)), lds, threadIdx.x); }
    constexpr int I_IN = 0, I_BR = 8 * 32, I_OUT = 16 * 32, I_G = 16 * 16, I_DN = 8 * 32;
    constexpr int PER_LAYER = I_IN + 3 * I_BR + I_OUT + 16 * I_DN + 32;
    for (int it = gw; it < DEPTH * PER_LAYER; it += NGW) {
        const int l = it / PER_LAYER; int r = it % PER_LAYER;
        if (r < 3 * I_BR) { const int b = r / I_BR, q = r % I_BR, kb = q / 32, nb = q % 32; tr_item(a.in(13 + b) + (size_t)l * 512 * 1024, 1024, 64 * kb, 32 * nb, (bf16*)(ws + WS_WBR) + (size_t)l * 1024 * 1536, (size_t)(32 * nb), 1536, b * 512, scr, lane); continue; } r -= 3 * I_BR;
        if (r < I_OUT) { const int kb = r / 32, nb = r % 32; tr_item(a.in(16) + (size_t)l * 1024 * 1024, 1024, 64 * kb, 32 * nb, (bf16*)(ws + WS_WOUT) + (size_t)l * 1024 * 1024, (size_t)(32 * nb), 1024, 0, scr, lane); continue; } r -= I_OUT;
        if (r < 16 * I_DN) { const int e = r / I_DN, q = r % I_DN, kb = q / 32, nb = q % 32; tr_item(a.in(25) + ((size_t)l * NEXP + e) * 512 * 1024, 1024, 64 * kb, 32 * nb, (bf16*)(ws + WS_WDN) + ((size_t)l * NEXP + e) * 1024 * 512, (size_t)(32 * nb), 512, 0, scr, lane);
            continue; } r -= 16 * I_DN;
        { const int gsel = r / 16, hd = (r % 16) / 2, nb = r % 2;
          tr_item(a.in(gsel ? 9 : 7) + ((size_t)l * 8 + hd) * 4096, 64, 0, 32 * nb, (bf16*)(ws + WS_LRUW) + (((size_t)l * 2 + gsel) * 8 + hd) * 4096, (size_t)(32 * nb), 64, 0, scr, lane); }
    }
    const float* gam = a.in(1); const float* bet = a.in(2); bf16* H = (bf16*)(ws + WS_H); signed char* HQ = (signed char*)(ws + WS_HQ); float* HS = (float*)(ws + WS_HS);
    for (int m = gw; m < NTOK; m += NGW) {
        const float* xr = a.in(0) + (size_t)m * D; float v[16];
#pragma unroll
        for (int h = 0; h < 2; ++h) { const f32x4 x0 = *(const f32x4*)(xr + 512 * h + 8 * lane), x1 = *(const f32x4*)(xr + 512 * h + 8 * lane + 4);
            v[8 * h] = x0.x; v[8 * h + 1] = x0.y; v[8 * h + 2] = x0.z; v[8 * h + 3] = x0.w; v[8 * h + 4] = x1.x; v[8 * h + 5] = x1.y; v[8 * h + 6] = x1.z; v[8 * h + 7] = x1.w; }
        ln16(v, gam, bet, lane);
        bf16* hp = H + (size_t)m * D; *(v4u*)(hp + 8 * lane) = pack8f(v); *(v4u*)(hp + 512 + 8 * lane) = pack8f(v + 8);
        quant_row16(v, HQ + (size_t)m * D, HS + m, 8 * lane, 512 + 8 * lane, lane);
    }
}

#define MFMA32(a, b, c) __builtin_amdgcn_mfma_f32_32x32x16_bf16((a), (b), (c), 0, 0, 0)
__device__ __forceinline__ int crow(int r, int hi) { return (r & 3) + 8 * (r >> 2) + 4 * hi; }
__device__ __forceinline__ bf16x8 pack8(const f32x16& x, int s) {
    v4u p; p.x = cvtpk(x[8 * s], x[8 * s + 1]); p.y = cvtpk(x[8 * s + 2], x[8 * s + 3]); p.z = cvtpk(x[8 * s + 4], x[8 * s + 5]); p.w = cvtpk(x[8 * s + 6], x[8 * s + 7]);
    return __builtin_bit_cast(bf16x8, p);
}
__device__ __forceinline__ float softplus2(float z) { return fmaxf(z, 0.f) + flog2(1.f + fexp2(-fabsf(z))); }

template <bool DIAG>
__device__ __forceinline__ bool sb_tile(const LAS unsigned char* kt_lds, const bf16x8 (&qf)[4], const bf16x8 (&tri)[2], bf16x8 mones,
                                        f32x16& o0, f32x16& o1, float& carry, int k0, int t0, int l32, int hi) {
    const int x = l32 & 7; const LAS unsigned char* krow = kt_lds + l32 * 128; const LAS unsigned char* vrow = kt_lds + 8192 + l32 * 128 + 8 * hi;
    f32x16 s0, s1;
#pragma unroll
    for (int r = 0; r < 16; ++r) { s0[r] = 0.f; s1[r] = 0.f; }
#pragma unroll
    for (int i = 0; i < 4; ++i) { const int po = ((2 * i + hi) ^ x) * 16;
        const bf16x8 ka = *(const LAS bf16x8*)(krow + po), kb = *(const LAS bf16x8*)(krow + 32 * 128 + po);
        s0 = MFMA32(ka, qf[i], s0); s1 = MFMA32(kb, qf[i], s1); }
    const float z00 = s0[0];
    v4u L[4];
#pragma unroll
    for (int f = 0; f < 2; ++f)
#pragma unroll
        for (int i = 0; i < 4; ++i) { const int r = 8 * f + 2 * i;
            float a0 = softplus2(s0[r]), a1 = softplus2(s0[r + 1]), b0 = softplus2(s1[r]), b1 = softplus2(s1[r + 1]);
            if (DIAG) { const int q = t0 + l32, ka = k0 + crow(r, hi), kb = k0 + crow(r + 1, hi); if (ka >= q) a0 = 0.f; if (kb >= q) a1 = 0.f; if (ka + 32 >= q) b0 = 0.f; if (kb + 32 >= q) b1 = 0.f; }
            L[f][i] = cvtpk(a0, a1); L[2 + f][i] = cvtpk(b0, b1); }
#pragma unroll
    for (int r = 0; r < 16; ++r) { s0[r] -= carry; s1[r] -= carry; }
    s0 = MFMA32(tri[0], __builtin_bit_cast(bf16x8, L[0]), s0); s0 = MFMA32(tri[1], __builtin_bit_cast(bf16x8, L[1]), s0); s0 = MFMA32(mones, __builtin_bit_cast(bf16x8, L[2]), s0); s0 = MFMA32(mones, __builtin_bit_cast(bf16x8, L[3]), s0);
    s1 = MFMA32(tri[0], __builtin_bit_cast(bf16x8, L[2]), s1); s1 = MFMA32(tri[1], __builtin_bit_cast(bf16x8, L[3]), s1);
    float tot = (z00 - carry) - s0[0];
    tot = __shfl(tot, l32);
    v4u P[4];
#pragma unroll
    for (int f = 0; f < 2; ++f)
#pragma unroll
        for (int i = 0; i < 4; ++i) { const int r = 8 * f + 2 * i;
            float a0 = fexp2(s0[r]), a1 = fexp2(s0[r + 1]), b0 = fexp2(s1[r]), b1 = fexp2(s1[r + 1]);
            if (DIAG) { const int q = t0 + l32, ka = k0 + crow(r, hi), kb = k0 + crow(r + 1, hi); if (ka >= q) a0 = 0.f; if (kb >= q) a1 = 0.f; if (ka + 32 >= q) b0 = 0.f; if (kb + 32 >= q) b1 = 0.f; }
            P[f][i] = cvtpk(a0, a1); P[2 + f][i] = cvtpk(b0, b1); }
    carry += tot;
#pragma unroll
    for (int db = 0; db < 2; ++db) {
        f32x16 o = db ? o1 : o0;
#pragma unroll
        for (int s = 0; s < 4; ++s) { const v2u lo = *(const LAS v2u*)(vrow + db * 32 * 128 + (((2 * s) ^ x) * 16)), hi8 = *(const LAS v2u*)(vrow + db * 32 * 128 + (((2 * s + 1) ^ x) * 16));
            o = MFMA32(__builtin_bit_cast(bf16x8, (v4u){lo.x, lo.y, hi8.x, hi8.y}), __builtin_bit_cast(bf16x8, P[s]), o); }
        if (db) o1 = o; else o0 = o;
    }
    return __all(carry > 150.f) != 0;
}
__device__ __forceinline__ void sb_attn_wg(const bf16* __restrict__ Q, const bf16* __restrict__ Kh, const bf16* __restrict__ VT, bf16* Y, LAS unsigned char* lds, int b, int hd, int qg, int wave, int lane) {
    const int l32 = lane & 31, hi = lane >> 5, seq0 = b * SEQ, T0 = qg * 256, t0 = T0 + 32 * wave, ktd = t0 >> 6, B = T0 >> 6;
    LAS int* FL = (LAS int*)(lds + LDSCTL_OFF + 2048);
    const int koff = (wave * 8 + (lane >> 3)) * 64 + (((lane & 7) ^ ((lane >> 3) & 7)) * 8);
    const bf16* ksrc = Kh + ((size_t)hd * HTOK + seq0) * 64 + koff; const bf16* vsrc = VT + ((size_t)hd * 256 + (seq0 >> 6)) * 4096 + koff;
#define SB_STAGE(kt) do { const unsigned so_ = (unsigned)(((kt) & 7) * 16384 + wave * 1024); \
        __builtin_amdgcn_global_load_lds((const unsigned*)(ksrc + (size_t)(kt) * 4096), (LAS unsigned*)(lds + so_), 16, 0, 0); \
        __builtin_amdgcn_global_load_lds((const unsigned*)(vsrc + (size_t)(kt) * 4096), (LAS unsigned*)(lds + so_ + 8192), 16, 0, 0); } while (0)
#pragma unroll
    for (int i = 0; i < 4; ++i) SB_STAGE(B + i);
    bf16x8 qf[4];
    { const bf16* qp = Q + (size_t)(seq0 + t0 + l32) * 512 + hd * 64 + 8 * hi;
#pragma unroll
      for (int i = 0; i < 4; ++i) qf[i] = *(const bf16x8*)(qp + 16 * i); }
    bf16x8 tri[2], mones;
#pragma unroll
    for (int i2 = 0; i2 < 2; ++i2)
#pragma unroll
        for (int j = 0; j < 8; ++j) { const int ko = 16 * i2 + 8 * (j >> 2) + 4 * hi + (j & 3); tri[i2][j] = (ko >= l32) ? (short)0xBF80 : (short)0; }
#pragma unroll
    for (int j = 0; j < 8; ++j) mones[j] = (short)0xBF80;
    f32x16 o0, o1;
#pragma unroll
    for (int r = 0; r < 16; ++r) { o0[r] = 0.f; o1[r] = 0.f; }
    float carry = 0.f; bool done = false;
    if (lane == 0) FL[wave] = 0;
#pragma unroll 1
    for (int j = 0; ; ++j) {
        asm volatile("s_waitcnt vmcnt(0)" ::: "memory");
        __syncthreads();
        const pg8::u32x4 f0 = *(const LAS pg8::u32x4*)(FL + (j & 1) * 8), f1 = *(const LAS pg8::u32x4*)(FL + (j & 1) * 8 + 4);
        if ((f0.x & f0.y & f0.z & f0.w & f1.x & f1.y & f1.z & f1.w) != 0u) break;
        if (B - j - 1 >= 0) SB_STAGE(B - j - 1);
        const int kt = ktd - j;
        if (!done) {
            if (kt < 0) done = true;
            else { const LAS unsigned char* tl = lds + (kt & 7) * 16384;
                if (j == 0) done = sb_tile<true>(tl, qf, tri, mones, o0, o1, carry, kt * 64, t0, l32, hi);
                else done = sb_tile<false>(tl, qf, tri, mones, o0, o1, carry, kt * 64, t0, l32, hi);
                if (kt == 0) done = true; }
        }
        if (lane == 0) FL[((j + 1) & 1) * 8 + wave] = done ? 1 : 0;
    }
#undef SB_STAGE
    bf16* yp = Y + (size_t)(seq0 + t0 + l32) * 1536 + hd * 64 + 4 * hi;
#pragma unroll
    for (int g = 0; g < 4; ++g) {
        *(v2u*)(yp + 8 * g) = (v2u){cvtpk(o0[4 * g], o0[4 * g + 1]), cvtpk(o0[4 * g + 2], o0[4 * g + 3])};
        *(v2u*)(yp + 32 + 8 * g) = (v2u){cvtpk(o1[4 * g], o1[4 * g + 1]), cvtpk(o1[4 * g + 2], o1[4 * g + 3])};
    }
    __syncthreads();
}

__device__ __forceinline__ void lru_local_task(const KA& a, int l, const bf16* __restrict__ LI, bf16* HLOC, bf16* CUMA, float* SUMA, float* SUMH, const bf16* __restrict__ LW,
                                               LAS bf16* U, int b, int ch, int hd, int lane) {
    const int seq0 = b * SEQ, t0 = ch * 64;
    { const int co = lane & 7, sub = lane >> 3, c0 = hd * 64 + co * 8;
      const float* cw = a.in(5) + (size_t)l * 4 * 512 + c0; const float* cb = a.in(6) + (size_t)l * 512 + c0;
      float w[4][8], bias[8];
#pragma unroll
      for (int k = 0; k < 4; ++k) { const f32x4 x0 = *(const f32x4*)(cw + k * 512), x1 = *(const f32x4*)(cw + k * 512 + 4);
          w[k][0] = x0.x; w[k][1] = x0.y; w[k][2] = x0.z; w[k][3] = x0.w; w[k][4] = x1.x; w[k][5] = x1.y; w[k][6] = x1.z; w[k][7] = x1.w; }
      { const f32x4 x0 = *(const f32x4*)(cb), x1 = *(const f32x4*)(cb + 4); bias[0] = x0.x; bias[1] = x0.y; bias[2] = x0.z; bias[3] = x0.w; bias[4] = x1.x; bias[5] = x1.y; bias[6] = x1.z; bias[7] = x1.w; }
#pragma unroll 2
      for (int it = 0; it < 8; ++it) { const int tl = it * 8 + sub, t = t0 + tl; float u[8];
#pragma unroll
          for (int j = 0; j < 8; ++j) u[j] = bias[j];
#pragma unroll
          for (int k = 0; k < 4; ++k) { const int tt = t - 3 + k; if (tt >= 0) { const v4u x = *(const v4u*)(LI + (size_t)(seq0 + tt) * 512 + c0);
              u[0] += w[k][0] * bflo(x.x); u[1] += w[k][1] * bfhi(x.x); u[2] += w[k][2] * bflo(x.y); u[3] += w[k][3] * bfhi(x.y);
              u[4] += w[k][4] * bflo(x.z); u[5] += w[k][5] * bfhi(x.z); u[6] += w[k][6] * bflo(x.w); u[7] += w[k][7] * bfhi(x.w); } }
          *(LAS v4u*)(U + tl * 72 + co * 8) = (v4u){pk2(u[0], u[1]), pk2(u[2], u[3]), pk2(u[4], u[5]), pk2(u[6], u[7])}; }
      LDS_WAIT(); asm volatile("" ::: "memory"); }
    const int l32 = lane & 31, hi = lane >> 5;
    bf16x8 af[2][4];
#pragma unroll
    for (int mb = 0; mb < 2; ++mb)
#pragma unroll
        for (int ks = 0; ks < 4; ++ks) af[mb][ks] = *(const LAS bf16x8*)(U + (mb * 32 + l32) * 72 + 16 * ks + 8 * hi);
    float Hrun = 0.f, Arun = 1.f;
#pragma unroll 1
    for (int nb = 0; nb < 2; ++nb) {
        const int chn = hd * 64 + nb * 32 + l32;
        const bf16* wa = LW + ((size_t)(l * 2 + 0) * 8 + hd) * 4096 + (nb * 32 + l32) * 64 + 8 * hi;
        const bf16* wx = LW + ((size_t)(l * 2 + 1) * 8 + hd) * 4096 + (nb * 32 + l32) * 64 + 8 * hi;
        f32x16 da[2], dx[2];
#pragma unroll
        for (int mb = 0; mb < 2; ++mb)
#pragma unroll
            for (int r = 0; r < 16; ++r) { da[mb][r] = 0.f; dx[mb][r] = 0.f; }
#pragma unroll
        for (int ks = 0; ks < 4; ++ks) { const bf16x8 ba = *(const bf16x8*)(wa + 16 * ks), bx = *(const bf16x8*)(wx + 16 * ks);
#pragma unroll
            for (int mb = 0; mb < 2; ++mb) { da[mb] = MFMA32(af[mb][ks], ba, da[mb]); dx[mb] = MFMA32(af[mb][ks], bx, dx[mb]); } }
        const float b_a = a.in(8)[l * 512 + chn], b_x = a.in(10)[l * 512 + chn], lam = a.in(11)[l * 512 + chn];
        const float c8 = -8.f * (fmaxf(-lam, 0.f) + log1pf(__expf(-fabsf(lam)))) * LOG2E;
        Hrun = 0.f; Arun = 1.f;
#pragma unroll
        for (int mb = 0; mb < 2; ++mb) {
            float hl[16], cA[16], gA[4], gB[4];
#pragma unroll
            for (int g = 0; g < 4; ++g) { float h = 0.f, A = 1.f;
#pragma unroll
                for (int j = 0; j < 4; ++j) { const int r = 4 * g + j, tl = mb * 32 + crow(r, hi);
                    const float ra = sigmoidf_(da[mb][r] + b_a), ix = sigmoidf_(dx[mb][r] + b_x);
                    const float la2 = c8 * ra, av = fexp2(la2), mult = sqrtf(fmaxf(1.f - fexp2(2.f * la2), 0.f));
                    const float uv = bf1(U[tl * 72 + nb * 32 + l32]);
                    const float dr = mult * ix * uv;
                    h = av * h + dr; A *= av; hl[r] = h; cA[r] = A; }
                gA[g] = A; gB[g] = h; }
#pragma unroll
            for (int g = 0; g < 4; ++g) {
                const float pA = __shfl_xor(gA[g], 32), pB = __shfl_xor(gB[g], 32);
                const float A0 = hi ? pA : gA[g], B0 = hi ? pB : gB[g], A1 = hi ? gA[g] : pA, B1 = hi ? gB[g] : pB;
                const float in0 = Hrun, inA0 = Arun; Hrun = A0 * Hrun + B0; Arun *= A0;
                const float in1 = Hrun, inA1 = Arun; Hrun = A1 * Hrun + B1; Arun *= A1;
                const float my_in = hi ? in1 : in0, my_inA = hi ? inA1 : inA0;
#pragma unroll
                for (int j = 0; j < 4; ++j) { const int r = 4 * g + j, tl = mb * 32 + crow(r, hi); const size_t o = (size_t)(seq0 + t0 + tl) * 512 + chn;
                    HLOC[o] = (bf16)f2bf(hl[r] + cA[r] * my_in); CUMA[o] = (bf16)f2bf(cA[r] * my_inA); }
            }
        }
        if (hi == 0) { const size_t so = ((size_t)b * 64 + ch) * 512 + chn; __hip_atomic_store(SUMA + so, Arun, RLX_AGENT); __hip_atomic_store(SUMH + so, Hrun, RLX_AGENT); }
    }
    LDS_WAIT(); asm volatile("" ::: "memory");
}
__device__ __forceinline__ void sc_pass(const KA& a, int l, const bf16* __restrict__ SB, const bf16* __restrict__ P, bf16* Y, int gt, int ngt) {
    const float* cw = a.in(12) + (size_t)l * 3 * 512;
    for (int it = gt; it < HTOK * 64; it += ngt) {
        const int row = it >> 6, c0 = (it & 63) * 8, t = row & (SEQ - 1);
        const v4u sb = *(const v4u*)(SB + (size_t)row * 512 + c0), p2 = *(const v4u*)(P + (size_t)row * 512 + c0);
        v4u p1 = (v4u){0u, 0u, 0u, 0u}, p0 = (v4u){0u, 0u, 0u, 0u};
        if (t >= 1) p1 = *(const v4u*)(P + (size_t)(row - 1) * 512 + c0);
        if (t >= 2) p0 = *(const v4u*)(P + (size_t)(row - 2) * 512 + c0);
        float w0[8], w1[8], w2[8];
#pragma unroll
        for (int h = 0; h < 2; ++h) { const f32x4 x0 = *(const f32x4*)(cw + c0 + 4 * h), x1 = *(const f32x4*)(cw + 512 + c0 + 4 * h), x2 = *(const f32x4*)(cw + 1024 + c0 + 4 * h);
#pragma unroll
            for (int j = 0; j < 4; ++j) { w0[4 * h + j] = x0[j]; w1[4 * h + j] = x1[j]; w2[4 * h + j] = x2[j]; } }
        const unsigned s_[4] = {sb.x, sb.y, sb.z, sb.w}, q0[4] = {p0.x, p0.y, p0.z, p0.w}, q1[4] = {p1.x, p1.y, p1.z, p1.w}, q2[4] = {p2.x, p2.y, p2.z, p2.w};
        unsigned o[4];
#pragma unroll
        for (int j = 0; j < 4; ++j) { const float lo = bflo(s_[j]) * (w0[2 * j] * bflo(q0[j]) + w1[2 * j] * bflo(q1[j]) + w2[2 * j] * bflo(q2[j]));
            const float hi = bfhi(s_[j]) * (w0[2 * j + 1] * bfhi(q0[j]) + w1[2 * j + 1] * bfhi(q1[j]) + w2[2 * j + 1] * bfhi(q2[j])); o[j] = cvtpk(lo, hi); }
        *(v4u*)(Y + (size_t)row * 1536 + 1024 + c0) = (v4u){o[0], o[1], o[2], o[3]};
    }
}
__device__ __forceinline__ float gelu_tanh_f(float x) { return x * sigmoidf_(2.f * 0.7978845608028654f * (x + 0.044715f * x * x * x)); }
__device__ __forceinline__ void lru_fix_task(const bf16* __restrict__ LG, const bf16* __restrict__ HLOC, const bf16* __restrict__ CUMA, float* SUMA, float* SUMH,
                                             bf16* Y, LAS float* CAR, int b, int ch, int tid) {
    { float carry = 0.f; float* pa = SUMA + (size_t)b * 64 * 512 + tid; float* ph = SUMH + (size_t)b * 64 * 512 + tid;
#pragma unroll 8
      for (int c = 0; c < ch; ++c) carry = __hip_atomic_load(pa + c * 512, RLX_AGENT) * carry + __hip_atomic_load(ph + c * 512, RLX_AGENT);
      CAR[tid] = carry; }
    __syncthreads();
    const int g8 = (tid & 63) * 8; float cr[8];
#pragma unroll
    for (int j = 0; j < 8; ++j) cr[j] = CAR[g8 + j];
    const size_t r0 = (size_t)b * SEQ + ch * 64;
#pragma unroll 2
    for (int k = 0; k < 8; ++k) { const size_t row = r0 + (tid >> 6) + 8 * k, o = row * 512 + g8;
        float x[8], h[8], c[8]; unpack8(*(const v4u*)(LG + o), x); unpack8(*(const v4u*)(HLOC + o), h); unpack8(*(const v4u*)(CUMA + o), c);
#pragma unroll
        for (int j = 0; j < 8; ++j) x[j] = gelu_tanh_f(x[j]) * (h[j] + c[j] * cr[j]);
        *(v4u*)(Y + row * 1536 + 512 + g8) = pack8f(x); }
    __syncthreads();
}

__device__ __forceinline__ void p6_ln1_router(const KA& a, int l, LAS unsigned char* lds, int G, int tid, int wave, int lane) {
    unsigned char* ws = a.ws(); bf16* H = (bf16*)(ws + WS_H); float* WTS = (float*)(ws + WS_WTS); unsigned* LIST = (unsigned*)(ws + WS_LIST); gu32* ctl = (gu32*)(ws + WS_CTL);
    LAS float* RW = (LAS float*)lds;
    LAS int* ENT = (LAS int*)(lds + 81920);
    LAS int* RANK = ENT + 256;
    LAS unsigned* LCNT = (LAS unsigned*)(RANK + 256);
    LAS unsigned* LBASE = LCNT + 16;
    LAS float* RSC = (LAS float*)(LBASE + 16);
    LAS float* LGS = (LAS float*)(lds + 81920 + 4096) + wave * (16 * 20 * 4);
    { const float* wg = a.in(19) + (size_t)l * 1024 * 4; const float* we = a.in(21) + (size_t)l * 1024 * 16;
      for (int i = tid; i < 1024 * 4; i += 512) RW[(i & 3) * 1024 + (i >> 2)] = wg[i];
      for (int i = tid; i < 1024 * 16; i += 512) RW[(4 + (i & 15)) * 1024 + (i >> 4)] = we[i]; }
    __syncthreads();
    const float* gam = a.in(17) + l * D; const float* bet = a.in(18) + l * D; const float* gbias = a.in(20) + l * 4; const float* ebias = a.in(22) + l * 16;
    for (int rb = blockIdx.x; rb < NTOK / 128; rb += G) {
        if (tid < 16) LCNT[tid] = 0u;
#pragma unroll 1
        for (int grp = 0; grp < 4; ++grp) {
            float v[4][16];
#pragma unroll
            for (int r = 0; r < 4; ++r) { bf16* hp = H + (size_t)(rb * 128 + wave * 16 + grp * 4 + r) * D; unpack8(*(const v4u*)(hp + 8 * lane), v[r]); unpack8(*(const v4u*)(hp + 512 + 8 * lane), v[r] + 8); }
#pragma unroll
            for (int r = 0; r < 4; ++r) { ln16(v[r], gam, bet, lane); const size_t row_ = (size_t)(rb * 128 + wave * 16 + grp * 4 + r); bf16* hp = H + row_ * D; *(v4u*)(hp + 8 * lane) = pack8f(v[r]); *(v4u*)(hp + 512 + 8 * lane) = pack8f(v[r] + 8);
                const float sc_ = quant_row16(v[r], (signed char*)(ws + WS_HQ) + row_ * D, (float*)(ws + WS_HS) + row_, 8 * lane, 512 + 8 * lane, lane); if (lane == 0) RSC[wave * 16 + grp * 4 + r] = sc_; }
#pragma unroll 2
            for (int o = 0; o < 20; ++o) { const LAS float* w = RW + o * 1024 + 8 * lane; float wv[16];
#pragma unroll
                for (int h = 0; h < 2; ++h) { const f32x4 w0 = *(const LAS f32x4*)(w + 512 * h), w1 = *(const LAS f32x4*)(w + 512 * h + 4);
                    wv[8 * h] = w0.x; wv[8 * h + 1] = w0.y; wv[8 * h + 2] = w0.z; wv[8 * h + 3] = w0.w; wv[8 * h + 4] = w1.x; wv[8 * h + 5] = w1.y; wv[8 * h + 6] = w1.z; wv[8 * h + 7] = w1.w; }
#pragma unroll
                for (int r = 0; r < 4; ++r) { float s = 0.f;
#pragma unroll
                    for (int j = 0; j < 16; ++j) s += v[r][j] * wv[j];
                    s = row16_sum(s);
                    if ((lane & 15) == 0) LGS[((grp * 4 + r) * 20 + o) * 4 + (lane >> 4)] = s; } }
        }
        LDS_WAIT(); asm volatile("" ::: "memory");
        if (lane < 16) {
            const int rl = wave * 16 + lane, row = rb * 128 + rl; float lg[20];
#pragma unroll
            for (int o = 0; o < 20; ++o) { const f32x4 p = *(const LAS f32x4*)(LGS + (lane * 20 + o) * 4); lg[o] = (p.x + p.y) + (p.z + p.w); }
            int gs = 0; float bestg = lg[0] + gbias[0];
#pragma unroll
            for (int g = 1; g < 4; ++g) { const float x = lg[g] + gbias[g]; if (x > bestg) { bestg = x; gs = g; } }
            const float gmax = fmaxf(fmaxf(lg[0], lg[1]), fmaxf(lg[2], lg[3]));
            float gden = 0.f, gnum = 0.f;
#pragma unroll
            for (int g = 0; g < 4; ++g) { const float e = __expf(lg[g] - gmax); gden += e; gnum = (g == gs) ? e : gnum; }
            const float gprob = gnum / gden;
            float ein[4], eb[4];
#pragma unroll
            for (int i = 0; i < 4; ++i) { ein[i] = gs == 0 ? lg[4 + i] : gs == 1 ? lg[8 + i] : gs == 2 ? lg[12 + i] : lg[16 + i]; eb[i] = ein[i] + ebias[gs * 4 + i]; }
            int i0 = 0; float b0 = eb[0];
#pragma unroll
            for (int i = 1; i < 4; ++i) if (eb[i] > b0) { b0 = eb[i]; i0 = i; }
            int i1 = -1; float b1 = 0.f;
#pragma unroll
            for (int i = 0; i < 4; ++i) if (i != i0 && (i1 < 0 || eb[i] > b1)) { b1 = eb[i]; i1 = i; }
            const float x0 = i0 == 0 ? ein[0] : i0 == 1 ? ein[1] : i0 == 2 ? ein[2] : ein[3], x1 = i1 == 0 ? ein[0] : i1 == 1 ? ein[1] : i1 == 2 ? ein[2] : ein[3];
            const float mx = fmaxf(x0, x1), e0 = __expf(x0 - mx), e1 = __expf(x1 - mx), inv = gprob / (e0 + e1);
            *(pg8::f32x2*)(WTS + (size_t)row * 2) = (pg8::f32x2){e0 * inv, e1 * inv}; ENT[rl * 2] = gs * 4 + i0; ENT[rl * 2 + 1] = gs * 4 + i1;
        }
        __syncthreads();
        if (tid < 256) RANK[tid] = (int)__hip_atomic_fetch_add((LAS unsigned*)&LCNT[ENT[tid]], 1u, __ATOMIC_RELAXED, __HIP_MEMORY_SCOPE_WORKGROUP);
        __syncthreads();
        if (tid < 16) LBASE[tid] = __hip_atomic_fetch_add(ctl + CW_CNT + (l * 16 + tid) * 64, LCNT[tid], RLX_AGENT);
        __syncthreads();
        if (tid < 256) { const int e = ENT[tid]; const size_t slot = (size_t)e * LISTCAP + LBASE[e] + RANK[tid]; LIST[slot] = (unsigned)((rb * 128 + (tid >> 1)) * 2 + (tid & 1)); ((float*)(ws + WS_LSC))[slot] = RSC[tid >> 1]; }
        __syncthreads();
    }
}
__device__ __forceinline__ void moe_table(const KA& a, int l, LAS int* tab, int tid) {
    gu32* ctl = (gu32*)(a.ws() + WS_CTL);
    if (tid < 16) tab[17 + tid] = (int)__hip_atomic_load(ctl + CW_CNT + (l * 16 + tid) * 64, RLX_AGENT);
    __syncthreads();
    if (tid == 0) { int s = 0; for (int e = 0; e < 16; ++e) { tab[e] = s; s += (tab[17 + e] + 255) >> 8; } tab[16] = s; }
    __syncthreads();
}
__device__ __forceinline__ void p9_ln2(const KA& a, int l, int gw, int NGW, int lane) {
    unsigned char* ws = a.ws(); bf16* H = (bf16*)(ws + WS_H); const float* WTS = (const float*)(ws + WS_WTS); const bf16* F0 = (const bf16*)(ws + WS_FFN); const bf16* F1 = F0 + (size_t)NTOK * D;
    const float* gam = a.in(26) + l * D; const float* bet = a.in(27) + l * D;
    for (int row = gw; row < NTOK; row += NGW) {
        bf16* hp = H + (size_t)row * D; const bf16* f0 = F0 + (size_t)row * D; const bf16* f1 = F1 + (size_t)row * D; const float w0 = WTS[(size_t)row * 2], w1 = WTS[(size_t)row * 2 + 1];
        float v[16], x[8], y[8];
#pragma unroll
        for (int h = 0; h < 2; ++h) { unpack8(*(const v4u*)(hp + 512 * h + 8 * lane), v + 8 * h); unpack8(*(const v4u*)(f0 + 512 * h + 8 * lane), x); unpack8(*(const v4u*)(f1 + 512 * h + 8 * lane), y);
#pragma unroll
            for (int j = 0; j < 8; ++j) v[8 * h + j] = ALPHA * v[8 * h + j] + w0 * x[j] + w1 * y[j]; }
        ln16(v, gam, bet, lane);
        if (l == DEPTH - 1) { float* op = a.out() + (size_t)row * D;
#pragma unroll
            for (int h = 0; h < 2; ++h) { *(f32x4*)(op + 512 * h + 8 * lane) = (f32x4){v[8 * h], v[8 * h + 1], v[8 * h + 2], v[8 * h + 3]}; *(f32x4*)(op + 512 * h + 8 * lane + 4) = (f32x4){v[8 * h + 4], v[8 * h + 5], v[8 * h + 6], v[8 * h + 7]}; } }
        else { *(v4u*)(hp + 8 * lane) = pack8f(v); *(v4u*)(hp + 512 + 8 * lane) = pack8f(v + 8);
            quant_row16(v, (signed char*)(ws + WS_HQ) + (size_t)row * D, (float*)(ws + WS_HS) + row, 8 * lane, 512 + 8 * lane, lane); }
    }
}

#ifndef PH_MASK
#define PH_MASK 0xFFFF
#endif
#ifndef REP_MASK
#define REP_MASK 0
#endif
#define REPS(bit) for (int rep_ = 0; rep_ < ((REP_MASK & (bit)) ? 2 : 1); ++rep_)
#ifndef STOP_AT
#define STOP_AT 0
#endif
#define STOP_DUMP(n, off) do { if (STOP_AT == (n) && l == 0 && hf == 0) { PHASE_BEGIN const bf16* H_ = (const bf16*)(ws + (off)); float* o_ = A_.out(); for (size_t i = (size_t)bx * 512 + tid; i < (size_t)NTOK * D; i += (size_t)G * 512) o_[i] = bf1(H_[i]); return; } } while (0)
#define STOP_HERE(n) do { if (STOP_AT == (n)) { PHASE_BEGIN const bf16* H_ = (const bf16*)(ws + WS_H); float* o_ = A_.out(); for (size_t i = (size_t)bx * 512 + tid; i < (size_t)NTOK * D; i += (size_t)G * 512) o_[i] = bf1(H_[i]); return; } } while (0)
__global__ void __launch_bounds__(NWAVES * 64, 2) hybrid_fwd(Args args) {
    extern __shared__ __attribute__((aligned(16))) unsigned char lds_raw[];
    LAS unsigned char* lds = (LAS unsigned char*)lds_raw;
    const int G = gridDim.x, bx = blockIdx.x;
#define PHASE_BEGIN KA A_; A_.kp = (KP)__builtin_amdgcn_kernarg_segment_ptr(); asm volatile("" : "+s"(A_.kp)); int tid = threadIdx.x; asm volatile("" : "+v"(tid)); \
    const int lane = tid & 63, wave = __builtin_amdgcn_readfirstlane(tid >> 6), gw = bx * NWAVES + wave, NGW = G * NWAVES; unsigned char* ws = A_.ws(); (void)lane; (void)gw; (void)NGW; (void)ws;
    XcdBarrier bar;
    { PHASE_BEGIN
      for (int u = tid; u < (LDS_BYTES - LDSCTL_OFF) / 4; u += NWAVES * 64) ((LAS unsigned*)(lds + LDSCTL_OFF))[u] = 0u;
      __syncthreads();
      bar = xcd_barrier_post((unsigned*)(ws + WS_CTL) + CW_BAR, (volatile LAS unsigned*)(lds + MISC_OFF) + 8);
      REPS(1) if (PH_MASK & 1) p0_prologue(A_, lds, gw, NGW, wave, lane); }
    xcd_barrier(bar);
    STOP_HERE(1);

#pragma unroll 1
    for (int l = 0; l < DEPTH; ++l) {
#pragma unroll 1
        for (int hf = 0; hf < 2; ++hf) {
            REPS(2) if (PH_MASK & 2) { PHASE_BEGIN
              InprojSched S; S.G = G; S.c = bx; S.Hh = (const char*)(ws + WS_HQ) + (size_t)hf * HTOK * D; S.Win = (const char*)(ws + WS_WIN) + (size_t)l * PROJ * 1024;
              EpiInproj E{(bf16*)(ws + WS_ZC), (bf16*)(ws + WS_G), (bf16*)(ws + WS_VT), A_.in(4) + (size_t)l * 3 * 1024, (const float*)(ws + WS_HS) + hf * HTOK, (const float*)(ws + WS_CTL) + CW_WS + l * PROJ};
              pg8::gemm_phase<EpiInproj, InprojSched, true, false, true>(lds, pg8::Gemm{512, 512, 512}, S, E); }
            xcd_barrier(bar);
            STOP_DUMP(10, WS_ZC); STOP_DUMP(11, WS_ZC + 64 * MiB); STOP_DUMP(12, WS_ZC + 128 * MiB); STOP_DUMP(13, WS_ZC + 144 * MiB);
            REPS(4) if (PH_MASK & 4) { PHASE_BEGIN
              bf16* ZC = (bf16*)(ws + WS_ZC); bf16* Y = (bf16*)(ws + WS_Y); bf16* HLOC = (bf16*)(ws + WS_MRG); bf16* CUMA = HLOC + (size_t)HTOK * 512; float* SUMA = (float*)(ws + WS_SUM); float* SUMH = SUMA + 4 * 64 * 512;
              gu32* cnt = (gu32*)(ws + WS_CTL) + CW_LRU + ((l * 2 + hf) * 4) * 64;
              LAS bf16* U = (LAS bf16*)(lds + wave * 9216);
              if (rep_ == 0) {
                for (int tw = bx; tw < 4 * 64; tw += G) lru_local_task(A_, l, ZC + (size_t)2 * HTOK * 512, HLOC, CUMA, SUMA, SUMH, (const bf16*)(ws + WS_LRUW), U, tw >> 6, tw & 63, wave, lane);
                asm volatile("s_waitcnt vmcnt(0)" ::: "memory");
                __syncthreads();
                if (tid == 0) for (int tw = bx; tw < 4 * 64; tw += G) __hip_atomic_fetch_add(cnt + (tw >> 6) * 64, 1u, RLX_AGENT);
              }
              REPS(2048) for (int t = bx; t < 4 * 8 * 16; t += G) sb_attn_wg(ZC, ZC + (size_t)HTOK * 512, (const bf16*)(ws + WS_VT), Y, lds, t >> 7, (t >> 4) & 7, t & 15, wave, lane);
              REPS(4096) sc_pass(A_, l, ZC + (size_t)4 * HTOK * 512, ZC + (size_t)5 * HTOK * 512, Y, bx * 512 + tid, G * 512);
              for (int tw = bx; tw < 4 * 64; tw += G) {
                  if (tid == 0) { unsigned sp = 0; while (__hip_atomic_load(cnt + (tw >> 6) * 64, RLX_AGENT) < 64u) { __builtin_amdgcn_s_sleep(2); if (++sp > (1u << 20)) { __hip_atomic_store((gu32*)(ws + WS_CTL) + CW_TMO, 1u, RLX_AGENT); break; } } }
                  __syncthreads();
                  lru_fix_task(ZC + (size_t)3 * HTOK * 512, HLOC, CUMA, SUMA, SUMH, Y, (LAS float*)lds, tw >> 6, tw & 63, tid); }
            }
            xcd_barrier(bar);
            STOP_DUMP(30, WS_Y);
            REPS(16) if (PH_MASK & 16) { PHASE_BEGIN
              BranchSched S; S.G = G; S.c = bx; S.Y = (const char*)(ws + WS_Y); S.WBR = (const char*)(ws + WS_WBR) + (size_t)l * 1024 * 1536 * 2;
              EpiBranch E{(const unsigned char*)(ws + WS_G), (bf16*)(ws + WS_MRG)};
              pg8::gemm_phase<EpiBranch, BranchSched, true, false>(lds, pg8::Gemm{512, 1536, 1536}, S, E); }
            xcd_barrier(bar);
            STOP_DUMP(40, WS_MRG);
            if (PH_MASK & 32) { PHASE_BEGIN
              PlainSched S; S.G = G; S.c = bx; S.nM = 64; S.nN = 4; S.A = (const char*)(ws + WS_MRG); S.B = (const char*)(ws + WS_WOUT) + (size_t)l * 1024 * 1024 * 2; S.astep = (size_t)256 * 1024 * 2; S.bstep = (size_t)256 * 1024 * 2;
              EpiOutproj E{(bf16*)(ws + WS_H) + (size_t)hf * HTOK * D};
              pg8::gemm_phase<EpiOutproj, PlainSched, true, false>(lds, pg8::Gemm{1024, 1024, 1024}, S, E); }
            if (hf == 1) xcd_barrier(bar);
            STOP_DUMP(50, WS_H);
        }
        STOP_HERE(2);
        if (PH_MASK & 64) { PHASE_BEGIN p6_ln1_router(A_, l, lds, G, tid, wave, lane); }
        xcd_barrier(bar);
        STOP_HERE(3);
        REPS(128) if (PH_MASK & 128) { PHASE_BEGIN
          LAS int* tab = (LAS int*)(lds + MOE_OFF);
          moe_table(A_, l, tab, tid);
          MoeSched S; S.G = G; S.c = bx; S.tab = tab; S.Abase = (const char*)(ws + WS_HQ); S.atile = 0; S.Wbase = (const char*)(ws + WS_WGU) + (size_t)l * NEXP * 1024 * 1024; S.wstride = (size_t)1024 * 1024; S.bstep = (size_t)256 * 1024;
          S.list = (const unsigned*)(ws + WS_LIST);
          EpiGateUp E{(bf16*)(ws + WS_HB), (const float*)(ws + WS_LSC), (const float*)(ws + WS_WGUS) + (size_t)l * NEXP * 1024};
          pg8::gemm_phase<EpiGateUp, MoeSched, true, true, true>(lds, pg8::Gemm{512, 512, 512}, S, E); }
        xcd_barrier(bar);
        REPS(256) if (PH_MASK & 256) { PHASE_BEGIN
          LAS int* tab = (LAS int*)(lds + MOE_OFF);
          moe_table(A_, l, tab, tid);
          MoeSched S; S.G = G; S.c = bx; S.tab = tab; S.Abase = (const char*)(ws + WS_HB); S.atile = (size_t)256 * 512 * 2; S.Wbase = (const char*)(ws + WS_WDN) + (size_t)l * NEXP * 1024 * 512 * 2; S.wstride = (size_t)1024 * 512 * 2; S.bstep = (size_t)256 * 512 * 2;
          S.list = (const unsigned*)(ws + WS_LIST);
          EpiDown E{(bf16*)(ws + WS_FFN), (const unsigned*)(ws + WS_LIST)};
          pg8::gemm_phase<EpiDown, MoeSched, true, false>(lds, pg8::Gemm{512, 512, 512}, S, E); }
        xcd_barrier(bar);
        for (int rep_ = 0; rep_ < (((REP_MASK & 512) && l == DEPTH - 1) ? 2 : 1); ++rep_) if (PH_MASK & 512) { PHASE_BEGIN p9_ln2(A_, l, gw, NGW, lane); }
        if (l + 1 < DEPTH) xcd_barrier(bar);
        STOP_HERE(4);
    }
}

extern "C" void kernel_launch(void* const* d_in, const int* in_sizes, int n_in, void* d_out, int out_size, void* d_ws, size_t ws_size, hipStream_t stream) {
    static int grid = 0;
    if (grid == 0) {
        if (n_in != 28 || in_sizes[0] != NTOK * D || out_size != NTOK * D || ws_size < WS_END) { fprintf(stderr, "kernel_launch: unexpected shapes (n_in %d, in0 %d, out %d, ws %zu); nothing launched\n", n_in, n_in > 0 ? in_sizes[0] : -1, out_size, ws_size); grid = -1; return; }
        int dev = 0, cus = 0, per_cu = 0;
        if (hipGetDevice(&dev) != hipSuccess || hipDeviceGetAttribute(&cus, hipDeviceAttributeMultiprocessorCount, dev) != hipSuccess) { grid = -1; return; }
        if (hipFuncSetAttribute((const void*)hybrid_fwd, hipFuncAttributeMaxDynamicSharedMemorySize, LDS_BYTES) != hipSuccess) { fprintf(stderr, "kernel_launch: hipFuncSetAttribute failed\n"); grid = -1; return; }
        if (hipOccupancyMaxActiveBlocksPerMultiprocessor(&per_cu, (const void*)hybrid_fwd, NWAVES * 64, LDS_BYTES) != hipSuccess || per_cu < 1) fprintf(stderr, "kernel_launch: occupancy query reports %d\n", per_cu);
        (void)hipGetLastError();
        grid = cus;
    }
    if (grid < 0) return;
    if (hipMemsetAsync((char*)d_ws + WS_CTL, 0, CTL_ZERO_BYTES, stream) != hipSuccess) return;
    Args a{};
    for (int i = 0; i < 28; ++i) a.in[i] = (const float*)d_in[i];
    a.out = (float*)d_out; a.ws = (unsigned char*)d_ws;
    hipLaunchKernelGGL(hybrid_fwd, dim3(grid), dim3(NWAVES * 64), LDS_BYTES, stream, a);
}
```
